# Optimizing an MI355X kernel written in HIP

```python
import math
import jax, jax.numpy as jnp
from jax import lax
import numpy as np

D_MODEL = 2048
BATCH = 2
SEQ = 8192
DEPTH = 1

CHUNK = 64
D_MIX = D_MODEL
RET_WIDTH = D_MIX // 2
RET_HEAD_DIM = 256
RET_HEADS = RET_WIDTH // RET_HEAD_DIM
SSD_WIDTH = D_MIX - RET_WIDTH
SSD_HEAD_DIM = 64
SSD_HEADS = SSD_WIDTH // SSD_HEAD_DIM
SSD_GROUPS = 2
SSD_HEADS_PER_GROUP = SSD_HEADS // SSD_GROUPS
SSD_STATE = 128
CONV_WIDTH = 4
CONV_CH = SSD_WIDTH + 2 * SSD_GROUPS * SSD_STATE
D_IN_PROJ = 4 * RET_WIDTH + SSD_WIDTH + CONV_CH + SSD_HEADS
D_FF = ((8 * D_MODEL // 3 + 255) // 256) * 256
ROPE_BASE = 10000.0
LN_EPS = 1e-5
DEEPNORM_ALPHA = (2.0 * DEPTH) ** 0.25
DEEPNORM_BETA = (8.0 * DEPTH) ** -0.25
FFN_RES_WEIGHT = 0.5

kernel_name = "hymba_retention_ssd_macaron_deepnorm"


def layer_norm(x, gain, bias):
    xf = x.astype(jnp.float32)
    mu = jnp.mean(xf, axis=-1, keepdims=True)
    var = jnp.mean(jnp.square(xf - mu), axis=-1, keepdims=True)
    return ((xf - mu) * lax.rsqrt(var + LN_EPS)).astype(x.dtype) * gain + bias


def swiglu_ffn(x, w_gate, w_up, w_down):
    return (jax.nn.silu(x @ w_gate) * (x @ w_up)) @ w_down


def rotate_every_two(t, positions):
    half = t.shape[-1] // 2
    inv_freq = 1.0 / (ROPE_BASE ** jnp.linspace(0.0, 1.0, half, dtype=jnp.float32))
    theta = positions.astype(jnp.float32)[..., None] * inv_freq
    cos = jnp.cos(theta)[:, :, None, :].astype(t.dtype)
    sin = jnp.sin(theta)[:, :, None, :].astype(t.dtype)
    t2 = t.reshape(t.shape[:-1] + (half, 2))
    t_even, t_odd = t2[..., 0], t2[..., 1]
    out = jnp.stack([t_even * cos - t_odd * sin, t_odd * cos + t_even * sin], axis=-1)
    return out.reshape(t.shape)


def multiscale_retention(q, k, v, positions):
    b, l, _ = q.shape
    nc = l // CHUNK
    dtype = q.dtype
    shp = (b, l, RET_HEADS, RET_HEAD_DIM)
    q = rotate_every_two(q.reshape(shp), positions)
    k = rotate_every_two(k.reshape(shp), positions) * (RET_HEAD_DIM ** -0.5)
    v = v.reshape(shp)
    log_gamma = jnp.log(1.0 - 2.0 ** (-5.0 - jnp.arange(RET_HEADS, dtype=jnp.float32)))
    pos = jnp.arange(CHUNK, dtype=jnp.float32)
    rel = pos[:, None] - pos[None, :]
    intra_decay = jnp.where(rel >= 0, jnp.exp(log_gamma[:, None, None] * jnp.maximum(rel, 0.0)), 0.0).astype(dtype)
    query_decay = jnp.exp(log_gamma[None, :] * (pos[:, None] + 1.0)).astype(dtype)
    key_decay = jnp.exp(log_gamma[None, :] * (CHUNK - 1.0 - pos[:, None])).astype(dtype)
    chunk_decay = jnp.exp(log_gamma * CHUNK).astype(dtype)
    cshp = (b, nc, CHUNK, RET_HEADS, RET_HEAD_DIM)
    qc, kc, vc = q.reshape(cshp), k.reshape(cshp), v.reshape(cshp)
    scores = jnp.einsum('bzihd,bzjhd->bzhij', qc, kc) * intra_decay
    o_intra = jnp.einsum('bzhij,bzjhe->bzihe', scores, vc)

    def step(state, inp):
        q_z, k_z, v_z = inp
        o_z = jnp.einsum('bihd,bhde->bihe', q_z, state) * query_decay[None, :, :, None]
        state = state * chunk_decay[None, :, None, None] + jnp.einsum('bjhd,bjhe,jh->bhde', k_z, v_z, key_decay)
        return state, o_z

    state0 = jnp.zeros((b, RET_HEADS, RET_HEAD_DIM, RET_HEAD_DIM), dtype)
    _, o_inter = lax.scan(step, state0, (jnp.moveaxis(qc, 1, 0), jnp.moveaxis(kc, 1, 0), jnp.moveaxis(vc, 1, 0)))
    o = o_intra + jnp.moveaxis(o_inter, 0, 1)
    return o.reshape(shp)


def head_group_norm(o, gain, bias):
    of = o.astype(jnp.float32)
    mu = jnp.mean(of, axis=-1, keepdims=True)
    var = jnp.mean(jnp.square(of - mu), axis=-1, keepdims=True)
    on = ((of - mu) * lax.rsqrt(var + LN_EPS)).astype(o.dtype)
    b, l = o.shape[0], o.shape[1]
    return on.reshape(b, l, RET_WIDTH) * gain + bias


def ssd_mixer(z, xbc, dt_raw, conv_w, conv_b, dt_bias, a_log, d_skip, norm_gain):
    b, l, _ = z.shape
    nc = l // CHUNK
    G, R, P, N = SSD_GROUPS, SSD_HEADS_PER_GROUP, SSD_HEAD_DIM, SSD_STATE
    xpad = jnp.pad(xbc, ((0, 0), (CONV_WIDTH - 1, 0), (0, 0)))
    conv = conv_b + sum(xpad[:, t:t + l] * conv_w[t] for t in range(CONV_WIDTH))
    xbc = jax.nn.silu(conv)
    xs, bm, cm = jnp.split(xbc, [SSD_WIDTH, SSD_WIDTH + G * N], axis=-1)
    x = xs.reshape(b, nc, CHUNK, G, R, P)
    bm = bm.reshape(b, nc, CHUNK, G, N)
    cm = cm.reshape(b, nc, CHUNK, G, N)
    dt = jax.nn.softplus((dt_raw + dt_bias).astype(jnp.float32)).reshape(b, nc, CHUNK, G, R)
    a = -jnp.exp(a_log.astype(jnp.float32)).reshape(G, R)
    a_cum = jnp.cumsum(dt * a, axis=2)
    xdt = x * dt[..., None].astype(x.dtype)
    seg = a_cum[:, :, :, None] - a_cum[:, :, None, :]
    idx = jnp.arange(CHUNK)
    causal = (idx[:, None] >= idx[None, :])[None, None, :, :, None, None]
    decay = jnp.exp(jnp.where(causal, seg, -jnp.inf)).astype(x.dtype)
    cb = jnp.einsum('bzign,bzjgn->bzijg', cm, bm)
    y_intra = jnp.einsum('bzijgr,bzjgrp->bzigrp', cb[..., None] * decay, xdt)

    def step(state, inp):
        c_z, b_z, xdt_z, acum_z = inp
        from_start = jnp.exp(acum_z).astype(state.dtype)
        to_end = jnp.exp(acum_z[:, -1:] - acum_z).astype(state.dtype)
        total = jnp.exp(acum_z[:, -1]).astype(state.dtype)
        y_z = jnp.einsum('bign,bgrpn->bigrp', c_z, state) * from_start[..., None]
        state = state * total[..., None, None] + jnp.einsum('bjgn,bjgr,bjgrp->bgrpn', b_z, to_end, xdt_z)
        return state, y_z

    state0 = jnp.zeros((b, G, R, P, N), x.dtype)
    _, y_inter = lax.scan(step, state0, (jnp.moveaxis(cm, 1, 0), jnp.moveaxis(bm, 1, 0),
                                         jnp.moveaxis(xdt, 1, 0), jnp.moveaxis(a_cum, 1, 0)))
    y = y_intra + jnp.moveaxis(y_inter, 0, 1) + x * d_skip.reshape(G, R)[:, :, None]
    y = y.reshape(b, l, SSD_WIDTH) * jax.nn.silu(z)
    yg = y.reshape(b, l, G, SSD_WIDTH // G).astype(jnp.float32)
    yg = yg * lax.rsqrt(jnp.mean(jnp.square(yg), axis=-1, keepdims=True) + LN_EPS)
    return yg.reshape(b, l, SSD_WIDTH).astype(z.dtype) * norm_gain


def hybrid_mixer(h, positions, w_in, ret_gn_gain, ret_gn_bias, conv_w, conv_b,
                 dt_bias, a_log, d_skip, ssd_norm_gain, w_out):
    proj = h @ w_in
    splits = [RET_WIDTH, 2 * RET_WIDTH, 3 * RET_WIDTH, 4 * RET_WIDTH,
              4 * RET_WIDTH + SSD_WIDTH, 4 * RET_WIDTH + SSD_WIDTH + CONV_CH]
    q, k, v, g, z, xbc, dt_raw = jnp.split(proj, splits, axis=-1)
    ret = multiscale_retention(q, k, v, positions)
    ret_out = jax.nn.silu(g) * head_group_norm(ret, ret_gn_gain, ret_gn_bias)
    ssd_out = ssd_mixer(z, xbc, dt_raw, conv_w, conv_b, dt_bias, a_log, d_skip, ssd_norm_gain)
    return jnp.concatenate([ret_out, ssd_out], axis=-1) @ w_out


def setup_inputs(seed: int = 0) -> dict:
    key = jax.random.key(seed)
    ks = jax.random.split(key, 26)
    f32 = jnp.float32

    def normal(k, shape, scale):
        return jax.random.normal(k, shape, f32) * scale

    x = jax.random.normal(ks[0], (BATCH, SEQ, D_MODEL), f32)
    offset = jax.random.randint(ks[1], (BATCH, 1), 0, 1024, dtype=jnp.int32) * CHUNK
    positions = (offset + jnp.arange(SEQ, dtype=jnp.int32)[None, :]).astype(jnp.int32)
    dt_init = jnp.exp(jax.random.uniform(ks[13], (DEPTH, SSD_HEADS), f32, math.log(1e-3), math.log(1e-1)))
    ssd_dt_bias = dt_init + jnp.log(-jnp.expm1(-dt_init))
    ssd_a_log = jnp.log(jax.random.uniform(ks[14], (DEPTH, SSD_HEADS), f32, 1.0, 16.0))
    return {
        "x": x,
        "positions": positions,
        "ffn1_w_gate": normal(ks[2], (DEPTH, D_MODEL, D_FF), D_MODEL ** -0.5),
        "ffn1_w_up": normal(ks[3], (DEPTH, D_MODEL, D_FF), D_MODEL ** -0.5),
        "ffn1_w_down": normal(ks[4], (DEPTH, D_FF, D_MODEL), DEEPNORM_BETA * D_FF ** -0.5),
        "ln1_gain": 1.0 + normal(ks[5], (DEPTH, D_MODEL), 0.02),
        "ln1_bias": normal(ks[6], (DEPTH, D_MODEL), 0.02),
        "mix_w_in": normal(ks[7], (DEPTH, D_MODEL, D_IN_PROJ), D_MODEL ** -0.5),
        "ret_gn_gain": 1.0 + normal(ks[8], (DEPTH, RET_WIDTH), 0.02),
        "ret_gn_bias": normal(ks[9], (DEPTH, RET_WIDTH), 0.02),
        "ssd_conv_w": normal(ks[10], (DEPTH, CONV_WIDTH, CONV_CH), CONV_WIDTH ** -0.5),
        "ssd_conv_b": normal(ks[11], (DEPTH, CONV_CH), 0.02),
        "ssd_dt_bias": ssd_dt_bias,
        "ssd_a_log": ssd_a_log,
        "ssd_d": 1.0 + normal(ks[15], (DEPTH, SSD_HEADS), 0.02),
        "ssd_norm_gain": 1.0 + normal(ks[16], (DEPTH, SSD_WIDTH), 0.02),
        "mix_w_out": normal(ks[17], (DEPTH, D_MIX, D_MODEL), DEEPNORM_BETA * D_MIX ** -0.5),
        "ln2_gain": 1.0 + normal(ks[18], (DEPTH, D_MODEL), 0.02),
        "ln2_bias": normal(ks[19], (DEPTH, D_MODEL), 0.02),
        "ffn2_w_gate": normal(ks[20], (DEPTH, D_MODEL, D_FF), D_MODEL ** -0.5),
        "ffn2_w_up": normal(ks[21], (DEPTH, D_MODEL, D_FF), D_MODEL ** -0.5),
        "ffn2_w_down": normal(ks[22], (DEPTH, D_FF, D_MODEL), DEEPNORM_BETA * D_FF ** -0.5),
        "ln3_gain": 1.0 + normal(ks[23], (DEPTH, D_MODEL), 0.02),
        "ln3_bias": normal(ks[24], (DEPTH, D_MODEL), 0.02),
    }


def reference(x, positions, ffn1_w_gate, ffn1_w_up, ffn1_w_down, ln1_gain, ln1_bias,
              mix_w_in, ret_gn_gain, ret_gn_bias, ssd_conv_w, ssd_conv_b, ssd_dt_bias,
              ssd_a_log, ssd_d, ssd_norm_gain, mix_w_out, ln2_gain, ln2_bias,
              ffn2_w_gate, ffn2_w_up, ffn2_w_down, ln3_gain, ln3_bias):
    for layer in range(DEPTH):
        x = layer_norm(DEEPNORM_ALPHA * x + FFN_RES_WEIGHT * swiglu_ffn(x, ffn1_w_gate[layer], ffn1_w_up[layer], ffn1_w_down[layer]),
                       ln1_gain[layer], ln1_bias[layer])
        mix = hybrid_mixer(x, positions, mix_w_in[layer], ret_gn_gain[layer], ret_gn_bias[layer],
                           ssd_conv_w[layer], ssd_conv_b[layer], ssd_dt_bias[layer], ssd_a_log[layer],
                           ssd_d[layer], ssd_norm_gain[layer], mix_w_out[layer])
        x = layer_norm(DEEPNORM_ALPHA * x + mix, ln2_gain[layer], ln2_bias[layer])
        x = layer_norm(DEEPNORM_ALPHA * x + FFN_RES_WEIGHT * swiglu_ffn(x, ffn2_w_gate[layer], ffn2_w_up[layer], ffn2_w_down[layer]),
                       ln3_gain[layer], ln3_bias[layer])
    return x
```

```cpp
#include <hip/hip_runtime.h>
#include <hip/hip_cooperative_groups.h>
#include <cstdio>
#include <cstdint>
namespace cg = cooperative_groups;
namespace pg8 {
#define PG8_LAS __attribute__((address_space(3)))
typedef unsigned short bf16_t;
typedef short bf16x8 __attribute__((ext_vector_type(8)));
typedef float f32x4 __attribute__((ext_vector_type(4)));
typedef unsigned u32x4 __attribute__((ext_vector_type(4)));
constexpr int BM = 256, BK = 64, HALF = 128, HTB = HALF * BK * 2  , STAGE_BYTES = 8 * HTB, NXCD = 8, WGM = 8;

__host__ __device__ __forceinline__ int lds_byte(int r, int c) { const int st = (r >> 4) * 2 + (c >> 5), rr = r & 15, cc = c & 31, ob = rr * 64 + cc * 2; return st * 1024 + (ob ^ (((ob >> 9) & 1) << 5)); }
__host__ __device__ __forceinline__ void stage_rc(int b, int& R, int& C) { const int st = b / 1024, sb = b % 1024, swz = sb ^ (((sb >> 9) & 1) << 5); R = (st >> 1) * 16 + swz / 64; C = (st & 1) * 32 + (swz % 64) / 2; }
__host__ __device__ __forceinline__ int perm32(int rho) { const int n = rho >> 4, i = rho & 15; return 8 * (i >> 2) + 4 * n + (i & 3); }

struct Unit { int pm, pn; };
struct Gemm { const bf16_t* A; const bf16_t* Bt; int M, N, K; };

struct StaticOrder {
    int nM, nN, nwg, G, c;
    __host__ __device__ void init(int M, int N, int G_, int c_) { nM = M / BM; nN = N / BM; nwg = nM * nN; G = G_; c = c_; }
    __host__ __device__ bool next(int i, Unit& u) const {
        const long L = (long)i * G + c; if (L >= nwg) return false;
        int wgid = (int)L; { const int q = nwg / NXCD, r = nwg % NXCD, xcd = wgid % NXCD, off = wgid / NXCD; wgid = (xcd < r ? xcd * (q + 1) : r * (q + 1) + (xcd - r) * q) + off; }
        const int nig = WGM * nN, gid = wgid / nig, fm = gid * WGM, gsz = (nM - fm) < WGM ? (nM - fm) : WGM;
        u.pm = fm + ((wgid % nig) % gsz); u.pn = (wgid % nig) / gsz; return true;
    }
    __device__ __forceinline__ void a_ready(const Unit&) const {}
    __device__ __forceinline__ void done(const Unit&) const {}
};

typedef float cvt_f32x2 __attribute__((ext_vector_type(2)));
typedef __bf16 cvt_bf16x2 __attribute__((ext_vector_type(2)));
__device__ __forceinline__ unsigned cvt_pk_bf16(float lo, float hi) { const cvt_f32x2 v = {lo, hi}; return __builtin_bit_cast(unsigned, __builtin_convertvector(v, cvt_bf16x2)); }

__device__ __forceinline__ float swi(float g, float u) { return g * u * __builtin_amdgcn_rcpf(1.0f + __expf(-g)); }
struct EpiSwiglu {
    static constexpr bool PERM = true, AFTER_DRAIN = false;
    bf16_t* H; int ldh;
    __device__ __forceinline__ void operator()(const f32x4 (&acc)[2][2][4][2], const Unit& u, int wr, int wc, int fr, int fq) const {
        const int row0 = u.pm * BM + wr * 64 + fr, col0 = u.pn * 128 + wc * 32 + 8 * fq;
#pragma unroll
        for (int ai = 0; ai < 2; ++ai)
#pragma unroll
            for (int m = 0; m < 4; ++m) {
                bf16_t* p = H + (size_t)(row0 + ai * HALF + m * 16) * ldh + col0;
                const f32x4 g0 = acc[ai][0][m][0], g1 = acc[ai][0][m][1], u0 = acc[ai][1][m][0], u1 = acc[ai][1][m][1];
                u32x4 w;
                w.x = cvt_pk_bf16(swi(g0[0], u0[0]), swi(g0[1], u0[1])); w.y = cvt_pk_bf16(swi(g0[2], u0[2]), swi(g0[3], u0[3]));
                w.z = cvt_pk_bf16(swi(g1[0], u1[0]), swi(g1[1], u1[1])); w.w = cvt_pk_bf16(swi(g1[2], u1[2]), swi(g1[3], u1[3]));
                *(u32x4*)p = w;
            }
    }
};
struct EpiRes {
    static constexpr bool PERM = false, AFTER_DRAIN = false;
    const float* res; float* out; int ld; float alpha, s;
    __device__ __forceinline__ void operator()(const f32x4 (&acc)[2][2][4][2], const Unit& u, int wr, int wc, int fr, int fq) const {
        const int row0 = u.pm * BM + wr * 64 + fr, col0 = u.pn * BM + wc * 32 + 4 * fq;
#pragma unroll
        for (int ai = 0; ai < 2; ++ai)
#pragma unroll
            for (int m = 0; m < 4; ++m) {
                const size_t off = (size_t)(row0 + ai * HALF + m * 16) * ld + col0;
#pragma unroll
                for (int bj = 0; bj < 2; ++bj)
#pragma unroll
                    for (int n = 0; n < 2; ++n) {
                        const f32x4 r = *(const f32x4*)(res + off + bj * HALF + n * 16);
                        *(f32x4*)(out + off + bj * HALF + n * 16) = r * alpha + acc[ai][bj][m][n] * s;
                    }
            }
    }
};
struct EpiInProj {
    static constexpr bool PERM = true, AFTER_DRAIN = false;
    bf16_t* P; const float* cs; const float* sn; float* DT;
    __device__ __forceinline__ void operator()(const f32x4 (&acc)[2][2][4][2], const Unit& u, int wr, int wc, int fr, int fq) const {
        const int row0 = u.pm * BM + wr * 64 + fr, pn = u.pn;
#pragma unroll
        for (int ai = 0; ai < 2; ++ai)
#pragma unroll
            for (int m = 0; m < 4; ++m) {
                const int row = row0 + ai * HALF + m * 16;
#pragma unroll
                for (int bj = 0; bj < 2; ++bj) {
                    const int colt = bj * HALF + wc * 32 + 8 * fq;
                    f32x4 v0 = acc[ai][bj][m][0], v1 = acc[ai][bj][m][1];
                    if (pn < 8) {
                        const f32x4 c = *(const f32x4*)(cs + (size_t)row * 128 + (colt >> 1)), s = *(const f32x4*)(sn + (size_t)row * 128 + (colt >> 1));
                        const float sc = pn >= 4 ? 0.0625f : 1.0f;
                        f32x4 a, b;
                        a[0] = (v0[0] * c[0] - v0[1] * s[0]) * sc; a[1] = (v0[1] * c[0] + v0[0] * s[0]) * sc;
                        a[2] = (v0[2] * c[1] - v0[3] * s[1]) * sc; a[3] = (v0[3] * c[1] + v0[2] * s[1]) * sc;
                        b[0] = (v1[0] * c[2] - v1[1] * s[2]) * sc; b[1] = (v1[1] * c[2] + v1[0] * s[2]) * sc;
                        b[2] = (v1[2] * c[3] - v1[3] * s[3]) * sc; b[3] = (v1[3] * c[3] + v1[2] * s[3]) * sc;
                        v0 = a; v1 = b;
                    }
                    if (pn < 26) {
                        u32x4 w; w.x = cvt_pk_bf16(v0[0], v0[1]); w.y = cvt_pk_bf16(v0[2], v0[3]); w.z = cvt_pk_bf16(v1[0], v1[1]); w.w = cvt_pk_bf16(v1[2], v1[3]);
                        *(u32x4*)(P + (size_t)row * 6672 + pn * BM + colt) = w;
                    } else if (colt < 16) {
                        *(f32x4*)(DT + (size_t)row * 16 + colt) = v0; *(f32x4*)(DT + (size_t)row * 16 + colt + 4) = v1;
                    }
                }
            }
    }
};
template <class Epi, class Sched, bool ALIGN_EPI = false, bool SP2 = false>
__device__ __forceinline__ void gemm_phase(PG8_LAS unsigned char* lds, const Gemm g, const Sched& S, const Epi& E) {
    int tid_o = threadIdx.x; asm volatile("" : "+v"(tid_o));
    const int tid = tid_o, wid = __builtin_amdgcn_readfirstlane(tid >> 6), lane = tid & 63, wr = wid >> 2, wc = wid & 3, fr = lane & 15, fq = lane >> 4;
    const int K = g.K, nt = K / BK;
    unsigned voffA[2], voffB[2];
#pragma unroll
    for (int i = 0; i < 2; ++i) { int R, C; stage_rc(tid * 16 + i * 8192, R, C); const int Rb = Epi::PERM ? ((R & ~31) + perm32(R & 31)) : R;
        voffA[i] = (unsigned)(R * K + C) * 2u; voffB[i] = (unsigned)(Rb * K + C) * 2u; }
    const size_t kstep = (size_t)(BK * 2);
    const size_t hstep = (size_t)HALF * K * 2;
    const size_t tstep = 2 * hstep;
    const unsigned ldsw = (unsigned)wid * 1024u;
    const int aoff = lds_byte(wr * 64 + fr, fq * 8), boff = lds_byte(wc * 32 + fr, fq * 8);
#define PG8_SA(b, h) (((b) * 2 + (h)) * HTB)
#define PG8_SB(b, h) ((4 + (b) * 2 + (h)) * HTB)
#define PG8_STAGE(bufoff, gbase, voff) do { _Pragma("unroll") for (int _i = 0; _i < 2; ++_i) \
        __builtin_amdgcn_global_load_lds((const unsigned*)((const char*)(gbase) + (voff)[_i]), (PG8_LAS unsigned*)(lds + (bufoff) + ldsw + _i * 8192), 16, 0, 0); } while (0)
#define PG8_LDA(dst, b, h) do { _Pragma("unroll") for (int m = 0; m < 4; ++m) _Pragma("unroll") for (int k = 0; k < 2; ++k) dst[m][k] = *(const PG8_LAS bf16x8*)(lds + PG8_SA(b, h) + aoff + m * 2048 + k * 1024); } while (0)
#define PG8_LDB(dst, b, h) do { _Pragma("unroll") for (int n = 0; n < 2; ++n) _Pragma("unroll") for (int k = 0; k < 2; ++k) dst[n][k] = *(const PG8_LAS bf16x8*)(lds + PG8_SB(b, h) + boff + n * 2048 + k * 1024); } while (0)
#define PG8_MMA(ai, bj, At, Bt) do { __builtin_amdgcn_s_setprio(1); _Pragma("unroll") for (int m = 0; m < 4; ++m) _Pragma("unroll") for (int n = 0; n < 2; ++n) _Pragma("unroll") for (int k = 0; k < 2; ++k) \
        acc[ai][bj][m][n] = __builtin_amdgcn_mfma_f32_16x16x32_bf16(Bt[n][k], At[m][k], acc[ai][bj][m][n], 0, 0, 0); __builtin_amdgcn_s_setprio(0); } while (0)
#define PG8_WAIT_V(n) asm volatile("s_waitcnt vmcnt(" #n ")" ::: "memory")
#define PG8_WAIT_L(n) asm volatile("s_waitcnt lgkmcnt(" #n ")" ::: "memory")
#define PG8_BAR __builtin_amdgcn_s_barrier()
#define PG8_SCHED __builtin_amdgcn_sched_barrier(0)
    Unit cur, nxt; int ui = 0;
    if (!S.next(0, cur)) return;
    f32x4 acc[2][2][4][2];
#pragma unroll
    for (int a = 0; a < 2; ++a)
#pragma unroll
        for (int b = 0; b < 2; ++b)
#pragma unroll
            for (int m = 0; m < 4; ++m)
#pragma unroll
                for (int n = 0; n < 2; ++n) acc[a][b][m][n] = (f32x4){0.f, 0.f, 0.f, 0.f};
    bf16x8 At[4][2], B0[2][2], B1[2][2];
    const char* cA = (const char*)g.A + (size_t)cur.pm * tstep; const char* cB = (const char*)g.Bt + (size_t)cur.pn * tstep;
    S.a_ready(cur);
    if constexpr (SP2) {
        PG8_STAGE(PG8_SB(0, 0), cB, voffB); PG8_STAGE(PG8_SB(0, 1), cB + hstep, voffB); PG8_STAGE(PG8_SA(0, 0), cA, voffA); PG8_STAGE(PG8_SA(0, 1), cA + hstep, voffA);
        if (wr == 1) PG8_BAR;
        PG8_WAIT_V(2); PG8_BAR;
        PG8_STAGE(PG8_SB(1, 0), cB + kstep, voffB); PG8_STAGE(PG8_SA(1, 0), cA + kstep, voffA); PG8_STAGE(PG8_SB(1, 1), cB + hstep + kstep, voffB);
        PG8_WAIT_V(6); PG8_BAR;
    } else {
        PG8_STAGE(PG8_SB(0, 0), cB, voffB); PG8_STAGE(PG8_SA(0, 0), cA, voffA); PG8_STAGE(PG8_SB(0, 1), cB + hstep, voffB); PG8_STAGE(PG8_SA(0, 1), cA + hstep, voffA);
        if (wr == 1) PG8_BAR;
        PG8_WAIT_V(4); PG8_BAR;
        PG8_STAGE(PG8_SB(1, 0), cB + kstep, voffB); PG8_STAGE(PG8_SA(1, 0), cA + kstep, voffA); PG8_STAGE(PG8_SB(1, 1), cB + hstep + kstep, voffB);
        PG8_WAIT_V(6); PG8_BAR;
    }
    for (;;) {
        const bool has_next = S.next(ui + 1, nxt);
        const char* nA = has_next ? (const char*)g.A + (size_t)nxt.pm * tstep : cA; const char* nB = has_next ? (const char*)g.Bt + (size_t)nxt.pn * tstep : cB;
        for (int t = 0; t < nt; t += 2) {
            const bool last = (t == nt - 2);
            const char* a1 = cA + (size_t)(t + 1) * kstep;
            const char* a2 = last ? nA : cA + (size_t)(t + 2) * kstep; const char* b2 = last ? nB : cB + (size_t)(t + 2) * kstep;
            const char* a3 = a2 + kstep; const char* b3 = b2 + kstep;
            if (last && has_next) S.a_ready(nxt);
            if constexpr (SP2) {
            PG8_LDB(B0, 0, 0); PG8_LDB(B1, 0, 1); PG8_SCHED; PG8_LDA(At, 0, 0); PG8_STAGE(PG8_SA(1, 1), a1 + hstep, voffA);
            PG8_WAIT_V(8); PG8_WAIT_L(0); PG8_BAR; PG8_MMA(0, 0, At, B0); PG8_MMA(0, 1, At, B1); PG8_BAR; PG8_SCHED;
            PG8_LDA(At, 0, 1); PG8_STAGE(PG8_SB(0, 0), b2, voffB); PG8_STAGE(PG8_SB(0, 1), b2 + hstep, voffB); PG8_STAGE(PG8_SA(0, 0), a2, voffA);
            PG8_WAIT_V(8); PG8_WAIT_L(0); PG8_BAR; PG8_MMA(1, 0, At, B0); PG8_MMA(1, 1, At, B1); PG8_BAR; PG8_SCHED;
            PG8_LDB(B0, 1, 0); PG8_LDB(B1, 1, 1); PG8_SCHED; PG8_LDA(At, 1, 0); PG8_STAGE(PG8_SA(0, 1), a2 + hstep, voffA);
            PG8_WAIT_V(8); PG8_WAIT_L(0); PG8_BAR; PG8_MMA(0, 0, At, B0); PG8_MMA(0, 1, At, B1); PG8_BAR; PG8_SCHED;
            PG8_LDA(At, 1, 1); PG8_STAGE(PG8_SB(1, 0), b3, voffB); PG8_STAGE(PG8_SB(1, 1), b3 + hstep, voffB); PG8_STAGE(PG8_SA(1, 0), a3, voffA);
            PG8_WAIT_V(8); PG8_WAIT_L(0); PG8_BAR; PG8_MMA(1, 0, At, B0); PG8_MMA(1, 1, At, B1); PG8_BAR; PG8_SCHED;
            } else {
            PG8_LDB(B0, 0, 0); PG8_SCHED; PG8_LDA(At, 0, 0); PG8_STAGE(PG8_SA(1, 1), a1 + hstep, voffA);
            PG8_WAIT_L(8); PG8_BAR; PG8_WAIT_L(0); PG8_MMA(0, 0, At, B0); PG8_BAR; PG8_SCHED;
            PG8_LDB(B1, 0, 1); PG8_STAGE(PG8_SB(0, 0), b2, voffB);
            PG8_BAR; PG8_WAIT_L(0); PG8_MMA(0, 1, At, B1); PG8_BAR;
            PG8_LDA(At, 0, 1); PG8_STAGE(PG8_SA(0, 0), a2, voffA);
            PG8_BAR; PG8_WAIT_L(0); PG8_MMA(1, 0, At, B0); PG8_BAR; PG8_SCHED;
            PG8_STAGE(PG8_SB(0, 1), b2 + hstep, voffB);
            PG8_WAIT_V(6); PG8_BAR; PG8_MMA(1, 1, At, B1); PG8_BAR;
            PG8_LDB(B0, 1, 0); PG8_SCHED; PG8_LDA(At, 1, 0); PG8_STAGE(PG8_SA(0, 1), a2 + hstep, voffA);
            PG8_WAIT_L(8); PG8_BAR; PG8_WAIT_L(0); PG8_MMA(0, 0, At, B0); PG8_BAR; PG8_SCHED;
            PG8_LDB(B1, 1, 1); PG8_STAGE(PG8_SB(1, 0), b3, voffB);
            PG8_BAR; PG8_WAIT_L(0); PG8_MMA(0, 1, At, B1); PG8_BAR;
            PG8_LDA(At, 1, 1); PG8_STAGE(PG8_SA(1, 0), a3, voffA);
            PG8_BAR; PG8_WAIT_L(0); PG8_MMA(1, 0, At, B0); PG8_BAR; PG8_SCHED;
            PG8_STAGE(PG8_SB(1, 1), b3 + hstep, voffB);
            PG8_WAIT_V(6); PG8_BAR; PG8_MMA(1, 1, At, B1); PG8_BAR;
            }
        }
        if constexpr (ALIGN_EPI) { if (wr == 0) PG8_BAR; }
        if constexpr (!Epi::AFTER_DRAIN) { E(acc, cur, wr, wc, fr, fq); S.done(cur); }
        if (!has_next) break;
#pragma unroll
        for (int a = 0; a < 2; ++a)
#pragma unroll
            for (int b = 0; b < 2; ++b)
#pragma unroll
                for (int m = 0; m < 4; ++m)
#pragma unroll
                    for (int n = 0; n < 2; ++n) acc[a][b][m][n] = (f32x4){0.f, 0.f, 0.f, 0.f};
        cur = nxt; cA = nA; cB = nB; ++ui;
        if constexpr (ALIGN_EPI) { if (wr == 1) PG8_BAR; }
    }
    PG8_WAIT_V(0);
    if constexpr (!ALIGN_EPI) { if (wr == 0) PG8_BAR; }
    PG8_BAR;
    if constexpr (Epi::AFTER_DRAIN) { E.fused(acc, cur, wr, wc, fr, fq, lds, wid, lane); S.done(cur); }
#undef PG8_SA
#undef PG8_SB
#undef PG8_STAGE
#undef PG8_LDA
#undef PG8_LDB
#undef PG8_MMA
#undef PG8_WAIT_V
#undef PG8_WAIT_L
#undef PG8_BAR
#undef PG8_SCHED
}
}

#define LAS __attribute__((address_space(3)))
typedef unsigned short bf16;
typedef unsigned u32x4 __attribute__((ext_vector_type(4)));
typedef unsigned u32x2 __attribute__((ext_vector_type(2)));
typedef float f32x4 __attribute__((ext_vector_type(4)));
typedef short bf16x8 __attribute__((ext_vector_type(8)));

constexpr int NT = 512;
constexpr int M_TOK = 16384, SEQ = 8192, DM = 2048, DFF = 5632, NGU = 11264, NIN = 6672, NINP = 6912, PLD = 6672;
constexpr float LN_EPS = 1e-5f;
constexpr float ALPHA = 1.189207115002721f;
constexpr size_t MiB = (size_t)1 << 20;
constexpr size_t WS_RETS = 0, WS_SSDS = 128 * MiB, WS_WGU = 0, WS_WD = 44 * MiB, WS_WIN = 66 * MiB, WS_COS = 93 * MiB, WS_SIN = 101 * MiB,
                 WS_WOUT = 192 * MiB, WS_XB = 200 * MiB, WS_BIG = 264 * MiB, WS_DT = 473 * MiB, WS_TOT = 474 * MiB, WS_CTL = 475 * MiB, WS_END = 476 * MiB;
constexpr size_t CTL_ZERO_BYTES = 65536;
constexpr int MISC_OFF = 152064;
constexpr int LDS_BYTES = 153600;

__device__ __forceinline__ float lo16(unsigned w) { return __uint_as_float(w << 16); }
__device__ __forceinline__ float hi16(unsigned w) { return __uint_as_float(w & 0xffff0000u); }
__device__ __forceinline__ float bf2f(bf16 h) { return __uint_as_float((unsigned)h << 16); }
__device__ __forceinline__ bf16 f2bf(float f) { unsigned u = __float_as_uint(f); return (bf16)((u + 0x7fffu + ((u >> 16) & 1u)) >> 16); }
__device__ __forceinline__ unsigned pk2(float a, float b) { return pg8::cvt_pk_bf16(a, b); }
__device__ __forceinline__ float wave_sum(float v) {
#pragma unroll
    for (int o = 1; o < 64; o <<= 1) v += __shfl_xor(v, o);
    return v;
}
__device__ __forceinline__ float silu_f(float x) { return x * __builtin_amdgcn_rcpf(1.0f + __expf(-x)); }
__device__ __forceinline__ f32x4 mma(bf16x8 y, bf16x8 x, f32x4 c) { return __builtin_amdgcn_mfma_f32_16x16x32_bf16(y, x, c, 0, 0, 0); }
__device__ __forceinline__ unsigned opaque0() { unsigned z; asm volatile("s_mov_b32 %0, 0" : "=s"(z)); return z; }
#define LDS_WAIT() asm volatile("s_waitcnt lgkmcnt(0)" ::: "memory")
#define FRAG(p) (*(const LAS bf16x8*)(p))

__device__ __forceinline__ void xpose_item(const float* W, int Nsrc, int K, bf16* WT, int k0, int n0, int drow0, LAS float* scr, int lane) {
    const int nn = n0 + (lane & 31);
#pragma unroll 8
    for (int i = 0; i < 32; ++i) { const int kk = 2 * i + (lane >> 5); scr[kk * 33 + (lane & 31)] = nn < Nsrc ? W[(size_t)(k0 + kk) * Nsrc + nn] : 0.0f; }
    LDS_WAIT();
    const int c = lane & 7;
#pragma unroll
    for (int j = 0; j < 4; ++j) { const int n = (lane >> 3) + 8 * j; const LAS float* s = scr + (8 * c) * 33 + n;
        u32x4 o; o.x = pk2(s[0 * 33], s[1 * 33]); o.y = pk2(s[2 * 33], s[3 * 33]); o.z = pk2(s[4 * 33], s[5 * 33]); o.w = pk2(s[6 * 33], s[7 * 33]);
        *(u32x4*)(WT + (size_t)(drow0 + n) * K + k0 + 8 * c) = o; }
    LDS_WAIT();
}
__device__ __forceinline__ void convert_ffn(const float* wg, const float* wu, const float* wd, bf16* WGU, bf16* WD, LAS float* scr, int gw, int NGW, int lane) {
    for (int it = gw; it < 3 * 5632; it += NGW) {
        int r = it;
        if (r < 2 * 5632) { const int up = r >= 5632 ? 1 : 0; r -= up * 5632; const int kb = r / 176, nb = r % 176, n0 = nb * 32;
            xpose_item(up ? wu : wg, DFF, DM, WGU, kb * 64, n0, 256 * (n0 >> 7) + (n0 & 127) + up * 128, scr, lane); }
        else { r -= 2 * 5632; const int kb = r / 64, nb = r % 64; xpose_item(wd, DM, DFF, WD, kb * 64, nb * 32, nb * 32, scr, lane); }
    }
}
template <bool WBF>
__device__ __forceinline__ void ln_rows(float* io, const float* gain, const float* bias, bf16* xb, int gw, int NGW, int lane) {
    for (int row = gw; row < M_TOK; row += NGW) {
        f32x4* p = (f32x4*)(io + (size_t)row * DM) + lane;
        f32x4 v[8]; float s = 0.f;
#pragma unroll
        for (int j = 0; j < 8; ++j) { v[j] = p[64 * j]; s += (v[j][0] + v[j][1]) + (v[j][2] + v[j][3]); }
        const float mean = wave_sum(s) * (1.0f / DM); float s2 = 0.f;
#pragma unroll
        for (int j = 0; j < 8; ++j) { v[j] = v[j] - mean; s2 += (v[j][0] * v[j][0] + v[j][1] * v[j][1]) + (v[j][2] * v[j][2] + v[j][3] * v[j][3]); }
        const float rstd = 1.0f / sqrtf(wave_sum(s2) * (1.0f / DM) + LN_EPS);
#pragma unroll
        for (int j = 0; j < 8; ++j) {
            const f32x4 g = ((const f32x4*)gain)[lane + 64 * j], b = ((const f32x4*)bias)[lane + 64 * j];
            const f32x4 o = v[j] * rstd * g + b;
            p[64 * j] = o;
            if (WBF) { u32x2 w; w.x = pk2(o[0], o[1]); w.y = pk2(o[2], o[3]); ((u32x2*)(xb + (size_t)row * DM))[lane + 64 * j] = w; }
        }
    }
}

__device__ __forceinline__ void conv8(const bf16* PROJ, const float* cw, const float* cb, size_t tokrow, int t, int ch, f32x4& a0, f32x4& a1) {
    a0 = *(const f32x4*)(cb + ch); a1 = *(const f32x4*)(cb + ch + 4);
#pragma unroll
    for (int k = 0; k < 4; ++k) {
        if (t - 3 + k >= 0) {
            const u32x4 raw = *(const u32x4*)(PROJ + (tokrow - 3 + k) * PLD + 5120 + ch);
            const f32x4 w0 = *(const f32x4*)(cw + k * 1536 + ch), w1 = *(const f32x4*)(cw + k * 1536 + ch + 4);
            a0[0] += w0[0] * lo16(raw.x); a0[1] += w0[1] * hi16(raw.x); a0[2] += w0[2] * lo16(raw.y); a0[3] += w0[3] * hi16(raw.y);
            a1[0] += w1[0] * lo16(raw.z); a1[1] += w1[1] * hi16(raw.z); a1[2] += w1[2] * lo16(raw.w); a1[3] += w1[3] * hi16(raw.w);
        }
    }
#pragma unroll
    for (int i = 0; i < 4; ++i) { a0[i] = silu_f(a0[i]); a1[i] = silu_f(a1[i]); }
}
__device__ __forceinline__ void dt_acum(const float* DT, const float* dt_bias, const float* a_log, size_t tok0, int head, int lane, float& dt, float& ac) {
    const float x = DT[(tok0 + lane) * 16 + head] + dt_bias[head];
    dt = x > 20.0f ? x : log1pf(expf(x));
    float s = dt * (-expf(a_log[head]));
#pragma unroll
    for (int o = 1; o < 64; o <<= 1) { const float t = __shfl_up(s, o); if (lane >= o) s += t; }
    ac = s;
}

__device__ __forceinline__ void ret_a_unit(LAS unsigned char* lds, const bf16* PROJ, bf16* RETS, int b, int z, int h, int tid) {
    const int wave = tid >> 6, lane = tid & 63, l15 = lane & 15, l4 = lane >> 4;
    const size_t tok0 = (size_t)b * SEQ + (size_t)z * 64;
    const float lg2 = log2f(1.0f - exp2f(-5.0f - (float)h));
    LAS bf16* Kt = (LAS bf16*)lds;
    LAS bf16* Vt = (LAS bf16*)(lds + 36864);
#pragma unroll 2
    for (int it = 0; it < 8; ++it) {
        const int q = it * NT + tid, j = q & 63, ch = (q >> 6) & 31, mat = q >> 11;
        const u32x4 raw = *(const u32x4*)(PROJ + (tok0 + j) * PLD + (mat ? 2048 : 1024) + h * 256 + ch * 8);
        const float sc = mat ? 1.0f : exp2f(lg2 * (float)(63 - j));
#ifdef DBG_RAW
        ((u32x4*)(RETS + (size_t)200 * 1024 * 1024 / 2))[(size_t)((b * 128 + z) * 4 + h) * 4096 + q] = raw;
#endif
        LAS bf16* dst = (mat ? Vt : Kt) + (ch * 8) * 72 + j;
        dst[0 * 72] = f2bf(lo16(raw.x) * sc); dst[1 * 72] = f2bf(hi16(raw.x) * sc); dst[2 * 72] = f2bf(lo16(raw.y) * sc); dst[3 * 72] = f2bf(hi16(raw.y) * sc);
        dst[4 * 72] = f2bf(lo16(raw.z) * sc); dst[5 * 72] = f2bf(hi16(raw.z) * sc); dst[6 * 72] = f2bf(lo16(raw.w) * sc); dst[7 * 72] = f2bf(hi16(raw.w) * sc);
    }
    __syncthreads();
#ifdef DBG_LDS
#define DBG_CHECK(slot) { int bad = 0; \
    for (int it = 0; it < 8; ++it) { const int q = it * NT + tid, j = q & 63, ch = (q >> 6) & 31, mat = q >> 11; \
        const u32x4 raw = *(const u32x4*)(PROJ + (tok0 + j) * PLD + (mat ? 2048 : 1024) + h * 256 + ch * 8); \
        const float sc = mat ? 1.0f : exp2f(lg2 * (float)(63 - j)); \
        volatile LAS bf16* dst = (mat ? Vt : Kt) + (ch * 8) * 72 + j; \
        bad += (dst[0 * 72] != f2bf(lo16(raw.x) * sc)) + (dst[1 * 72] != f2bf(hi16(raw.x) * sc)) + (dst[2 * 72] != f2bf(lo16(raw.y) * sc)) + (dst[3 * 72] != f2bf(hi16(raw.y) * sc)) \
             + (dst[4 * 72] != f2bf(lo16(raw.z) * sc)) + (dst[5 * 72] != f2bf(hi16(raw.z) * sc)) + (dst[6 * 72] != f2bf(lo16(raw.w) * sc)) + (dst[7 * 72] != f2bf(hi16(raw.w) * sc)); } \
    (RETS + (size_t)200 * 1024 * 1024 / 2)[(size_t)((b * 128 + z) * 4 + h) * 1024 + (slot) * 512 + tid] = f2bf(1000.0f * (float)bad); }
    DBG_CHECK(0)
#endif
    bf16* out = RETS + ((size_t)((b * 4 + h) * 128 + z)) * 65536;
#pragma unroll 1
    for (int dh = 0; dh < 2; ++dh) {
        f32x4 acc[2][8];
#pragma unroll
        for (int mt = 0; mt < 2; ++mt)
#pragma unroll
            for (int nt = 0; nt < 8; ++nt) acc[mt][nt] = (f32x4){0.f, 0.f, 0.f, 0.f};
#pragma unroll
        for (int ks = 0; ks < 2; ++ks) {
            bf16x8 xa[2];
#pragma unroll
            for (int mt = 0; mt < 2; ++mt) xa[mt] = FRAG(Vt + (32 * wave + 16 * mt + l15) * 72 + ks * 32 + 8 * l4);
#pragma unroll
            for (int nt = 0; nt < 8; ++nt) { const bf16x8 yb = FRAG(Kt + (128 * dh + 16 * nt + l15) * 72 + ks * 32 + 8 * l4);
#pragma unroll
                for (int mt = 0; mt < 2; ++mt) acc[mt][nt] = mma(yb, xa[mt], acc[mt][nt]); }
        }
#pragma unroll
        for (int mt = 0; mt < 2; ++mt)
#pragma unroll
            for (int nt = 0; nt < 8; ++nt) { const int e = 32 * wave + 16 * mt + l15, d = 128 * dh + 16 * nt + 4 * l4;
                u32x2 w; w.x = pk2(acc[mt][nt][0], acc[mt][nt][1]); w.y = pk2(acc[mt][nt][2], acc[mt][nt][3]); *(u32x2*)(out + e * 256 + d) = w; }
    }
#ifdef DBG_LDS
    DBG_CHECK(1)
#endif
    __syncthreads();
}

__device__ __forceinline__ void ssd_a_unit(LAS unsigned char* lds, const bf16* PROJ, const float* DT, const float* cw, const float* cb, const float* dt_bias, const float* a_log,
                                           bf16* SSDS, float* TOT, int b, int z, int g, int tid) {
    const int wave = tid >> 6, lane = tid & 63, l15 = lane & 15, l4 = lane >> 4;
    const size_t tok0 = (size_t)b * SEQ + (size_t)z * 64;
    LAS bf16* Bt = (LAS bf16*)lds;
    LAS bf16* Xt = (LAS bf16*)(lds + 18432);
    LAS float* coef = (LAS float*)(lds + 92160);
    { float dt, ac; dt_acum(DT, dt_bias, a_log, tok0, g * 8 + wave, lane, dt, ac); const float last = __shfl(ac, 63);
      coef[wave * 64 + lane] = dt * expf(last - ac); if (lane == 63) TOT[(size_t)(b * 128 + z) * 16 + g * 8 + wave] = expf(last); }
    __syncthreads();
#pragma unroll 1
    for (int it = 0; it < 2; ++it) {
        const int q = it * NT + tid, j = q & 63, ch = q >> 6; f32x4 a0, a1;
        conv8(PROJ, cw, cb, tok0 + j, z * 64 + j, 1024 + g * 128 + ch * 8, a0, a1);
        LAS bf16* dst = Bt + (ch * 8) * 72 + j;
        dst[0 * 72] = f2bf(a0[0]); dst[1 * 72] = f2bf(a0[1]); dst[2 * 72] = f2bf(a0[2]); dst[3 * 72] = f2bf(a0[3]);
        dst[4 * 72] = f2bf(a1[0]); dst[5 * 72] = f2bf(a1[1]); dst[6 * 72] = f2bf(a1[2]); dst[7 * 72] = f2bf(a1[3]);
    }
#pragma unroll 1
    for (int it = 0; it < 8; ++it) {
        const int q = it * NT + tid, j = q & 63, ch = q >> 6; f32x4 a0, a1;
        conv8(PROJ, cw, cb, tok0 + j, z * 64 + j, g * 512 + ch * 8, a0, a1);
        const float c = coef[(ch >> 3) * 64 + j];
        LAS bf16* dst = Xt + (ch * 8) * 72 + j;
        dst[0 * 72] = f2bf(a0[0] * c); dst[1 * 72] = f2bf(a0[1] * c); dst[2 * 72] = f2bf(a0[2] * c); dst[3 * 72] = f2bf(a0[3] * c);
        dst[4 * 72] = f2bf(a1[0] * c); dst[5 * 72] = f2bf(a1[1] * c); dst[6 * 72] = f2bf(a1[2] * c); dst[7 * 72] = f2bf(a1[3] * c);
    }
    __syncthreads();
    bf16* out = SSDS + ((size_t)((b * 16 + g * 8 + wave) * 128 + z)) * 8192;
#pragma unroll 1
    for (int nh = 0; nh < 2; ++nh) {
        f32x4 acc[4][4];
#pragma unroll
        for (int mt = 0; mt < 4; ++mt)
#pragma unroll
            for (int nt = 0; nt < 4; ++nt) acc[mt][nt] = (f32x4){0.f, 0.f, 0.f, 0.f};
#pragma unroll
        for (int ks = 0; ks < 2; ++ks) {
            bf16x8 xa[4];
#pragma unroll
            for (int mt = 0; mt < 4; ++mt) xa[mt] = FRAG(Xt + (64 * wave + 16 * mt + l15) * 72 + ks * 32 + 8 * l4);
#pragma unroll
            for (int nt = 0; nt < 4; ++nt) { const bf16x8 yb = FRAG(Bt + (64 * nh + 16 * nt + l15) * 72 + ks * 32 + 8 * l4);
#pragma unroll
                for (int mt = 0; mt < 4; ++mt) acc[mt][nt] = mma(yb, xa[mt], acc[mt][nt]); }
        }
#pragma unroll
        for (int mt = 0; mt < 4; ++mt)
#pragma unroll
            for (int nt = 0; nt < 4; ++nt) { const int p = 16 * mt + l15, n = 64 * nh + 16 * nt + 4 * l4;
                u32x2 w; w.x = pk2(acc[mt][nt][0], acc[mt][nt][1]); w.y = pk2(acc[mt][nt][2], acc[mt][nt][3]); *(u32x2*)(out + p * 128 + n) = w; }
    }
    __syncthreads();
}

__device__ __forceinline__ void scan_phase(bf16* RETS, bf16* SSDS, const float* TOT, int gtid, int nth) {
    for (int task = gtid; task < 98304; task += nth) {
        bf16* base; size_t stride; float cdec = 0.f; const float* totp = nullptr;
        if (task < 65536) { const int bh = task >> 13, e8 = task & 8191; base = RETS + (size_t)bh * 128 * 65536 + (size_t)e8 * 8; stride = 65536;
            cdec = exp2f(64.0f * log2f(1.0f - exp2f(-5.0f - (float)(bh & 3)))); }
        else { const int t2 = task - 65536, bhd = t2 >> 10, e8 = t2 & 1023; base = SSDS + (size_t)bhd * 128 * 8192 + (size_t)e8 * 8; stride = 8192;
            totp = TOT + (size_t)(bhd >> 4) * 128 * 16 + (bhd & 15); }
        float s0 = 0.f, s1 = 0.f, s2 = 0.f, s3 = 0.f, s4 = 0.f, s5 = 0.f, s6 = 0.f, s7 = 0.f;
#pragma unroll 1
        for (int z0 = 0; z0 < 128; z0 += 8) {
            u32x4 v[8]; float dec[8];
#pragma unroll
            for (int i = 0; i < 8; ++i) { v[i] = *(const u32x4*)(base + (size_t)(z0 + i) * stride); dec[i] = totp ? totp[(z0 + i) * 16] : cdec; }
#pragma unroll
            for (int i = 0; i < 8; ++i) {
                u32x4 o; o.x = pk2(s0, s1); o.y = pk2(s2, s3); o.z = pk2(s4, s5); o.w = pk2(s6, s7);
                *(u32x4*)(base + (size_t)(z0 + i) * stride) = o;
                const float d = dec[i];
                s0 = s0 * d + lo16(v[i].x); s1 = s1 * d + hi16(v[i].x); s2 = s2 * d + lo16(v[i].y); s3 = s3 * d + hi16(v[i].y);
                s4 = s4 * d + lo16(v[i].z); s5 = s5 * d + hi16(v[i].z); s6 = s6 * d + lo16(v[i].w); s7 = s7 * d + hi16(v[i].w);
            }
        }
    }
}

__device__ __forceinline__ void ret_c_unit(LAS unsigned char* lds, const bf16* PROJ, const bf16* RETS, const float* gn_g, const float* gn_b, bf16* MIX, int b, int z, int h, int tid) {
    const int wave = tid >> 6, lane = tid & 63, l15 = lane & 15, l4 = lane >> 4;
    const size_t tok0 = (size_t)b * SEQ + (size_t)z * 64;
    const float lg2 = log2f(1.0f - exp2f(-5.0f - (float)h));
    LAS bf16* Q = (LAS bf16*)lds;
    LAS bf16* Kn = (LAS bf16*)(lds + 33792);
    LAS bf16* Vt = (LAS bf16*)(lds + 67584);
    LAS bf16* Pm = (LAS bf16*)(lds + 104448);
    LAS float* st1 = (LAS float*)(lds + 113664);
    LAS float* st2 = (LAS float*)(lds + 115712);
#pragma unroll 2
    for (int it = 0; it < 8; ++it) {
        const int q = it * NT + tid, ch = q & 31, j = (q >> 5) & 63, mat = q >> 11;
        const u32x4 raw = *(const u32x4*)(PROJ + (tok0 + j) * PLD + mat * 1024 + h * 256 + ch * 8);
        *(LAS u32x4*)((mat ? Kn : Q) + j * 264 + ch * 8) = raw;
    }
#pragma unroll 2
    for (int it = 0; it < 4; ++it) {
        const int q = it * NT + tid, j = q & 63, ch = q >> 6;
        const u32x4 raw = *(const u32x4*)(PROJ + (tok0 + j) * PLD + 2048 + h * 256 + ch * 8);
        LAS bf16* dst = Vt + (ch * 8) * 72 + j;
        dst[0 * 72] = (bf16)(raw.x & 0xffffu); dst[1 * 72] = (bf16)(raw.x >> 16); dst[2 * 72] = (bf16)(raw.y & 0xffffu); dst[3 * 72] = (bf16)(raw.y >> 16);
        dst[4 * 72] = (bf16)(raw.z & 0xffffu); dst[5 * 72] = (bf16)(raw.z >> 16); dst[6 * 72] = (bf16)(raw.w & 0xffffu); dst[7 * 72] = (bf16)(raw.w >> 16);
    }
    __syncthreads();
    {
        const int mt = wave >> 1, nt0 = 2 * (wave & 1);
        f32x4 sc[2] = {(f32x4){0.f, 0.f, 0.f, 0.f}, (f32x4){0.f, 0.f, 0.f, 0.f}};
#pragma unroll
        for (int ks = 0; ks < 8; ++ks) {
            const bf16x8 xa = FRAG(Q + (16 * mt + l15) * 264 + ks * 32 + 8 * l4);
#pragma unroll
            for (int n2 = 0; n2 < 2; ++n2) { const bf16x8 yb = FRAG(Kn + (16 * (nt0 + n2) + l15) * 264 + ks * 32 + 8 * l4); sc[n2] = mma(yb, xa, sc[n2]); }
        }
#pragma unroll
        for (int n2 = 0; n2 < 2; ++n2) {
            const int i = 16 * mt + l15 + (int)opaque0(), j0 = 16 * (nt0 + n2) + 4 * l4; float p[4];
#pragma unroll
            for (int ii = 0; ii < 4; ++ii) { const int j = j0 + ii; p[ii] = (j <= i) ? sc[n2][ii] * exp2f(lg2 * (float)(i - j)) : 0.0f; }
            u32x2 w; w.x = pk2(p[0], p[1]); w.y = pk2(p[2], p[3]); *(LAS u32x2*)(Pm + i * 72 + j0) = w;
        }
    }
    __syncthreads();
    f32x4 acc[4][2];
#pragma unroll
    for (int mt = 0; mt < 4; ++mt)
#pragma unroll
        for (int nt = 0; nt < 2; ++nt) acc[mt][nt] = (f32x4){0.f, 0.f, 0.f, 0.f};
    const bf16* S = RETS + ((size_t)((b * 4 + h) * 128 + z)) * 65536;
#pragma unroll
    for (int ks = 0; ks < 8; ++ks) {
        bf16x8 yb[2];
#pragma unroll
        for (int nt = 0; nt < 2; ++nt) yb[nt] = *(const bf16x8*)(S + (32 * wave + 16 * nt + l15) * 256 + ks * 32 + 8 * l4);
#pragma unroll
        for (int mt = 0; mt < 4; ++mt) { const bf16x8 xa = FRAG(Q + (16 * mt + l15) * 264 + ks * 32 + 8 * l4);
#pragma unroll
            for (int nt = 0; nt < 2; ++nt) acc[mt][nt] = mma(yb[nt], xa, acc[mt][nt]); }
    }
#pragma unroll
    for (int mt = 0; mt < 4; ++mt) { const float qd = exp2f(lg2 * (float)(16 * mt + l15 + 1));
#pragma unroll
        for (int nt = 0; nt < 2; ++nt) acc[mt][nt] = acc[mt][nt] * qd; }
#pragma unroll
    for (int ks = 0; ks < 2; ++ks) {
        bf16x8 yb[2];
#pragma unroll
        for (int nt = 0; nt < 2; ++nt) yb[nt] = FRAG(Vt + (32 * wave + 16 * nt + l15) * 72 + ks * 32 + 8 * l4);
#pragma unroll
        for (int mt = 0; mt < 4; ++mt) { const bf16x8 xa = FRAG(Pm + (16 * mt + l15) * 72 + ks * 32 + 8 * l4);
#pragma unroll
            for (int nt = 0; nt < 2; ++nt) acc[mt][nt] = mma(yb[nt], xa, acc[mt][nt]); }
    }
#pragma unroll
    for (int mt = 0; mt < 4; ++mt) {
        float s = 0.f;
#pragma unroll
        for (int nt = 0; nt < 2; ++nt) s += (acc[mt][nt][0] + acc[mt][nt][1]) + (acc[mt][nt][2] + acc[mt][nt][3]);
        s += __shfl_xor(s, 16); s += __shfl_xor(s, 32);
        if (l4 == 0) st1[wave * 64 + 16 * mt + l15] = s;
    }
    __syncthreads();
    float mean[4];
#pragma unroll
    for (int mt = 0; mt < 4; ++mt) { float m = 0.f;
#pragma unroll
        for (int w = 0; w < 8; ++w) m += st1[w * 64 + 16 * mt + l15];
        mean[mt] = m * (1.0f / 256.0f);
        float s = 0.f;
#pragma unroll
        for (int nt = 0; nt < 2; ++nt) { acc[mt][nt] = acc[mt][nt] - mean[mt]; s += (acc[mt][nt][0] * acc[mt][nt][0] + acc[mt][nt][1] * acc[mt][nt][1]) + (acc[mt][nt][2] * acc[mt][nt][2] + acc[mt][nt][3] * acc[mt][nt][3]); }
        s += __shfl_xor(s, 16); s += __shfl_xor(s, 32);
        if (l4 == 0) st2[wave * 64 + 16 * mt + l15] = s;
    }
    __syncthreads();
#pragma unroll
    for (int mt = 0; mt < 4; ++mt) { float q = 0.f; const int i = 16 * mt + l15;
#pragma unroll
        for (int w = 0; w < 8; ++w) q += st2[w * 64 + i];
        const float rstd = 1.0f / sqrtf(q * (1.0f / 256.0f) + LN_EPS);
#pragma unroll
        for (int nt = 0; nt < 2; ++nt) {
            const int col = h * 256 + 32 * wave + 16 * nt + 4 * l4;
            const f32x4 gg = *(const f32x4*)(gn_g + col), bb = *(const f32x4*)(gn_b + col);
            const u32x2 graw = *(const u32x2*)(PROJ + (tok0 + i) * PLD + 3072 + col);
            const f32x4 o = acc[mt][nt] * rstd * gg + bb;
            u32x2 w; w.x = pk2(o[0] * silu_f(lo16(graw.x)), o[1] * silu_f(hi16(graw.x))); w.y = pk2(o[2] * silu_f(lo16(graw.y)), o[3] * silu_f(hi16(graw.y)));
            *(u32x2*)(MIX + (tok0 + i) * DM + col) = w;
        }
    }
    __syncthreads();
}

__device__ __forceinline__ void ssd_c_unit(LAS unsigned char* lds, const bf16* PROJ, const float* DT, const float* cw, const float* cb, const float* dt_bias, const float* a_log,
                                           const float* dskip, const float* ngain, const bf16* SSDS, bf16* MIX, int b, int z, int g, int tid) {
    const int wave = tid >> 6, lane = tid & 63, l15 = lane & 15, l4 = lane >> 4;
    const size_t tok0 = (size_t)b * SEQ + (size_t)z * 64;
    LAS bf16* Cm = (LAS bf16*)lds;
    LAS bf16* Bm = (LAS bf16*)(lds + 17408);
    LAS bf16* Xt = (LAS bf16*)(lds + 34816);
    LAS float* CB = (LAS float*)(lds + 108544);
    LAS float* dts = (LAS float*)(lds + 125184);
    LAS float* acs = (LAS float*)(lds + 127232);
    LAS bf16* Lw = (LAS bf16*)(lds + 129280 + wave * 2304);
    LAS float* ssq = (LAS float*)(lds + 147712);
    { float dt, ac; dt_acum(DT, dt_bias, a_log, tok0, g * 8 + wave, lane, dt, ac); dts[wave * 64 + lane] = dt; acs[wave * 64 + lane] = ac; }
    __syncthreads();
#pragma unroll 1
    for (int it = 0; it < 4; ++it) {
        const int q = it * NT + tid, ch = q & 15, j = (q >> 4) & 63, mat = q >> 10; f32x4 a0, a1;
        conv8(PROJ, cw, cb, tok0 + j, z * 64 + j, 1024 + mat * 256 + g * 128 + ch * 8, a0, a1);
        u32x4 w; w.x = pk2(a0[0], a0[1]); w.y = pk2(a0[2], a0[3]); w.z = pk2(a1[0], a1[1]); w.w = pk2(a1[2], a1[3]);
        *(LAS u32x4*)((mat ? Cm : Bm) + j * 136 + ch * 8) = w;
    }
#pragma unroll 1
    for (int it = 0; it < 8; ++it) {
        const int q = it * NT + tid, j = q & 63, ch = q >> 6; f32x4 a0, a1;
        conv8(PROJ, cw, cb, tok0 + j, z * 64 + j, g * 512 + ch * 8, a0, a1);
        const float c = dts[(ch >> 3) * 64 + j];
        LAS bf16* dst = Xt + (ch * 8) * 72 + j;
        dst[0 * 72] = f2bf(a0[0] * c); dst[1 * 72] = f2bf(a0[1] * c); dst[2 * 72] = f2bf(a0[2] * c); dst[3 * 72] = f2bf(a0[3] * c);
        dst[4 * 72] = f2bf(a1[0] * c); dst[5 * 72] = f2bf(a1[1] * c); dst[6 * 72] = f2bf(a1[2] * c); dst[7 * 72] = f2bf(a1[3] * c);
    }
    __syncthreads();
    {
        const int mt = wave >> 1, nt0 = 2 * (wave & 1);
        f32x4 sc[2] = {(f32x4){0.f, 0.f, 0.f, 0.f}, (f32x4){0.f, 0.f, 0.f, 0.f}};
#pragma unroll
        for (int ks = 0; ks < 4; ++ks) {
            const bf16x8 xa = FRAG(Cm + (16 * mt + l15) * 136 + ks * 32 + 8 * l4);
#pragma unroll
            for (int n2 = 0; n2 < 2; ++n2) { const bf16x8 yb = FRAG(Bm + (16 * (nt0 + n2) + l15) * 136 + ks * 32 + 8 * l4); sc[n2] = mma(yb, xa, sc[n2]); }
        }
#pragma unroll
        for (int n2 = 0; n2 < 2; ++n2) { const int i = 16 * mt + l15, j0 = 16 * (nt0 + n2) + 4 * l4;
#pragma unroll
            for (int ii = 0; ii < 4; ++ii) CB[i * 65 + j0 + ii] = sc[n2][ii]; }
    }
    __syncthreads();
    const int r = wave, head = g * 8 + r;
    f32x4 acc[4][4];
#pragma unroll
    for (int mt = 0; mt < 4; ++mt)
#pragma unroll
        for (int nt = 0; nt < 4; ++nt) acc[mt][nt] = (f32x4){0.f, 0.f, 0.f, 0.f};
    const bf16* S = SSDS + ((size_t)((b * 16 + head) * 128 + z)) * 8192;
#pragma unroll
    for (int ks = 0; ks < 4; ++ks) {
        bf16x8 yb[4];
#pragma unroll
        for (int nt = 0; nt < 4; ++nt) yb[nt] = *(const bf16x8*)(S + (16 * nt + l15) * 128 + ks * 32 + 8 * l4);
#pragma unroll
        for (int mt = 0; mt < 4; ++mt) { const bf16x8 xa = FRAG(Cm + (16 * mt + l15) * 136 + ks * 32 + 8 * l4);
#pragma unroll
            for (int nt = 0; nt < 4; ++nt) acc[mt][nt] = mma(yb[nt], xa, acc[mt][nt]); }
    }
#pragma unroll
    for (int mt = 0; mt < 4; ++mt) { const float fs = expf(acs[r * 64 + 16 * mt + l15]);
#pragma unroll
        for (int nt = 0; nt < 4; ++nt) acc[mt][nt] = acc[mt][nt] * fs; }
#pragma unroll
    for (int mt = 0; mt < 4; ++mt) {
        const int i = 16 * mt + l15 + (int)opaque0(); const float ai = acs[r * 64 + i];
#pragma unroll
        for (int hh = 0; hh < 2; ++hh) {
            float lv[8];
#pragma unroll
            for (int k = 0; k < 8; ++k) { const int j = 16 * l4 + 8 * hh + k; const float e = expf(ai - acs[r * 64 + j]); lv[k] = (j <= i) ? CB[i * 65 + j] * e : 0.0f; }
            u32x4 w; w.x = pk2(lv[0], lv[1]); w.y = pk2(lv[2], lv[3]); w.z = pk2(lv[4], lv[5]); w.w = pk2(lv[6], lv[7]);
            *(LAS u32x4*)(Lw + l15 * 72 + 16 * l4 + 8 * hh) = w;
        }
        LDS_WAIT(); __builtin_amdgcn_wave_barrier();
#pragma unroll
        for (int ks = 0; ks < 2; ++ks) {
            const bf16x8 xa = FRAG(Lw + l15 * 72 + ks * 32 + 8 * l4);
#pragma unroll
            for (int nt = 0; nt < 4; ++nt) { const bf16x8 yb = FRAG(Xt + (64 * r + 16 * nt + l15) * 72 + ks * 32 + 8 * l4); acc[mt][nt] = mma(yb, xa, acc[mt][nt]); }
        }
        LDS_WAIT(); __builtin_amdgcn_wave_barrier();
    }
    const float dsk = dskip[head];
#pragma unroll
    for (int mt = 0; mt < 4; ++mt) {
        const int i = 16 * mt + l15; const float rdt = 1.0f / dts[r * 64 + i]; float sq = 0.f;
#pragma unroll
        for (int nt = 0; nt < 4; ++nt) {
            const int p0 = 16 * nt + 4 * l4;
            const u32x2 zraw = *(const u32x2*)(PROJ + (tok0 + i) * PLD + 4096 + g * 512 + r * 64 + p0);
            const float zz[4] = {lo16(zraw.x), hi16(zraw.x), lo16(zraw.y), hi16(zraw.y)};
#pragma unroll
            for (int ii = 0; ii < 4; ++ii) { const float x = bf2f(Xt[(64 * r + p0 + ii) * 72 + i]) * rdt; const float y = (acc[mt][nt][ii] + dsk * x) * silu_f(zz[ii]); acc[mt][nt][ii] = y; sq += y * y; }
        }
        sq += __shfl_xor(sq, 16); sq += __shfl_xor(sq, 32);
        if (l4 == 0) ssq[r * 64 + i] = sq;
    }
    __syncthreads();
#pragma unroll
    for (int mt = 0; mt < 4; ++mt) {
        const int i = 16 * mt + l15; float t = 0.f;
#pragma unroll
        for (int w = 0; w < 8; ++w) t += ssq[w * 64 + i];
        const float rstd = 1.0f / sqrtf(t * (1.0f / 512.0f) + LN_EPS);
#pragma unroll
        for (int nt = 0; nt < 4; ++nt) {
            const int col = g * 512 + r * 64 + 16 * nt + 4 * l4;
            const f32x4 gn = *(const f32x4*)(ngain + col);
            const f32x4 o = acc[mt][nt] * rstd * gn;
            u32x2 w; w.x = pk2(o[0], o[1]); w.y = pk2(o[2], o[3]);
            *(u32x2*)(MIX + (tok0 + i) * DM + 1024 + col) = w;
        }
    }
    __syncthreads();
}

#define XB_TMO      128
#define XB_XCNT(j)  (256  + 64 * (j))
#define XB_XSUB(j)  (1280 + 64 * (j))
#define XB_XGEN(j)  (2304 + 64 * (j))
#define XB_TOP      3328
#define XB_TOPGEN   3392
#define XCD_BAR_WORDS 3456
#define XB_SPIN_CAP (1u << 18)

__device__ __forceinline__ unsigned xb_ld(unsigned* p)              { return __hip_atomic_load(p, __ATOMIC_RELAXED, __HIP_MEMORY_SCOPE_AGENT); }
__device__ __forceinline__ unsigned xb_add(unsigned* p, unsigned v) { return __hip_atomic_fetch_add(p, v, __ATOMIC_RELAXED, __HIP_MEMORY_SCOPE_AGENT); }
__device__ __forceinline__ unsigned xb_xcc_id() { return (unsigned)__builtin_amdgcn_s_getreg((3 << 11) | 20) & 0xFu; }
#define XB_SPIN(cond, bar) do { unsigned _sp = 0; while (cond) { __builtin_amdgcn_s_sleep(1); \
    if ((++_sp & 255u) == 0u) { if (xb_ld(&(bar)[XB_TMO])) break; if (_sp > XB_SPIN_CAP) { atomicAdd(&(bar)[XB_TMO], 1u); break; } } } } while (0)

struct XcdBarrier {
    unsigned* bar; unsigned x;
    volatile LAS unsigned* st;
};

__device__ __forceinline__ XcdBarrier xcd_barrier_post(unsigned* bar, volatile LAS unsigned* st) {
    XcdBarrier b; b.bar = bar; b.x = xb_xcc_id(); b.st = st;
    if (threadIdx.x == 0) (void)xb_add(&bar[XB_XCNT(b.x)], 1u);
    return b;
}
__device__ __forceinline__ void xcd_barrier_complete(unsigned* bar, unsigned x, unsigned& nloc, unsigned& nx) {
    const unsigned G = gridDim.x * gridDim.y * gridDim.z;
    unsigned sum, cnt, mine, sp = 0u;
    for (;;) {
        sum = 0u; cnt = 0u; mine = 0u;
#pragma unroll
        for (unsigned j = 0; j < 16; ++j) { const unsigned c = xb_ld(&bar[XB_XCNT(j)]); sum += c; cnt += (c > 0u) ? 1u : 0u; mine = (j == x) ? c : mine; }
        if (sum == G) break;
        __builtin_amdgcn_s_sleep(1);
        if ((++sp & 255u) == 0u) { if (xb_ld(&bar[XB_TMO])) break; if (sp > XB_SPIN_CAP) { atomicAdd(&bar[XB_TMO], 1u); break; } }
    }
    nloc = mine > 0u ? mine : 1u; nx = cnt > 0u ? cnt : 1u;
}

__device__ __forceinline__ void xcd_barrier(const XcdBarrier& b) {
    asm volatile("s_waitcnt vmcnt(0)" ::: "memory");
    __syncthreads();
    if (threadIdx.x == 0) {
        unsigned* bar = b.bar;
        __builtin_amdgcn_s_waitcnt(0);
        unsigned nloc = b.st[0], nx = b.st[1];
        if (nloc == 0u) { xcd_barrier_complete(bar, b.x, nloc, nx); b.st[0] = nloc; b.st[1] = nx; }
        const unsigned old = xb_add(&bar[XB_XSUB(b.x)], 1u);
        const unsigned gen = old / nloc;
        if (old + 1u == (gen + 1u) * nloc) {
            __builtin_amdgcn_fence(__ATOMIC_RELEASE, "agent");
            asm volatile("s_waitcnt vmcnt(0)" ::: "memory");
            const unsigned og = xb_add(&bar[XB_TOP], 1u);
            const unsigned tg = og / nx;
            if (og + 1u == (tg + 1u) * nx) xb_add(&bar[XB_TOPGEN], 1u);
            else XB_SPIN(xb_ld(&bar[XB_TOPGEN]) == tg, bar);
            __builtin_amdgcn_fence(__ATOMIC_ACQUIRE, "agent");
            xb_add(&bar[XB_XGEN(b.x)], 1u);
            asm volatile("s_waitcnt vmcnt(0)" ::: "memory");
        } else {
            XB_SPIN(xb_ld(&bar[XB_XGEN(b.x)]) == gen, bar);
            __builtin_amdgcn_fence(__ATOMIC_ACQUIRE, "agent");
            asm volatile("s_waitcnt vmcnt(0)" ::: "memory");
        }
    }
    __syncthreads();
}


#ifndef DUMPC
#define DUMPC 0
#endif
__device__ __forceinline__ void dump_bf16(float* out, const bf16* src, size_t ld, size_t col0, int gtid, int nth) {
    for (size_t i = gtid; i < (size_t)M_TOK * DM; i += nth) { const size_t r = i >> 11, c = i & 2047; float v = bf2f(src[r * ld + col0 + c]); if (!(fabsf(v) < 1e30f)) v = 12345.0f; out[i] = v; }
}
struct Args { const void* in[24]; float* out; unsigned char* ws; };
typedef __attribute__((address_space(4))) const unsigned long long karg_t;
#define KARG(T, i) ((T)(((karg_t*)__builtin_amdgcn_kernarg_segment_ptr())[(i) + oz]))
#define KF(i) KARG(const float*, i)
#define WSP(T, off) ((T)(KARG(unsigned char*, 25) + (off)))
__global__ void __launch_bounds__(NT, 2) fwd_megakernel(Args a_unused) {
    extern __shared__ __attribute__((aligned(16))) unsigned char lds_raw[];
    LAS unsigned char* lds = (LAS unsigned char*)lds_raw;
    cg::grid_group grid = cg::this_grid();
    XcdBarrier bar;
    { volatile LAS unsigned* misc = (volatile LAS unsigned*)(lds + MISC_OFF); if (threadIdx.x < 2) misc[threadIdx.x] = 0u; if (threadIdx.x == 2) *(volatile LAS unsigned*)(lds + 140000) = 0u; __syncthreads();
      const unsigned oz = opaque0(); bar = xcd_barrier_post((unsigned*)WSP(unsigned char*, WS_CTL), misc); }
    grid.sync();
#define SEAM() xcd_barrier(bar)
#ifndef GEMM_ALIGN
#define GEMM_ALIGN true
#endif
#ifndef SKIP_GEMM
#define SKIP_GEMM 0
#endif
#ifndef STOP_AFTER
#define STOP_AFTER 99
#endif
#define GEOM int tid_o = threadIdx.x; asm volatile("" : "+v"(tid_o)); const int tid = tid_o, lane = tid & 63, wave = __builtin_amdgcn_readfirstlane(tid >> 6); (void)lane; (void)wave; const int G = gridDim.x, bx = blockIdx.x, gw = bx * 8 + wave, NGW = G * 8, gtid = bx * NT + tid, nth = G * NT; (void)gw; (void)NGW; (void)gtid; (void)nth; const unsigned oz = opaque0()

    { GEOM; LAS float* scr = (LAS float*)(lds + wave * 8448);
      convert_ffn(KF(2), KF(3), KF(4), WSP(bf16*, WS_WGU), WSP(bf16*, WS_WD), scr, gw, NGW, lane);
      { const float* win = KF(7); const float* wout = KF(16); bf16* WIN = WSP(bf16*, WS_WIN); bf16* WOUT = WSP(bf16*, WS_WOUT);
        for (int it = gw; it < 32 * 216 + 32 * 64; it += NGW) {
            if (it < 32 * 216) { const int kb = it / 216, nb = it % 216; xpose_item(win, NIN, DM, WIN, kb * 64, nb * 32, nb * 32, scr, lane); }
            else { const int r = it - 32 * 216, kb = r / 64, nb = r % 64; xpose_item(wout, DM, DM, WOUT, kb * 64, nb * 32, nb * 32, scr, lane); }
        } }
      { const float* x = KF(0); bf16* XB = WSP(bf16*, WS_XB);
        for (size_t i = gtid; i < (size_t)M_TOK * DM / 8; i += nth) {
            const f32x4 p = ((const f32x4*)x)[2 * i], q = ((const f32x4*)x)[2 * i + 1];
            u32x4 w; w.x = pk2(p[0], p[1]); w.y = pk2(p[2], p[3]); w.z = pk2(q[0], q[1]); w.w = pk2(q[2], q[3]);
            ((u32x4*)XB)[i] = w;
        } }
      { const int* pos = KARG(const int*, 1); float* COS = WSP(float*, WS_COS); float* SIN = WSP(float*, WS_SIN);
        for (int idx = gtid; idx < M_TOK * 128; idx += nth) {
            const int tok = idx >> 7, f = idx & 127;
            const float invf = exp2f(-((float)f * (1.0f / 127.0f)) * 13.287712379549449f);
            const double rev = (double)pos[tok] * (double)invf * 0.15915494309189535;
            const float fr = (float)(rev - rint(rev));
            COS[idx] = __builtin_amdgcn_cosf(fr); SIN[idx] = __builtin_amdgcn_sinf(fr);
        } }
      if (SKIP_GEMM) { bf16* BIGW = WSP(bf16*, WS_BIG); float* DTW = WSP(float*, WS_DT);
        for (size_t i = gtid; i < (size_t)M_TOK * PLD; i += nth) { unsigned hsh = (unsigned)i * 2654435761u; hsh ^= hsh >> 15; hsh *= 2246822519u; hsh ^= hsh >> 13; BIGW[i] = f2bf((float)(hsh & 0xffffu) * (1.0f / 65536.0f) - 0.5f); }
        for (size_t i = gtid; i < (size_t)M_TOK * 16; i += nth) { unsigned hsh = (unsigned)i * 2654435761u; hsh ^= hsh >> 15; hsh *= 2246822519u; hsh ^= hsh >> 13; DTW[i] = (float)(hsh & 0xffffu) * (1.0f / 65536.0f) - 0.5f; } }
    }
    SEAM(); if (STOP_AFTER == 0) return;

    { GEOM; pg8::Gemm g{WSP(const bf16*, WS_XB), WSP(const bf16*, WS_WGU), M_TOK, NGU, DM}; pg8::StaticOrder S; S.init(M_TOK, NGU, G, bx); pg8::EpiSwiglu E{WSP(bf16*, WS_BIG), DFF};
      if (!SKIP_GEMM) pg8::gemm_phase<pg8::EpiSwiglu, pg8::StaticOrder, GEMM_ALIGN, true>(lds, g, S, E); }
    SEAM(); if (STOP_AFTER == 1) return;
    { GEOM; pg8::Gemm g{WSP(const bf16*, WS_BIG), WSP(const bf16*, WS_WD), M_TOK, DM, DFF}; pg8::StaticOrder S; S.init(M_TOK, DM, G, bx); pg8::EpiRes E{KF(0), KARG(float*, 24), DM, ALPHA, 0.5f};
      if (!SKIP_GEMM) pg8::gemm_phase<pg8::EpiRes, pg8::StaticOrder, GEMM_ALIGN, true>(lds, g, S, E); }
    SEAM(); if (STOP_AFTER == 2) return;
    { GEOM; ln_rows<true>(KARG(float*, 24), KF(5), KF(6), WSP(bf16*, WS_XB), gw, NGW, lane); }
    SEAM(); if (STOP_AFTER == 3) return;
    { GEOM; pg8::Gemm g{WSP(const bf16*, WS_XB), WSP(const bf16*, WS_WIN), M_TOK, NINP, DM}; pg8::StaticOrder S; S.init(M_TOK, NINP, G, bx);
      pg8::EpiInProj E{WSP(bf16*, WS_BIG), WSP(const float*, WS_COS), WSP(const float*, WS_SIN), WSP(float*, WS_DT)};
      if (!SKIP_GEMM) pg8::gemm_phase<pg8::EpiInProj, pg8::StaticOrder, GEMM_ALIGN, true>(lds, g, S, E);
#ifdef DIAGMODE
      { volatile LAS unsigned* cnt = (volatile LAS unsigned*)(lds + 140000); if (lane == 0) atomicAdd((unsigned*)(lds_raw + 140000), 1u); __syncthreads(); const unsigned v = *cnt; WSP(float*, WS_XB)[gtid] = (float)v; }
#endif
    }
    SEAM();
#ifdef DIAGMODE
    { GEOM; const float* dg = WSP(const float*, WS_XB); float* o = KARG(float*, 24); for (size_t i = gtid; i < (size_t)M_TOK * DM; i += nth) o[i] = dg[i % nth]; return; }
#endif
    if (STOP_AFTER == 4) { GEOM; dump_bf16(KARG(float*, 24), WSP(const bf16*, WS_BIG), PLD, DUMPC, gtid, nth); return; }
#ifdef P5_TWICE
    for (int rep = 0; rep < 2; ++rep) {
#endif
    { GEOM; const bf16* BIG = WSP(const bf16*, WS_BIG);
      for (int u = bx; u < 1536; u += G) {
        if (u < 1024) ret_a_unit(lds, BIG, WSP(bf16*, WS_RETS), u >> 9, (u >> 2) & 127, u & 3, tid);
        else { const int v = u - 1024; ssd_a_unit(lds, BIG, WSP(const float*, WS_DT), KF(10), KF(11), KF(12), KF(13), WSP(bf16*, WS_SSDS), WSP(float*, WS_TOT), v >> 8, (v >> 1) & 127, v & 1, tid); }
      } }
#ifdef P5_TWICE
    if (rep == 0) SEAM(); }
#endif
#ifdef DBG_FLAG
    { GEOM; unsigned* FL = (unsigned*)WSP(unsigned char*, WS_CTL + 32768); if (tid == 511) FL[bx * 16] = 5u; }
    SEAM();
    { GEOM; const unsigned* FL = (const unsigned*)WSP(unsigned char*, WS_CTL + 32768); int bad = 0; for (int k = 0; k < G; ++k) bad += (FL[k * 16] != 5u);
      float* o = KARG(float*, 24); for (size_t i = gtid; i < (size_t)M_TOK * DM; i += nth) o[i] = 1000.0f * (float)bad; return; }
#endif
    SEAM(); if (STOP_AFTER == 5) { GEOM; dump_bf16(KARG(float*, 24), DUMPC == 2 ? WSP(const bf16*, WS_XB) : DUMPC ? WSP(const bf16*, WS_SSDS) : WSP(const bf16*, WS_RETS), DM, 0, gtid, nth); return; }
    { GEOM; scan_phase(WSP(bf16*, WS_RETS), WSP(bf16*, WS_SSDS), WSP(const float*, WS_TOT), gtid, nth); }
    SEAM(); if (STOP_AFTER == 6) { GEOM; dump_bf16(KARG(float*, 24), DUMPC ? WSP(const bf16*, WS_SSDS) : WSP(const bf16*, WS_RETS), DM, 0, gtid, nth); return; }
    { GEOM; const bf16* BIG = WSP(const bf16*, WS_BIG); bf16* XB = WSP(bf16*, WS_XB);
      for (int u = bx; u < 1536; u += G) {
        if (u < 1024) ret_c_unit(lds, BIG, WSP(const bf16*, WS_RETS), KF(8), KF(9), XB, u >> 9, (u >> 2) & 127, u & 3, tid);
        else { const int v = u - 1024; ssd_c_unit(lds, BIG, WSP(const float*, WS_DT), KF(10), KF(11), KF(12), KF(13), KF(14), KF(15), WSP(const bf16*, WS_SSDS), XB, v >> 8, (v >> 1) & 127, v & 1, tid); }
      } }
    SEAM(); if (STOP_AFTER == 7) { GEOM; dump_bf16(KARG(float*, 24), WSP(const bf16*, WS_XB), DM, 0, gtid, nth); return; }
    { GEOM; pg8::Gemm g{WSP(const bf16*, WS_XB), WSP(const bf16*, WS_WOUT), M_TOK, DM, DM}; pg8::StaticOrder S; S.init(M_TOK, DM, G, bx); float* out = KARG(float*, 24); pg8::EpiRes E{out, out, DM, ALPHA, 1.0f};
      if (!SKIP_GEMM) pg8::gemm_phase<pg8::EpiRes, pg8::StaticOrder, GEMM_ALIGN, true>(lds, g, S, E); }
    SEAM(); if (STOP_AFTER == 8) return;
    { GEOM; ln_rows<true>(KARG(float*, 24), KF(17), KF(18), WSP(bf16*, WS_XB), gw, NGW, lane);
      LAS float* scr = (LAS float*)(lds + wave * 8448);
      convert_ffn(KF(19), KF(20), KF(21), WSP(bf16*, WS_WGU), WSP(bf16*, WS_WD), scr, gw, NGW, lane); }
    SEAM(); if (STOP_AFTER == 9) return;
    { GEOM; pg8::Gemm g{WSP(const bf16*, WS_XB), WSP(const bf16*, WS_WGU), M_TOK, NGU, DM}; pg8::StaticOrder S; S.init(M_TOK, NGU, G, bx); pg8::EpiSwiglu E{WSP(bf16*, WS_BIG), DFF};
      if (!SKIP_GEMM) pg8::gemm_phase<pg8::EpiSwiglu, pg8::StaticOrder, GEMM_ALIGN, true>(lds, g, S, E); }
    SEAM(); if (STOP_AFTER == 10) return;
    { GEOM; pg8::Gemm g{WSP(const bf16*, WS_BIG), WSP(const bf16*, WS_WD), M_TOK, DM, DFF}; pg8::StaticOrder S; S.init(M_TOK, DM, G, bx); float* out = KARG(float*, 24); pg8::EpiRes E{out, out, DM, ALPHA, 0.5f};
      if (!SKIP_GEMM) pg8::gemm_phase<pg8::EpiRes, pg8::StaticOrder, GEMM_ALIGN, true>(lds, g, S, E); }
    SEAM(); if (STOP_AFTER == 11) return;
    { GEOM; ln_rows<false>(KARG(float*, 24), KF(22), KF(23), WSP(bf16*, WS_XB), gw, NGW, lane); }
}

extern "C" void kernel_launch(void* const* d_in, const int* in_sizes, int n_in, void* d_out, int out_size, void* d_ws, size_t ws_size, hipStream_t stream) {
    static int grid = 0;
    if (grid == 0) {
        if (n_in != 24 || in_sizes[0] != M_TOK * DM || out_size != M_TOK * DM || ws_size < WS_END) {
            fprintf(stderr, "kernel_launch: unexpected problem (n_in %d, in0 %d, out %d, ws %zu); nothing launched\n", n_in, n_in > 0 ? in_sizes[0] : -1, out_size, ws_size); grid = -1; return; }
        int dev = 0, cus = 0, per_cu = 0;
        (void)hipGetDevice(&dev); (void)hipDeviceGetAttribute(&cus, hipDeviceAttributeMultiprocessorCount, dev);
        (void)hipFuncSetAttribute((const void*)fwd_megakernel, hipFuncAttributeMaxDynamicSharedMemorySize, LDS_BYTES);
        if (hipOccupancyMaxActiveBlocksPerMultiprocessor(&per_cu, (const void*)fwd_megakernel, NT, LDS_BYTES) != hipSuccess || per_cu < 1) { per_cu = 1; (void)hipGetLastError(); }
        if (cus < 1) cus = 256;
        grid = cus * per_cu;
    }
    if (grid < 0) return;
    if (hipMemsetAsync((char*)d_ws + WS_CTL, 0, CTL_ZERO_BYTES, stream) != hipSuccess) { fprintf(stderr, "kernel_launch: memset of the barrier words failed\n"); return; }
    Args a{};
    for (int i = 0; i < 24; ++i) a.in[i] = d_in[i];
    a.out = (float*)d_out; a.ws = (unsigned char*)d_ws;
    void* args[] = {&a};
    hipError_t e = hipLaunchCooperativeKernel((const void*)fwd_megakernel, dim3(grid), dim3(NT), args, LDS_BYTES, stream);
    if (e != hipSuccess) fprintf(stderr, "cooperative launch failed: %s (grid %d)\n", hipGetErrorString(e), grid);
}
```

```cpp
#include <hip/hip_runtime.h>
#include <hip/hip_cooperative_groups.h>
#include <cstdio>
#include <cstdint>
namespace cg = cooperative_groups;
namespace pg8 {
#define PG8_LAS __attribute__((address_space(3)))
typedef unsigned short bf16_t;
typedef short bf16x8 __attribute__((ext_vector_type(8)));
typedef float f32x4 __attribute__((ext_vector_type(4)));
typedef unsigned u32x4 __attribute__((ext_vector_type(4)));
constexpr int BM = 256, BK = 64, HALF = 128, HTB = HALF * BK * 2  , STAGE_BYTES = 8 * HTB, NXCD = 8, WGM = 8;

__host__ __device__ __forceinline__ int lds_byte(int r, int c) { const int st = (r >> 4) * 2 + (c >> 5), rr = r & 15, cc = c & 31, ob = rr * 64 + cc * 2; return st * 1024 + (ob ^ (((ob >> 9) & 1) << 5)); }
__host__ __device__ __forceinline__ void stage_rc(int b, int& R, int& C) { const int st = b / 1024, sb = b % 1024, swz = sb ^ (((sb >> 9) & 1) << 5); R = (st >> 1) * 16 + swz / 64; C = (st & 1) * 32 + (swz % 64) / 2; }
__host__ __device__ __forceinline__ int perm32(int rho) { const int n = rho >> 4, i = rho & 15; return 8 * (i >> 2) + 4 * n + (i & 3); }

struct Unit { int pm, pn; };
struct Gemm { const bf16_t* A; const bf16_t* Bt; int M, N, K; };

struct StaticOrder {
    int nM, nN, nwg, G, c;
    __host__ __device__ void init(int M, int N, int G_, int c_) { nM = M / BM; nN = N / BM; nwg = nM * nN; G = G_; c = c_; }
    __host__ __device__ bool next(int i, Unit& u) const {
        const long L = (long)i * G + c; if (L >= nwg) return false;
        int wgid = (int)L; { const int q = nwg / NXCD, r = nwg % NXCD, xcd = wgid % NXCD, off = wgid / NXCD; wgid = (xcd < r ? xcd * (q + 1) : r * (q + 1) + (xcd - r) * q) + off; }
        const int nig = WGM * nN, gid = wgid / nig, fm = gid * WGM, gsz = (nM - fm) < WGM ? (nM - fm) : WGM;
        u.pm = fm + ((wgid % nig) % gsz); u.pn = (wgid % nig) / gsz; return true;
    }
    __device__ __forceinline__ void a_ready(const Unit&) const {}
    __device__ __forceinline__ void done(const Unit&) const {}
};

typedef float cvt_f32x2 __attribute__((ext_vector_type(2)));
typedef __bf16 cvt_bf16x2 __attribute__((ext_vector_type(2)));
__device__ __forceinline__ unsigned cvt_pk_bf16(float lo, float hi) { const cvt_f32x2 v = {lo, hi}; return __builtin_bit_cast(unsigned, __builtin_convertvector(v, cvt_bf16x2)); }

__device__ __forceinline__ float swi(float g, float u) { return g * u * __builtin_amdgcn_rcpf(1.0f + __expf(-g)); }
struct EpiSwiglu {
    static constexpr bool PERM = true, AFTER_DRAIN = false;
    bf16_t* H; int ldh;
    __device__ __forceinline__ void operator()(const f32x4 (&acc)[2][2][4][2], const Unit& u, int wr, int wc, int fr, int fq) const {
        const int row0 = u.pm * BM + wr * 64 + fr, col0 = u.pn * 128 + wc * 32 + 8 * fq;
#pragma unroll
        for (int ai = 0; ai < 2; ++ai)
#pragma unroll
            for (int m = 0; m < 4; ++m) {
                bf16_t* p = H + (size_t)(row0 + ai * HALF + m * 16) * ldh + col0;
                const f32x4 g0 = acc[ai][0][m][0], g1 = acc[ai][0][m][1], u0 = acc[ai][1][m][0], u1 = acc[ai][1][m][1];
                u32x4 w;
                w.x = cvt_pk_bf16(swi(g0[0], u0[0]), swi(g0[1], u0[1])); w.y = cvt_pk_bf16(swi(g0[2], u0[2]), swi(g0[3], u0[3]));
                w.z = cvt_pk_bf16(swi(g1[0], u1[0]), swi(g1[1], u1[1])); w.w = cvt_pk_bf16(swi(g1[2], u1[2]), swi(g1[3], u1[3]));
                *(u32x4*)p = w;
            }
    }
};
struct EpiRes {
    static constexpr bool PERM = false, AFTER_DRAIN = false;
    const float* res; float* out; int ld; float alpha, s;
    __device__ __forceinline__ void operator()(const f32x4 (&acc)[2][2][4][2], const Unit& u, int wr, int wc, int fr, int fq) const {
        const int row0 = u.pm * BM + wr * 64 + fr, col0 = u.pn * BM + wc * 32 + 4 * fq;
#pragma unroll
        for (int ai = 0; ai < 2; ++ai)
#pragma unroll
            for (int m = 0; m < 4; ++m) {
                const size_t off = (size_t)(row0 + ai * HALF + m * 16) * ld + col0;
#pragma unroll
                for (int bj = 0; bj < 2; ++bj)
#pragma unroll
                    for (int n = 0; n < 2; ++n) {
                        const f32x4 r = *(const f32x4*)(res + off + bj * HALF + n * 16);
                        *(f32x4*)(out + off + bj * HALF + n * 16) = r * alpha + acc[ai][bj][m][n] * s;
                    }
            }
    }
};
struct EpiInProj {
    static constexpr bool PERM = true, AFTER_DRAIN = false;
    bf16_t* P; const float* cs; const float* sn; float* DT;
    __device__ __forceinline__ void operator()(const f32x4 (&acc)[2][2][4][2], const Unit& u, int wr, int wc, int fr, int fq) const {
        const int row0 = u.pm * BM + wr * 64 + fr, pn = u.pn;
#pragma unroll
        for (int ai = 0; ai < 2; ++ai)
#pragma unroll
            for (int m = 0; m < 4; ++m) {
                const int row = row0 + ai * HALF + m * 16;
#pragma unroll
                for (int bj = 0; bj < 2; ++bj) {
                    const int colt = bj * HALF + wc * 32 + 8 * fq;
                    f32x4 v0 = acc[ai][bj][m][0], v1 = acc[ai][bj][m][1];
                    if (pn < 8) {
                        const f32x4 c = *(const f32x4*)(cs + (size_t)row * 128 + (colt >> 1)), s = *(const f32x4*)(sn + (size_t)row * 128 + (colt >> 1));
                        const float sc = pn >= 4 ? 0.0625f : 1.0f;
                        f32x4 a, b;
                        a[0] = (v0[0] * c[0] - v0[1] * s[0]) * sc; a[1] = (v0[1] * c[0] + v0[0] * s[0]) * sc;
                        a[2] = (v0[2] * c[1] - v0[3] * s[1]) * sc; a[3] = (v0[3] * c[1] + v0[2] * s[1]) * sc;
                        b[0] = (v1[0] * c[2] - v1[1] * s[2]) * sc; b[1] = (v1[1] * c[2] + v1[0] * s[2]) * sc;
                        b[2] = (v1[2] * c[3] - v1[3] * s[3]) * sc; b[3] = (v1[3] * c[3] + v1[2] * s[3]) * sc;
                        v0 = a; v1 = b;
                    }
                    if (pn < 26) {
                        u32x4 w; w.x = cvt_pk_bf16(v0[0], v0[1]); w.y = cvt_pk_bf16(v0[2], v0[3]); w.z = cvt_pk_bf16(v1[0], v1[1]); w.w = cvt_pk_bf16(v1[2], v1[3]);
                        *(u32x4*)(P + (size_t)row * 6672 + pn * BM + colt) = w;
                    } else if (colt < 16) {
                        *(f32x4*)(DT + (size_t)row * 16 + colt) = v0; *(f32x4*)(DT + (size_t)row * 16 + colt + 4) = v1;
                    }
                }
            }
    }
};
template <class Epi, class Sched, bool ALIGN_EPI = false, bool SP2 = false>
__device__ __forceinline__ void gemm_phase(PG8_LAS unsigned char* lds, const Gemm g, const Sched& S, const Epi& E) {
    int tid_o = threadIdx.x; asm volatile("" : "+v"(tid_o));
    const int tid = tid_o, wid = __builtin_amdgcn_readfirstlane(tid >> 6), lane = tid & 63, wr = wid >> 2, wc = wid & 3, fr = lane & 15, fq = lane >> 4;
    const int K = g.K, nt = K / BK;
    unsigned voffA[2], voffB[2];
#pragma unroll
    for (int i = 0; i < 2; ++i) { int R, C; stage_rc(tid * 16 + i * 8192, R, C); const int Rb = Epi::PERM ? ((R & ~31) + perm32(R & 31)) : R;
        voffA[i] = (unsigned)(R * K + C) * 2u; voffB[i] = (unsigned)(Rb * K + C) * 2u; }
    const size_t kstep = (size_t)(BK * 2);
    const size_t hstep = (size_t)HALF * K * 2;
    const size_t tstep = 2 * hstep;
    const unsigned ldsw = (unsigned)wid * 1024u;
    const int aoff = lds_byte(wr * 64 + fr, fq * 8), boff = lds_byte(wc * 32 + fr, fq * 8);
#define PG8_SA(b, h) (((b) * 2 + (h)) * HTB)
#define PG8_SB(b, h) ((4 + (b) * 2 + (h)) * HTB)
#define PG8_STAGE(bufoff, gbase, voff) do { _Pragma("unroll") for (int _i = 0; _i < 2; ++_i) \
        __builtin_amdgcn_global_load_lds((const unsigned*)((const char*)(gbase) + (voff)[_i]), (PG8_LAS unsigned*)(lds + (bufoff) + ldsw + _i * 8192), 16, 0, 0); } while (0)
#define PG8_LDA(dst, b, h) do { _Pragma("unroll") for (int m = 0; m < 4; ++m) _Pragma("unroll") for (int k = 0; k < 2; ++k) dst[m][k] = *(const PG8_LAS bf16x8*)(lds + PG8_SA(b, h) + aoff + m * 2048 + k * 1024); } while (0)
#define PG8_LDB(dst, b, h) do { _Pragma("unroll") for (int n = 0; n < 2; ++n) _Pragma("unroll") for (int k = 0; k < 2; ++k) dst[n][k] = *(const PG8_LAS bf16x8*)(lds + PG8_SB(b, h) + boff + n * 2048 + k * 1024); } while (0)
#define PG8_MMA(ai, bj, At, Bt) do { __builtin_amdgcn_s_setprio(1); _Pragma("unroll") for (int m = 0; m < 4; ++m) _Pragma("unroll") for (int n = 0; n < 2; ++n) _Pragma("unroll") for (int k = 0; k < 2; ++k) \
        acc[ai][bj][m][n] = __builtin_amdgcn_mfma_f32_16x16x32_bf16(Bt[n][k], At[m][k], acc[ai][bj][m][n], 0, 0, 0); __builtin_amdgcn_s_setprio(0); } while (0)
#define PG8_WAIT_V(n) asm volatile("s_waitcnt vmcnt(" #n ")" ::: "memory")
#define PG8_WAIT_L(n) asm volatile("s_waitcnt lgkmcnt(" #n ")" ::: "memory")
#define PG8_BAR __builtin_amdgcn_s_barrier()
#define PG8_SCHED __builtin_amdgcn_sched_barrier(0)
    Unit cur, nxt; int ui = 0;
    if (!S.next(0, cur)) return;
    f32x4 acc[2][2][4][2];
#pragma unroll
    for (int a = 0; a < 2; ++a)
#pragma unroll
        for (int b = 0; b < 2; ++b)
#pragma unroll
            for (int m = 0; m < 4; ++m)
#pragma unroll
                for (int n = 0; n < 2; ++n) acc[a][b][m][n] = (f32x4){0.f, 0.f, 0.f, 0.f};
    bf16x8 At[4][2], B0[2][2], B1[2][2];
    const char* cA = (const char*)g.A + (size_t)cur.pm * tstep; const char* cB = (const char*)g.Bt + (size_t)cur.pn * tstep;
    S.a_ready(cur);
    if constexpr (SP2) {
        PG8_STAGE(PG8_SB(0, 0), cB, voffB); PG8_STAGE(PG8_SB(0, 1), cB + hstep, voffB); PG8_STAGE(PG8_SA(0, 0), cA, voffA); PG8_STAGE(PG8_SA(0, 1), cA + hstep, voffA);
        if (wr == 1) PG8_BAR;
        PG8_WAIT_V(2); PG8_BAR;
        PG8_STAGE(PG8_SB(1, 0), cB + kstep, voffB); PG8_STAGE(PG8_SA(1, 0), cA + kstep, voffA); PG8_STAGE(PG8_SB(1, 1), cB + hstep + kstep, voffB);
        PG8_WAIT_V(6); PG8_BAR;
    } else {
        PG8_STAGE(PG8_SB(0, 0), cB, voffB); PG8_STAGE(PG8_SA(0, 0), cA, voffA); PG8_STAGE(PG8_SB(0, 1), cB + hstep, voffB); PG8_STAGE(PG8_SA(0, 1), cA + hstep, voffA);
        if (wr == 1) PG8_BAR;
        PG8_WAIT_V(4); PG8_BAR;
        PG8_STAGE(PG8_SB(1, 0), cB + kstep, voffB); PG8_STAGE(PG8_SA(1, 0), cA + kstep, voffA); PG8_STAGE(PG8_SB(1, 1), cB + hstep + kstep, voffB);
        PG8_WAIT_V(6); PG8_BAR;
    }
    for (;;) {
        const bool has_next = S.next(ui + 1, nxt);
        const char* nA = has_next ? (const char*)g.A + (size_t)nxt.pm * tstep : cA; const char* nB = has_next ? (const char*)g.Bt + (size_t)nxt.pn * tstep : cB;
        for (int t = 0; t < nt; t += 2) {
            const bool last = (t == nt - 2);
            const char* a1 = cA + (size_t)(t + 1) * kstep;
            const char* a2 = last ? nA : cA + (size_t)(t + 2) * kstep; const char* b2 = last ? nB : cB + (size_t)(t + 2) * kstep;
            const char* a3 = a2 + kstep; const char* b3 = b2 + kstep;
            if (last && has_next) S.a_ready(nxt);
            if constexpr (SP2) {
            PG8_LDB(B0, 0, 0); PG8_LDB(B1, 0, 1); PG8_SCHED; PG8_LDA(At, 0, 0); PG8_STAGE(PG8_SA(1, 1), a1 + hstep, voffA);
            PG8_WAIT_V(8); PG8_WAIT_L(0); PG8_BAR; PG8_MMA(0, 0, At, B0); PG8_MMA(0, 1, At, B1); PG8_BAR; PG8_SCHED;
            PG8_LDA(At, 0, 1); PG8_STAGE(PG8_SB(0, 0), b2, voffB); PG8_STAGE(PG8_SB(0, 1), b2 + hstep, voffB); PG8_STAGE(PG8_SA(0, 0), a2, voffA);
            PG8_WAIT_V(8); PG8_WAIT_L(0); PG8_BAR; PG8_MMA(1, 0, At, B0); PG8_MMA(1, 1, At, B1); PG8_BAR; PG8_SCHED;
            PG8_LDB(B0, 1, 0); PG8_LDB(B1, 1, 1); PG8_SCHED; PG8_LDA(At, 1, 0); PG8_STAGE(PG8_SA(0, 1), a2 + hstep, voffA);
            PG8_WAIT_V(8); PG8_WAIT_L(0); PG8_BAR; PG8_MMA(0, 0, At, B0); PG8_MMA(0, 1, At, B1); PG8_BAR; PG8_SCHED;
            PG8_LDA(At, 1, 1); PG8_STAGE(PG8_SB(1, 0), b3, voffB); PG8_STAGE(PG8_SB(1, 1), b3 + hstep, voffB); PG8_STAGE(PG8_SA(1, 0), a3, voffA);
            PG8_WAIT_V(8); PG8_WAIT_L(0); PG8_BAR; PG8_MMA(1, 0, At, B0); PG8_MMA(1, 1, At, B1); PG8_BAR; PG8_SCHED;
            } else {
            PG8_LDB(B0, 0, 0); PG8_SCHED; PG8_LDA(At, 0, 0); PG8_STAGE(PG8_SA(1, 1), a1 + hstep, voffA);
            PG8_WAIT_L(8); PG8_BAR; PG8_WAIT_L(0); PG8_MMA(0, 0, At, B0); PG8_BAR; PG8_SCHED;
            PG8_LDB(B1, 0, 1); PG8_STAGE(PG8_SB(0, 0), b2, voffB);
            PG8_BAR; PG8_WAIT_L(0); PG8_MMA(0, 1, At, B1); PG8_BAR;
            PG8_LDA(At, 0, 1); PG8_STAGE(PG8_SA(0, 0), a2, voffA);
            PG8_BAR; PG8_WAIT_L(0); PG8_MMA(1, 0, At, B0); PG8_BAR; PG8_SCHED;
            PG8_STAGE(PG8_SB(0, 1), b2 + hstep, voffB);
            PG8_WAIT_V(6); PG8_BAR; PG8_MMA(1, 1, At, B1); PG8_BAR;
            PG8_LDB(B0, 1, 0); PG8_SCHED; PG8_LDA(At, 1, 0); PG8_STAGE(PG8_SA(0, 1), a2 + hstep, voffA);
            PG8_WAIT_L(8); PG8_BAR; PG8_WAIT_L(0); PG8_MMA(0, 0, At, B0); PG8_BAR; PG8_SCHED;
            PG8_LDB(B1, 1, 1); PG8_STAGE(PG8_SB(1, 0), b3, voffB);
            PG8_BAR; PG8_WAIT_L(0); PG8_MMA(0, 1, At, B1); PG8_BAR;
            PG8_LDA(At, 1, 1); PG8_STAGE(PG8_SA(1, 0), a3, voffA);
            PG8_BAR; PG8_WAIT_L(0); PG8_MMA(1, 0, At, B0); PG8_BAR; PG8_SCHED;
            PG8_STAGE(PG8_SB(1, 1), b3 + hstep, voffB);
            PG8_WAIT_V(6); PG8_BAR; PG8_MMA(1, 1, At, B1); PG8_BAR;
            }
        }
        if constexpr (ALIGN_EPI) { if (wr == 0) PG8_BAR; }
        if constexpr (!Epi::AFTER_DRAIN) { E(acc, cur, wr, wc, fr, fq); S.done(cur); }
        if (!has_next) break;
#pragma unroll
        for (int a = 0; a < 2; ++a)
#pragma unroll
            for (int b = 0; b < 2; ++b)
#pragma unroll
                for (int m = 0; m < 4; ++m)
#pragma unroll
                    for (int n = 0; n < 2; ++n) acc[a][b][m][n] = (f32x4){0.f, 0.f, 0.f, 0.f};
        cur = nxt; cA = nA; cB = nB; ++ui;
        if constexpr (ALIGN_EPI) { if (wr == 1) PG8_BAR; }
    }
    PG8_WAIT_V(0);
    if constexpr (!ALIGN_EPI) { if (wr == 0) PG8_BAR; }
    PG8_BAR;
    if constexpr (Epi::AFTER_DRAIN) { E.fused(acc, cur, wr, wc, fr, fq, lds, wid, lane); S.done(cur); }
#undef PG8_SA
#undef PG8_SB
#undef PG8_STAGE
#undef PG8_LDA
#undef PG8_LDB
#undef PG8_MMA
#undef PG8_WAIT_V
#undef PG8_WAIT_L
#undef PG8_BAR
#undef PG8_SCHED
}
}

#define LAS __attribute__((address_space(3)))
typedef unsigned short bf16;
typedef unsigned u32x4 __attribute__((ext_vector_type(4)));
typedef unsigned u32x2 __attribute__((ext_vector_type(2)));
typedef float f32x4 __attribute__((ext_vector_type(4)));
typedef short bf16x8 __attribute__((ext_vector_type(8)));

constexpr int NT = 512;
constexpr int M_TOK = 16384, SEQ = 8192, DM = 2048, DFF = 5632, NGU = 11264, NIN = 6672, NINP = 6912, PLD = 6672;
constexpr float LN_EPS = 1e-5f;
constexpr float ALPHA = 1.189207115002721f;
constexpr size_t MiB = (size_t)1 << 20;
constexpr size_t WS_RETS = 0, WS_SSDS = 128 * MiB, WS_WGU = 0, WS_WD = 44 * MiB, WS_WIN = 66 * MiB, WS_COS = 93 * MiB, WS_SIN = 101 * MiB,
                 WS_WOUT = 192 * MiB, WS_XB = 200 * MiB, WS_BIG = 264 * MiB, WS_DT = 473 * MiB, WS_TOT = 474 * MiB, WS_CTL = 475 * MiB, WS_END = 476 * MiB;
constexpr size_t CTL_ZERO_BYTES = 65536;
constexpr int MISC_OFF = 152064;
constexpr int LDS_BYTES = 153600;

__device__ __forceinline__ float lo16(unsigned w) { return __uint_as_float(w << 16); }
__device__ __forceinline__ float hi16(unsigned w) { return __uint_as_float(w & 0xffff0000u); }
__device__ __forceinline__ float bf2f(bf16 h) { return __uint_as_float((unsigned)h << 16); }
__device__ __forceinline__ bf16 f2bf(float f) { unsigned u = __float_as_uint(f); return (bf16)((u + 0x7fffu + ((u >> 16) & 1u)) >> 16); }
__device__ __forceinline__ unsigned pk2(float a, float b) { return pg8::cvt_pk_bf16(a, b); }
__device__ __forceinline__ float wave_sum(float v) {
#pragma unroll
    for (int o = 1; o < 64; o <<= 1) v += __shfl_xor(v, o);
    return v;
}
__device__ __forceinline__ float silu_f(float x) { return x * __builtin_amdgcn_rcpf(1.0f + __expf(-x)); }
__device__ __forceinline__ f32x4 mma(bf16x8 y, bf16x8 x, f32x4 c) { return __builtin_amdgcn_mfma_f32_16x16x32_bf16(y, x, c, 0, 0, 0); }
__device__ __forceinline__ unsigned opaque0() { unsigned z; asm volatile("s_mov_b32 %0, 0" : "=s"(z)); return z; }
#define LDS_WAIT() asm volatile("s_waitcnt lgkmcnt(0)" ::: "memory")
#define FRAG(p) (*(const LAS bf16x8*)(p))

__device__ __forceinline__ void xpose_item(const float* W, int Nsrc, int K, bf16* WT, int k0, int n0, int drow0, LAS float* scr, int lane) {
    const int nn = n0 + (lane & 31);
#pragma unroll 8
    for (int i = 0; i < 32; ++i) { const int kk = 2 * i + (lane >> 5); scr[kk * 33 + (lane & 31)] = nn < Nsrc ? W[(size_t)(k0 + kk) * Nsrc + nn] : 0.0f; }
    LDS_WAIT();
    const int c = lane & 7;
#pragma unroll
    for (int j = 0; j < 4; ++j) { const int n = (lane >> 3) + 8 * j; const LAS float* s = scr + (8 * c) * 33 + n;
        u32x4 o; o.x = pk2(s[0 * 33], s[1 * 33]); o.y = pk2(s[2 * 33], s[3 * 33]); o.z = pk2(s[4 * 33], s[5 * 33]); o.w = pk2(s[6 * 33], s[7 * 33]);
        *(u32x4*)(WT + (size_t)(drow0 + n) * K + k0 + 8 * c) = o; }
    LDS_WAIT();
}
__device__ __forceinline__ void convert_ffn(const float* wg, const float* wu, const float* wd, bf16* WGU, bf16* WD, LAS float* scr, int gw, int NGW, int lane) {
    for (int it = gw; it < 3 * 5632; it += NGW) {
        int r = it;
        if (r < 2 * 5632) { const int up = r >= 5632 ? 1 : 0; r -= up * 5632; const int kb = r / 176, nb = r % 176, n0 = nb * 32;
            xpose_item(up ? wu : wg, DFF, DM, WGU, kb * 64, n0, 256 * (n0 >> 7) + (n0 & 127) + up * 128, scr, lane); }
        else { r -= 2 * 5632; const int kb = r / 64, nb = r % 64; xpose_item(wd, DM, DFF, WD, kb * 64, nb * 32, nb * 32, scr, lane); }
    }
}
template <bool WBF>
__device__ __forceinline__ void ln_rows(float* io, const float* gain, const float* bias, bf16* xb, int gw, int NGW, int lane) {
    for (int row = gw; row < M_TOK; row += NGW) {
        f32x4* p = (f32x4*)(io + (size_t)row * DM) + lane;
        f32x4 v[8]; float s = 0.f;
#pragma unroll
        for (int j = 0; j < 8; ++j) { v[j] = p[64 * j]; s += (v[j][0] + v[j][1]) + (v[j][2] + v[j][3]); }
        const float mean = wave_sum(s) * (1.0f / DM); float s2 = 0.f;
#pragma unroll
        for (int j = 0; j < 8; ++j) { v[j] = v[j] - mean; s2 += (v[j][0] * v[j][0] + v[j][1] * v[j][1]) + (v[j][2] * v[j][2] + v[j][3] * v[j][3]); }
        const float rstd = 1.0f / sqrtf(wave_sum(s2) * (1.0f / DM) + LN_EPS);
#pragma unroll
        for (int j = 0; j < 8; ++j) {
            const f32x4 g = ((const f32x4*)gain)[lane + 64 * j], b = ((const f32x4*)bias)[lane + 64 * j];
            const f32x4 o = v[j] * rstd * g + b;
            p[64 * j] = o;
            if (WBF) { u32x2 w; w.x = pk2(o[0], o[1]); w.y = pk2(o[2], o[3]); ((u32x2*)(xb + (size_t)row * DM))[lane + 64 * j] = w; }
        }
    }
}

__device__ __forceinline__ void conv8(const bf16* PROJ, const float* cw, const float* cb, size_t tokrow, int t, int ch, f32x4& a0, f32x4& a1) {
    a0 = *(const f32x4*)(cb + ch); a1 = *(const f32x4*)(cb + ch + 4);
#pragma unroll
    for (int k = 0; k < 4; ++k) {
        if (t - 3 + k >= 0) {
            const u32x4 raw = *(const u32x4*)(PROJ + (tokrow - 3 + k) * PLD + 5120 + ch);
            const f32x4 w0 = *(const f32x4*)(cw + k * 1536 + ch), w1 = *(const f32x4*)(cw + k * 1536 + ch + 4);
            a0[0] += w0[0] * lo16(raw.x); a0[1] += w0[1] * hi16(raw.x); a0[2] += w0[2] * lo16(raw.y); a0[3] += w0[3] * hi16(raw.y);
            a1[0] += w1[0] * lo16(raw.z); a1[1] += w1[1] * hi16(raw.z); a1[2] += w1[2] * lo16(raw.w); a1[3] += w1[3] * hi16(raw.w);
        }
    }
#pragma unroll
    for (int i = 0; i < 4; ++i) { a0[i] = silu_f(a0[i]); a1[i] = silu_f(a1[i]); }
}
__device__ __forceinline__ void dt_acum(const float* DT, const float* dt_bias, const float* a_log, size_t tok0, int head, int lane, float& dt, float& ac) {
    const float x = DT[(tok0 + lane) * 16 + head] + dt_bias[head];
    dt = x > 20.0f ? x : log1pf(expf(x));
    float s = dt * (-expf(a_log[head]));
#pragma unroll
    for (int o = 1; o < 64; o <<= 1) { const float t = __shfl_up(s, o); if (lane >= o) s += t; }
    ac = s;
}

__device__ __forceinline__ void ret_a_unit(LAS unsigned char* lds, const bf16* PROJ, bf16* RETS, int b, int z, int h, int tid) {
    const int wave = tid >> 6, lane = tid & 63, l15 = lane & 15, l4 = lane >> 4;
    const size_t tok0 = (size_t)b * SEQ + (size_t)z * 64;
    const float lg2 = log2f(1.0f - exp2f(-5.0f - (float)h));
    LAS bf16* Kt = (LAS bf16*)lds;
    LAS bf16* Vt = (LAS bf16*)(lds + 36864);
#pragma unroll 2
    for (int it = 0; it < 8; ++it) {
        const int q = it * NT + tid, j = q & 63, ch = (q >> 6) & 31, mat = q >> 11;
        const u32x4 raw = *(const u32x4*)(PROJ + (tok0 + j) * PLD + (mat ? 2048 : 1024) + h * 256 + ch * 8);
        const float sc = mat ? 1.0f : exp2f(lg2 * (float)(63 - j));
#ifdef DBG_RAW
        ((u32x4*)(RETS + (size_t)200 * 1024 * 1024 / 2))[(size_t)((b * 128 + z) * 4 + h) * 4096 + q] = raw;
#endif
        LAS bf16* dst = (mat ? Vt : Kt) + (ch * 8) * 72 + j;
        dst[0 * 72] = f2bf(lo16(raw.x) * sc); dst[1 * 72] = f2bf(hi16(raw.x) * sc); dst[2 * 72] = f2bf(lo16(raw.y) * sc); dst[3 * 72] = f2bf(hi16(raw.y) * sc);
        dst[4 * 72] = f2bf(lo16(raw.z) * sc); dst[5 * 72] = f2bf(hi16(raw.z) * sc); dst[6 * 72] = f2bf(lo16(raw.w) * sc); dst[7 * 72] = f2bf(hi16(raw.w) * sc);
    }
    __syncthreads();
#ifdef DBG_LDS
#define DBG_CHECK(slot) { int bad = 0; \
    for (int it = 0; it < 8; ++it) { const int q = it * NT + tid, j = q & 63, ch = (q >> 6) & 31, mat = q >> 11; \
        const u32x4 raw = *(const u32x4*)(PROJ + (tok0 + j) * PLD + (mat ? 2048 : 1024) + h * 256 + ch * 8); \
        const float sc = mat ? 1.0f : exp2f(lg2 * (float)(63 - j)); \
        volatile LAS bf16* dst = (mat ? Vt : Kt) + (ch * 8) * 72 + j; \
        bad += (dst[0 * 72] != f2bf(lo16(raw.x) * sc)) + (dst[1 * 72] != f2bf(hi16(raw.x) * sc)) + (dst[2 * 72] != f2bf(lo16(raw.y) * sc)) + (dst[3 * 72] != f2bf(hi16(raw.y) * sc)) \
             + (dst[4 * 72] != f2bf(lo16(raw.z) * sc)) + (dst[5 * 72] != f2bf(hi16(raw.z) * sc)) + (dst[6 * 72] != f2bf(lo16(raw.w) * sc)) + (dst[7 * 72] != f2bf(hi16(raw.w) * sc)); } \
    (RETS + (size_t)200 * 1024 * 1024 / 2)[(size_t)((b * 128 + z) * 4 + h) * 1024 + (slot) * 512 + tid] = f2bf(1000.0f * (float)bad); }
    DBG_CHECK(0)
#endif
    bf16* out = RETS + ((size_t)((b * 4 + h) * 128 + z)) * 65536;
#pragma unroll 1
    for (int dh = 0; dh < 2; ++dh) {
        f32x4 acc[2][8];
#pragma unroll
        for (int mt = 0; mt < 2; ++mt)
#pragma unroll
            for (int nt = 0; nt < 8; ++nt) acc[mt][nt] = (f32x4){0.f, 0.f, 0.f, 0.f};
#pragma unroll
        for (int ks = 0; ks < 2; ++ks) {
            bf16x8 xa[2];
#pragma unroll
            for (int mt = 0; mt < 2; ++mt) xa[mt] = FRAG(Vt + (32 * wave + 16 * mt + l15) * 72 + ks * 32 + 8 * l4);
#pragma unroll
            for (int nt = 0; nt < 8; ++nt) { const bf16x8 yb = FRAG(Kt + (128 * dh + 16 * nt + l15) * 72 + ks * 32 + 8 * l4);
#pragma unroll
                for (int mt = 0; mt < 2; ++mt) acc[mt][nt] = mma(yb, xa[mt], acc[mt][nt]); }
        }
#pragma unroll
        for (int mt = 0; mt < 2; ++mt)
#pragma unroll
            for (int nt = 0; nt < 8; ++nt) { const int e = 32 * wave + 16 * mt + l15, d = 128 * dh + 16 * nt + 4 * l4;
                u32x2 w; w.x = pk2(acc[mt][nt][0], acc[mt][nt][1]); w.y = pk2(acc[mt][nt][2], acc[mt][nt][3]); *(u32x2*)(out + e * 256 + d) = w; }
    }
#ifdef DBG_LDS
    DBG_CHECK(1)
#endif
    __syncthreads();
}

__device__ __forceinline__ void ssd_a_unit(LAS unsigned char* lds, const bf16* PROJ, const float* DT, const float* cw, const float* cb, const float* dt_bias, const float* a_log,
                                           bf16* SSDS, float* TOT, int b, int z, int g, int tid) {
    const int wave = tid >> 6, lane = tid & 63, l15 = lane & 15, l4 = lane >> 4;
    const size_t tok0 = (size_t)b * SEQ + (size_t)z * 64;
    LAS bf16* Bt = (LAS bf16*)lds;
    LAS bf16* Xt = (LAS bf16*)(lds + 18432);
    LAS float* coef = (LAS float*)(lds + 92160);
    { float dt, ac; dt_acum(DT, dt_bias, a_log, tok0, g * 8 + wave, lane, dt, ac); const float last = __shfl(ac, 63);
      coef[wave * 64 + lane] = dt * expf(last - ac); if (lane == 63) TOT[(size_t)(b * 128 + z) * 16 + g * 8 + wave] = expf(last); }
    __syncthreads();
#pragma unroll 1
    for (int it = 0; it < 2; ++it) {
        const int q = it * NT + tid, j = q & 63, ch = q >> 6; f32x4 a0, a1;
        conv8(PROJ, cw, cb, tok0 + j, z * 64 + j, 1024 + g * 128 + ch * 8, a0, a1);
        LAS bf16* dst = Bt + (ch * 8) * 72 + j;
        dst[0 * 72] = f2bf(a0[0]); dst[1 * 72] = f2bf(a0[1]); dst[2 * 72] = f2bf(a0[2]); dst[3 * 72] = f2bf(a0[3]);
        dst[4 * 72] = f2bf(a1[0]); dst[5 * 72] = f2bf(a1[1]); dst[6 * 72] = f2bf(a1[2]); dst[7 * 72] = f2bf(a1[3]);
    }
#pragma unroll 1
    for (int it = 0; it < 8; ++it) {
        const int q = it * NT + tid, j = q & 63, ch = q >> 6; f32x4 a0, a1;
        conv8(PROJ, cw, cb, tok0 + j, z * 64 + j, g * 512 + ch * 8, a0, a1);
        const float c = coef[(ch >> 3) * 64 + j];
        LAS bf16* dst = Xt + (ch * 8) * 72 + j;
        dst[0 * 72] = f2bf(a0[0] * c); dst[1 * 72] = f2bf(a0[1] * c); dst[2 * 72] = f2bf(a0[2] * c); dst[3 * 72] = f2bf(a0[3] * c);
        dst[4 * 72] = f2bf(a1[0] * c); dst[5 * 72] = f2bf(a1[1] * c); dst[6 * 72] = f2bf(a1[2] * c); dst[7 * 72] = f2bf(a1[3] * c);
    }
    __syncthreads();
    bf16* out = SSDS + ((size_t)((b * 16 + g * 8 + wave) * 128 + z)) * 8192;
#pragma unroll 1
    for (int nh = 0; nh < 2; ++nh) {
        f32x4 acc[4][4];
#pragma unroll
        for (int mt = 0; mt < 4; ++mt)
#pragma unroll
            for (int nt = 0; nt < 4; ++nt) acc[mt][nt] = (f32x4){0.f, 0.f, 0.f, 0.f};
#pragma unroll
        for (int ks = 0; ks < 2; ++ks) {
            bf16x8 xa[4];
#pragma unroll
            for (int mt = 0; mt < 4; ++mt) xa[mt] = FRAG(Xt + (64 * wave + 16 * mt + l15) * 72 + ks * 32 + 8 * l4);
#pragma unroll
            for (int nt = 0; nt < 4; ++nt) { const bf16x8 yb = FRAG(Bt + (64 * nh + 16 * nt + l15) * 72 + ks * 32 + 8 * l4);
#pragma unroll
                for (int mt = 0; mt < 4; ++mt) acc[mt][nt] = mma(yb, xa[mt], acc[mt][nt]); }
        }
#pragma unroll
        for (int mt = 0; mt < 4; ++mt)
#pragma unroll
            for (int nt = 0; nt < 4; ++nt) { const int p = 16 * mt + l15, n = 64 * nh + 16 * nt + 4 * l4;
                u32x2 w; w.x = pk2(acc[mt][nt][0], acc[mt][nt][1]); w.y = pk2(acc[mt][nt][2], acc[mt][nt][3]); *(u32x2*)(out + p * 128 + n) = w; }
    }
    __syncthreads();
}

__device__ __forceinline__ void scan_phase(bf16* RETS, bf16* SSDS, const float* TOT, int gtid, int nth) {
    for (int task = gtid; task < 98304; task += nth) {
        bf16* base; size_t stride; float cdec = 0.f; const float* totp = nullptr;
        if (task < 65536) { const int bh = task >> 13, e8 = task & 8191; base = RETS + (size_t)bh * 128 * 65536 + (size_t)e8 * 8; stride = 65536;
            cdec = exp2f(64.0f * log2f(1.0f - exp2f(-5.0f - (float)(bh & 3)))); }
        else { const int t2 = task - 65536, bhd = t2 >> 10, e8 = t2 & 1023; base = SSDS + (size_t)bhd * 128 * 8192 + (size_t)e8 * 8; stride = 8192;
            totp = TOT + (size_t)(bhd >> 4) * 128 * 16 + (bhd & 15); }
        float s0 = 0.f, s1 = 0.f, s2 = 0.f, s3 = 0.f, s4 = 0.f, s5 = 0.f, s6 = 0.f, s7 = 0.f;
#pragma unroll 1
        for (int z0 = 0; z0 < 128; z0 += 8) {
            u32x4 v[8]; float dec[8];
#pragma unroll
            for (int i = 0; i < 8; ++i) { v[i] = *(const u32x4*)(base + (size_t)(z0 + i) * stride); dec[i] = totp ? totp[(z0 + i) * 16] : cdec; }
#pragma unroll
            for (int i = 0; i < 8; ++i) {
                u32x4 o; o.x = pk2(s0, s1); o.y = pk2(s2, s3); o.z = pk2(s4, s5); o.w = pk2(s6, s7);
                *(u32x4*)(base + (size_t)(z0 + i) * stride) = o;
                const float d = dec[i];
                s0 = s0 * d + lo16(v[i].x); s1 = s1 * d + hi16(v[i].x); s2 = s2 * d + lo16(v[i].y); s3 = s3 * d + hi16(v[i].y);
                s4 = s4 * d + lo16(v[i].z); s5 = s5 * d + hi16(v[i].z); s6 = s6 * d + lo16(v[i].w); s7 = s7 * d + hi16(v[i].w);
            }
        }
    }
}

__device__ __forceinline__ void ret_c_unit(LAS unsigned char* lds, const bf16* PROJ, const bf16* RETS, const float* gn_g, const float* gn_b, bf16* MIX, int b, int z, int h, int tid) {
    const int wave = tid >> 6, lane = tid & 63, l15 = lane & 15, l4 = lane >> 4;
    const size_t tok0 = (size_t)b * SEQ + (size_t)z * 64;
    const float lg2 = log2f(1.0f - exp2f(-5.0f - (float)h));
    LAS bf16* Q = (LAS bf16*)lds;
    LAS bf16* Kn = (LAS bf16*)(lds + 33792);
    LAS bf16* Vt = (LAS bf16*)(lds + 67584);
    LAS bf16* Pm = (LAS bf16*)(lds + 104448);
    LAS float* st1 = (LAS float*)(lds + 113664);
    LAS float* st2 = (LAS float*)(lds + 115712);
#pragma unroll 2
    for (int it = 0; it < 8; ++it) {
        const int q = it * NT + tid, ch = q & 31, j = (q >> 5) & 63, mat = q >> 11;
        const u32x4 raw = *(const u32x4*)(PROJ + (tok0 + j) * PLD + mat * 1024 + h * 256 + ch * 8);
        *(LAS u32x4*)((mat ? Kn : Q) + j * 264 + ch * 8) = raw;
    }
#pragma unroll 2
    for (int it = 0; it < 4; ++it) {
        const int q = it * NT + tid, j = q & 63, ch = q >> 6;
        const u32x4 raw = *(const u32x4*)(PROJ + (tok0 + j) * PLD + 2048 + h * 256 + ch * 8);
        LAS bf16* dst = Vt + (ch * 8) * 72 + j;
        dst[0 * 72] = (bf16)(raw.x & 0xffffu); dst[1 * 72] = (bf16)(raw.x >> 16); dst[2 * 72] = (bf16)(raw.y & 0xffffu); dst[3 * 72] = (bf16)(raw.y >> 16);
        dst[4 * 72] = (bf16)(raw.z & 0xffffu); dst[5 * 72] = (bf16)(raw.z >> 16); dst[6 * 72] = (bf16)(raw.w & 0xffffu); dst[7 * 72] = (bf16)(raw.w >> 16);
    }
    __syncthreads();
    {
        const int mt = wave >> 1, nt0 = 2 * (wave & 1);
        f32x4 sc[2] = {(f32x4){0.f, 0.f, 0.f, 0.f}, (f32x4){0.f, 0.f, 0.f, 0.f}};
#pragma unroll
        for (int ks = 0; ks < 8; ++ks) {
            const bf16x8 xa = FRAG(Q + (16 * mt + l15) * 264 + ks * 32 + 8 * l4);
#pragma unroll
            for (int n2 = 0; n2 < 2; ++n2) { const bf16x8 yb = FRAG(Kn + (16 * (nt0 + n2) + l15) * 264 + ks * 32 + 8 * l4); sc[n2] = mma(yb, xa, sc[n2]); }
        }
#pragma unroll
        for (int n2 = 0; n2 < 2; ++n2) {
            const int i = 16 * mt + l15 + (int)opaque0(), j0 = 16 * (nt0 + n2) + 4 * l4; float p[4];
#pragma unroll
            for (int ii = 0; ii < 4; ++ii) { const int j = j0 + ii; p[ii] = (j <= i) ? sc[n2][ii] * exp2f(lg2 * (float)(i - j)) : 0.0f; }
            u32x2 w; w.x = pk2(p[0], p[1]); w.y = pk2(p[2], p[3]); *(LAS u32x2*)(Pm + i * 72 + j0) = w;
        }
    }
    __syncthreads();
    f32x4 acc[4][2];
#pragma unroll
    for (int mt = 0; mt < 4; ++mt)
#pragma unroll
        for (int nt = 0; nt < 2; ++nt) acc[mt][nt] = (f32x4){0.f, 0.f, 0.f, 0.f};
    const bf16* S = RETS + ((size_t)((b * 4 + h) * 128 + z)) * 65536;
#pragma unroll
    for (int ks = 0; ks < 8; ++ks) {
        bf16x8 yb[2];
#pragma unroll
        for (int nt = 0; nt < 2; ++nt) yb[nt] = *(const bf16x8*)(S + (32 * wave + 16 * nt + l15) * 256 + ks * 32 + 8 * l4);
#pragma unroll
        for (int mt = 0; mt < 4; ++mt) { const bf16x8 xa = FRAG(Q + (16 * mt + l15) * 264 + ks * 32 + 8 * l4);
#pragma unroll
            for (int nt = 0; nt < 2; ++nt) acc[mt][nt] = mma(yb[nt], xa, acc[mt][nt]); }
    }
#pragma unroll
    for (int mt = 0; mt < 4; ++mt) { const float qd = exp2f(lg2 * (float)(16 * mt + l15 + 1));
#pragma unroll
        for (int nt = 0; nt < 2; ++nt) acc[mt][nt] = acc[mt][nt] * qd; }
#pragma unroll
    for (int ks = 0; ks < 2; ++ks) {
        bf16x8 yb[2];
#pragma unroll
        for (int nt = 0; nt < 2; ++nt) yb[nt] = FRAG(Vt + (32 * wave + 16 * nt + l15) * 72 + ks * 32 + 8 * l4);
#pragma unroll
        for (int mt = 0; mt < 4; ++mt) { const bf16x8 xa = FRAG(Pm + (16 * mt + l15) * 72 + ks * 32 + 8 * l4);
#pragma unroll
            for (int nt = 0; nt < 2; ++nt) acc[mt][nt] = mma(yb[nt], xa, acc[mt][nt]); }
    }
#pragma unroll
    for (int mt = 0; mt < 4; ++mt) {
        float s = 0.f;
#pragma unroll
        for (int nt = 0; nt < 2; ++nt) s += (acc[mt][nt][0] + acc[mt][nt][1]) + (acc[mt][nt][2] + acc[mt][nt][3]);
        s += __shfl_xor(s, 16); s += __shfl_xor(s, 32);
        if (l4 == 0) st1[wave * 64 + 16 * mt + l15] = s;
    }
    __syncthreads();
    float mean[4];
#pragma unroll
    for (int mt = 0; mt < 4; ++mt) { float m = 0.f;
#pragma unroll
        for (int w = 0; w < 8; ++w) m += st1[w * 64 + 16 * mt + l15];
        mean[mt] = m * (1.0f / 256.0f);
        float s = 0.f;
#pragma unroll
        for (int nt = 0; nt < 2; ++nt) { acc[mt][nt] = acc[mt][nt] - mean[mt]; s += (acc[mt][nt][0] * acc[mt][nt][0] + acc[mt][nt][1] * acc[mt][nt][1]) + (acc[mt][nt][2] * acc[mt][nt][2] + acc[mt][nt][3] * acc[mt][nt][3]); }
        s += __shfl_xor(s, 16); s += __shfl_xor(s, 32);
        if (l4 == 0) st2[wave * 64 + 16 * mt + l15] = s;
    }
    __syncthreads();
#pragma unroll
    for (int mt = 0; mt < 4; ++mt) { float q = 0.f; const int i = 16 * mt + l15;
#pragma unroll
        for (int w = 0; w < 8; ++w) q += st2[w * 64 + i];
        const float rstd = 1.0f / sqrtf(q * (1.0f / 256.0f) + LN_EPS);
#pragma unroll
        for (int nt = 0; nt < 2; ++nt) {
            const int col = h * 256 + 32 * wave + 16 * nt + 4 * l4;
            const f32x4 gg = *(const f32x4*)(gn_g + col), bb = *(const f32x4*)(gn_b + col);
            const u32x2 graw = *(const u32x2*)(PROJ + (tok0 + i) * PLD + 3072 + col);
            const f32x4 o = acc[mt][nt] * rstd * gg + bb;
            u32x2 w; w.x = pk2(o[0] * silu_f(lo16(graw.x)), o[1] * silu_f(hi16(graw.x))); w.y = pk2(o[2] * silu_f(lo16(graw.y)), o[3] * silu_f(hi16(graw.y)));
            *(u32x2*)(MIX + (tok0 + i) * DM + col) = w;
        }
    }
    __syncthreads();
}

__device__ __forceinline__ void ssd_c_unit(LAS unsigned char* lds, const bf16* PROJ, const float* DT, const float* cw, const float* cb, const float* dt_bias, const float* a_log,
                                           const float* dskip, const float* ngain, const bf16* SSDS, bf16* MIX, int b, int z, int g, int tid) {
    const int wave = tid >> 6, lane = tid & 63, l15 = lane & 15, l4 = lane >> 4;
    const size_t tok0 = (size_t)b * SEQ + (size_t)z * 64;
    LAS bf16* Cm = (LAS bf16*)lds;
    LAS bf16* Bm = (LAS bf16*)(lds + 17408);
    LAS bf16* Xt = (LAS bf16*)(lds + 34816);
    LAS float* CB = (LAS float*)(lds + 108544);
    LAS float* dts = (LAS float*)(lds + 125184);
    LAS float* acs = (LAS float*)(lds + 127232);
    LAS bf16* Lw = (LAS bf16*)(lds + 129280 + wave * 2304);
    LAS float* ssq = (LAS float*)(lds + 147712);
    { float dt, ac; dt_acum(DT, dt_bias, a_log, tok0, g * 8 + wave, lane, dt, ac); dts[wave * 64 + lane] = dt; acs[wave * 64 + lane] = ac; }
    __syncthreads();
#pragma unroll 1
    for (int it = 0; it < 4; ++it) {
        const int q = it * NT + tid, ch = q & 15, j = (q >> 4) & 63, mat = q >> 10; f32x4 a0, a1;
        conv8(PROJ, cw, cb, tok0 + j, z * 64 + j, 1024 + mat * 256 + g * 128 + ch * 8, a0, a1);
        u32x4 w; w.x = pk2(a0[0], a0[1]); w.y = pk2(a0[2], a0[3]); w.z = pk2(a1[0], a1[1]); w.w = pk2(a1[2], a1[3]);
        *(LAS u32x4*)((mat ? Cm : Bm) + j * 136 + ch * 8) = w;
    }
#pragma unroll 1
    for (int it = 0; it < 8; ++it) {
        const int q = it * NT + tid, j = q & 63, ch = q >> 6; f32x4 a0, a1;
        conv8(PROJ, cw, cb, tok0 + j, z * 64 + j, g * 512 + ch * 8, a0, a1);
        const float c = dts[(ch >> 3) * 64 + j];
        LAS bf16* dst = Xt + (ch * 8) * 72 + j;
        dst[0 * 72] = f2bf(a0[0] * c); dst[1 * 72] = f2bf(a0[1] * c); dst[2 * 72] = f2bf(a0[2] * c); dst[3 * 72] = f2bf(a0[3] * c);
        dst[4 * 72] = f2bf(a1[0] * c); dst[5 * 72] = f2bf(a1[1] * c); dst[6 * 72] = f2bf(a1[2] * c); dst[7 * 72] = f2bf(a1[3] * c);
    }
    __syncthreads();
    {
        const int mt = wave >> 1, nt0 = 2 * (wave & 1);
        f32x4 sc[2] = {(f32x4){0.f, 0.f, 0.f, 0.f}, (f32x4){0.f, 0.f, 0.f, 0.f}};
#pragma unroll
        for (int ks = 0; ks < 4; ++ks) {
            const bf16x8 xa = FRAG(Cm + (16 * mt + l15) * 136 + ks * 32 + 8 * l4);
#pragma unroll
            for (int n2 = 0; n2 < 2; ++n2) { const bf16x8 yb = FRAG(Bm + (16 * (nt0 + n2) + l15) * 136 + ks * 32 + 8 * l4); sc[n2] = mma(yb, xa, sc[n2]); }
        }
#pragma unroll
        for (int n2 = 0; n2 < 2; ++n2) { const int i = 16 * mt + l15, j0 = 16 * (nt0 + n2) + 4 * l4;
#pragma unroll
            for (int ii = 0; ii < 4; ++ii) CB[i * 65 + j0 + ii] = sc[n2][ii]; }
    }
    __syncthreads();
    const int r = wave, head = g * 8 + r;
    f32x4 acc[4][4];
#pragma unroll
    for (int mt = 0; mt < 4; ++mt)
#pragma unroll
        for (int nt = 0; nt < 4; ++nt) acc[mt][nt] = (f32x4){0.f, 0.f, 0.f, 0.f};
    const bf16* S = SSDS + ((size_t)((b * 16 + head) * 128 + z)) * 8192;
#pragma unroll
    for (int ks = 0; ks < 4; ++ks) {
        bf16x8 yb[4];
#pragma unroll
        for (int nt = 0; nt < 4; ++nt) yb[nt] = *(const bf16x8*)(S + (16 * nt + l15) * 128 + ks * 32 + 8 * l4);
#pragma unroll
        for (int mt = 0; mt < 4; ++mt) { const bf16x8 xa = FRAG(Cm + (16 * mt + l15) * 136 + ks * 32 + 8 * l4);
#pragma unroll
            for (int nt = 0; nt < 4; ++nt) acc[mt][nt] = mma(yb[nt], xa, acc[mt][nt]); }
    }
#pragma unroll
    for (int mt = 0; mt < 4; ++mt) { const float fs = expf(acs[r * 64 + 16 * mt + l15]);
#pragma unroll
        for (int nt = 0; nt < 4; ++nt) acc[mt][nt] = acc[mt][nt] * fs; }
#pragma unroll
    for (int mt = 0; mt < 4; ++mt) {
        const int i = 16 * mt + l15 + (int)opaque0(); const float ai = acs[r * 64 + i];
#pragma unroll
        for (int hh = 0; hh < 2; ++hh) {
            float lv[8];
#pragma unroll
            for (int k = 0; k < 8; ++k) { const int j = 16 * l4 + 8 * hh + k; const float e = expf(ai - acs[r * 64 + j]); lv[k] = (j <= i) ? CB[i * 65 + j] * e : 0.0f; }
            u32x4 w; w.x = pk2(lv[0], lv[1]); w.y = pk2(lv[2], lv[3]); w.z = pk2(lv[4], lv[5]); w.w = pk2(lv[6], lv[7]);
            *(LAS u32x4*)(Lw + l15 * 72 + 16 * l4 + 8 * hh) = w;
        }
        LDS_WAIT(); __builtin_amdgcn_wave_barrier();
#pragma unroll
        for (int ks = 0; ks < 2; ++ks) {
            const bf16x8 xa = FRAG(Lw + l15 * 72 + ks * 32 + 8 * l4);
#pragma unroll
            for (int nt = 0; nt < 4; ++nt) { const bf16x8 yb = FRAG(Xt + (64 * r + 16 * nt + l15) * 72 + ks * 32 + 8 * l4); acc[mt][nt] = mma(yb, xa, acc[mt][nt]); }
        }
        LDS_WAIT(); __builtin_amdgcn_wave_barrier();
    }
    const float dsk = dskip[head];
#pragma unroll
    for (int mt = 0; mt < 4; ++mt) {
        const int i = 16 * mt + l15; const float rdt = 1.0f / dts[r * 64 + i]; float sq = 0.f;
#pragma unroll
        for (int nt = 0; nt < 4; ++nt) {
            const int p0 = 16 * nt + 4 * l4;
            const u32x2 zraw = *(const u32x2*)(PROJ + (tok0 + i) * PLD + 4096 + g * 512 + r * 64 + p0);
            const float zz[4] = {lo16(zraw.x), hi16(zraw.x), lo16(zraw.y), hi16(zraw.y)};
#pragma unroll
            for (int ii = 0; ii < 4; ++ii) { const float x = bf2f(Xt[(64 * r + p0 + ii) * 72 + i]) * rdt; const float y = (acc[mt][nt][ii] + dsk * x) * silu_f(zz[ii]); acc[mt][nt][ii] = y; sq += y * y; }
        }
        sq += __shfl_xor(sq, 16); sq += __shfl_xor(sq, 32);
        if (l4 == 0) ssq[r * 64 + i] = sq;
    }
    __syncthreads();
#pragma unroll
    for (int mt = 0; mt < 4; ++mt) {
        const int i = 16 * mt + l15; float t = 0.f;
#pragma unroll
        for (int w = 0; w < 8; ++w) t += ssq[w * 64 + i];
        const float rstd = 1.0f / sqrtf(t * (1.0f / 512.0f) + LN_EPS);
#pragma unroll
        for (int nt = 0; nt < 4; ++nt) {
            const int col = g * 512 + r * 64 + 16 * nt + 4 * l4;
            const f32x4 gn = *(const f32x4*)(ngain + col);
            const f32x4 o = acc[mt][nt] * rstd * gn;
            u32x2 w; w.x = pk2(o[0], o[1]); w.y = pk2(o[2], o[3]);
            *(u32x2*)(MIX + (tok0 + i) * DM + 1024 + col) = w;
        }
    }
    __syncthreads();
}

#define XB_TMO      128
#define XB_XCNT(j)  (256  + 64 * (j))
#define XB_XSUB(j)  (1280 + 64 * (j))
#define XB_XGEN(j)  (2304 + 64 * (j))
#define XB_TOP      3328
#define XB_TOPGEN   3392
#define XCD_BAR_WORDS 3456
#define XB_SPIN_CAP (1u << 18)

__device__ __forceinline__ unsigned xb_ld(unsigned* p)              { return __hip_atomic_load(p, __ATOMIC_RELAXED, __HIP_MEMORY_SCOPE_AGENT); }
__device__ __forceinline__ unsigned xb_add(unsigned* p, unsigned v) { return __hip_atomic_fetch_add(p, v, __ATOMIC_RELAXED, __HIP_MEMORY_SCOPE_AGENT); }
__device__ __forceinline__ unsigned xb_xcc_id() { return (unsigned)__builtin_amdgcn_s_getreg((3 << 11) | 20) & 0xFu; }
#define XB_SPIN(cond, bar) do { unsigned _sp = 0; while (cond) { __builtin_amdgcn_s_sleep(1); \
    if ((++_sp & 255u) == 0u) { if (xb_ld(&(bar)[XB_TMO])) break; if (_sp > XB_SPIN_CAP) { atomicAdd(&(bar)[XB_TMO], 1u); break; } } } } while (0)

struct XcdBarrier {
    unsigned* bar; unsigned x;
    volatile LAS unsigned* st;
};

__device__ __forceinline__ XcdBarrier xcd_barrier_post(unsigned* bar, volatile LAS unsigned* st) {
    XcdBarrier b; b.bar = bar; b.x = xb_xcc_id(); b.st = st;
    if (threadIdx.x == 0) (void)xb_add(&bar[XB_XCNT(b.x)], 1u);
    return b;
}
__device__ __forceinline__ void xcd_barrier_complete(unsigned* bar, unsigned x, unsigned& nloc, unsigned& nx) {
    const unsigned G = gridDim.x * gridDim.y * gridDim.z;
    unsigned sum, cnt, mine, sp = 0u;
    for (;;) {
        sum = 0u; cnt = 0u; mine = 0u;
#pragma unroll
        for (unsigned j = 0; j < 16; ++j) { const unsigned c = xb_ld(&bar[XB_XCNT(j)]); sum += c; cnt += (c > 0u) ? 1u : 0u; mine = (j == x) ? c : mine; }
        if (sum == G) break;
        __builtin_amdgcn_s_sleep(1);
        if ((++sp & 255u) == 0u) { if (xb_ld(&bar[XB_TMO])) break; if (sp > XB_SPIN_CAP) { atomicAdd(&bar[XB_TMO], 1u); break; } }
    }
    nloc = mine > 0u ? mine : 1u; nx = cnt > 0u ? cnt : 1u;
}

__device__ __forceinline__ void xcd_barrier(const XcdBarrier& b) {
    asm volatile("s_waitcnt vmcnt(0)" ::: "memory");
    __syncthreads();
    if (threadIdx.x == 0) {
        unsigned* bar = b.bar;
        __builtin_amdgcn_s_waitcnt(0);
        unsigned nloc = b.st[0], nx = b.st[1];
        if (nloc == 0u) { xcd_barrier_complete(bar, b.x, nloc, nx); b.st[0] = nloc; b.st[1] = nx; }
        const unsigned old = xb_add(&bar[XB_XSUB(b.x)], 1u);
        const unsigned gen = old / nloc;
        if (old + 1u == (gen + 1u) * nloc) {
            __builtin_amdgcn_fence(__ATOMIC_RELEASE, "agent");
            asm volatile("s_waitcnt vmcnt(0)" ::: "memory");
            const unsigned og = xb_add(&bar[XB_TOP], 1u);
            const unsigned tg = og / nx;
            if (og + 1u == (tg + 1u) * nx) xb_add(&bar[XB_TOPGEN], 1u);
            else XB_SPIN(xb_ld(&bar[XB_TOPGEN]) == tg, bar);
            __builtin_amdgcn_fence(__ATOMIC_ACQUIRE, "agent");
            xb_add(&bar[XB_XGEN(b.x)], 1u);
            asm volatile("s_waitcnt vmcnt(0)" ::: "memory");
        } else {
            XB_SPIN(xb_ld(&bar[XB_XGEN(b.x)]) == gen, bar);
            __builtin_amdgcn_fence(__ATOMIC_ACQUIRE, "agent");
            asm volatile("s_waitcnt vmcnt(0)" ::: "memory");
        }
    }
    __syncthreads();
}


#ifndef DUMPC
#define DUMPC 0
#endif
__device__ __forceinline__ void dump_bf16(float* out, const bf16* src, size_t ld, size_t col0, int gtid, int nth) {
    for (size_t i = gtid; i < (size_t)M_TOK * DM; i += nth) { const size_t r = i >> 11, c = i & 2047; float v = bf2f(src[r * ld + col0 + c]); if (!(fabsf(v) < 1e30f)) v = 12345.0f; out[i] = v; }
}
struct Args { const void* in[24]; float* out; unsigned char* ws; };
typedef __attribute__((address_space(4))) const unsigned long long karg_t;
#define KARG(T, i) ((T)(__attribute__((address_space(1))) char*)(((karg_t*)__builtin_amdgcn_kernarg_segment_ptr())[(i) + oz]))
#define KF(i) KARG(const float*, i)
#define WSP(T, off) ((T)(KARG(unsigned char*, 25) + (off)))
__global__ void __launch_bounds__(NT, 2) fwd_megakernel(Args a_unused) {
    extern __shared__ __attribute__((aligned(16))) unsigned char lds_raw[];
    LAS unsigned char* lds = (LAS unsigned char*)lds_raw;
    cg::grid_group grid = cg::this_grid();
    XcdBarrier bar;
    { volatile LAS unsigned* misc = (volatile LAS unsigned*)(lds + MISC_OFF); if (threadIdx.x < 2) misc[threadIdx.x] = 0u; if (threadIdx.x == 2) *(volatile LAS unsigned*)(lds + 140000) = 0u; __syncthreads();
      const unsigned oz = opaque0(); bar = xcd_barrier_post((unsigned*)WSP(unsigned char*, WS_CTL), misc); }
    grid.sync();
#define SEAM() xcd_barrier(bar)
#ifndef GEMM_ALIGN
#define GEMM_ALIGN true
#endif
#ifndef SKIP_GEMM
#define SKIP_GEMM 0
#endif
#ifndef STOP_AFTER
#define STOP_AFTER 99
#endif
#define GEOM int tid_o = threadIdx.x; asm volatile("" : "+v"(tid_o)); const int tid = tid_o, lane = tid & 63, wave = __builtin_amdgcn_readfirstlane(tid >> 6); (void)lane; (void)wave; const int G = gridDim.x, bx = blockIdx.x, gw = bx * 8 + wave, NGW = G * 8, gtid = bx * NT + tid, nth = G * NT; (void)gw; (void)NGW; (void)gtid; (void)nth; const unsigned oz = opaque0()

    { GEOM; LAS float* scr = (LAS float*)(lds + wave * 8448);
      convert_ffn(KF(2), KF(3), KF(4), WSP(bf16*, WS_WGU), WSP(bf16*, WS_WD), scr, gw, NGW, lane);
      { const float* win = KF(7); const float* wout = KF(16); bf16* WIN = WSP(bf16*, WS_WIN); bf16* WOUT = WSP(bf16*, WS_WOUT);
        for (int it = gw; it < 32 * 216 + 32 * 64; it += NGW) {
            if (it < 32 * 216) { const int kb = it / 216, nb = it % 216; xpose_item(win, NIN, DM, WIN, kb * 64, nb * 32, nb * 32, scr, lane); }
            else { const int r = it - 32 * 216, kb = r / 64, nb = r % 64; xpose_item(wout, DM, DM, WOUT, kb * 64, nb * 32, nb * 32, scr, lane); }
        } }
      { const float* x = KF(0); bf16* XB = WSP(bf16*, WS_XB);
        for (size_t i = gtid; i < (size_t)M_TOK * DM / 8; i += nth) {
            const f32x4 p = ((const f32x4*)x)[2 * i], q = ((const f32x4*)x)[2 * i + 1];
            u32x4 w; w.x = pk2(p[0], p[1]); w.y = pk2(p[2], p[3]); w.z = pk2(q[0], q[1]); w.w = pk2(q[2], q[3]);
            ((u32x4*)XB)[i] = w;
        } }
      { const int* pos = KARG(const int*, 1); float* COS = WSP(float*, WS_COS); float* SIN = WSP(float*, WS_SIN);
        for (int idx = gtid; idx < M_TOK * 128; idx += nth) {
            const int tok = idx >> 7, f = idx & 127;
            const float invf = exp2f(-((float)f * (1.0f / 127.0f)) * 13.287712379549449f);
            const double rev = (double)pos[tok] * (double)invf * 0.15915494309189535;
            const float fr = (float)(rev - rint(rev));
            COS[idx] = __builtin_amdgcn_cosf(fr); SIN[idx] = __builtin_amdgcn_sinf(fr);
        } }
      if (SKIP_GEMM) { bf16* BIGW = WSP(bf16*, WS_BIG); float* DTW = WSP(float*, WS_DT);
        for (size_t i = gtid; i < (size_t)M_TOK * PLD; i += nth) { unsigned hsh = (unsigned)i * 2654435761u; hsh ^= hsh >> 15; hsh *= 2246822519u; hsh ^= hsh >> 13; BIGW[i] = f2bf((float)(hsh & 0xffffu) * (1.0f / 65536.0f) - 0.5f); }
        for (size_t i = gtid; i < (size_t)M_TOK * 16; i += nth) { unsigned hsh = (unsigned)i * 2654435761u; hsh ^= hsh >> 15; hsh *= 2246822519u; hsh ^= hsh >> 13; DTW[i] = (float)(hsh & 0xffffu) * (1.0f / 65536.0f) - 0.5f; } }
    }
    SEAM(); if (STOP_AFTER == 0) return;

    { GEOM; pg8::Gemm g{WSP(const bf16*, WS_XB), WSP(const bf16*, WS_WGU), M_TOK, NGU, DM}; pg8::StaticOrder S; S.init(M_TOK, NGU, G, bx); pg8::EpiSwiglu E{WSP(bf16*, WS_BIG), DFF};
      if (!SKIP_GEMM) pg8::gemm_phase<pg8::EpiSwiglu, pg8::StaticOrder, GEMM_ALIGN, true>(lds, g, S, E); }
    SEAM(); if (STOP_AFTER == 1) return;
    { GEOM; pg8::Gemm g{WSP(const bf16*, WS_BIG), WSP(const bf16*, WS_WD), M_TOK, DM, DFF}; pg8::StaticOrder S; S.init(M_TOK, DM, G, bx); pg8::EpiRes E{KF(0), KARG(float*, 24), DM, ALPHA, 0.5f};
      if (!SKIP_GEMM) pg8::gemm_phase<pg8::EpiRes, pg8::StaticOrder, GEMM_ALIGN, true>(lds, g, S, E); }
    SEAM(); if (STOP_AFTER == 2) return;
    { GEOM; ln_rows<true>(KARG(float*, 24), KF(5), KF(6), WSP(bf16*, WS_XB), gw, NGW, lane); }
    SEAM(); if (STOP_AFTER == 3) return;
    { GEOM; pg8::Gemm g{WSP(const bf16*, WS_XB), WSP(const bf16*, WS_WIN), M_TOK, NINP, DM}; pg8::StaticOrder S; S.init(M_TOK, NINP, G, bx);
      pg8::EpiInProj E{WSP(bf16*, WS_BIG), WSP(const float*, WS_COS), WSP(const float*, WS_SIN), WSP(float*, WS_DT)};
      if (!SKIP_GEMM) pg8::gemm_phase<pg8::EpiInProj, pg8::StaticOrder, GEMM_ALIGN, true>(lds, g, S, E);
#ifdef DIAGMODE
      { volatile LAS unsigned* cnt = (volatile LAS unsigned*)(lds + 140000); if (lane == 0) atomicAdd((unsigned*)(lds_raw + 140000), 1u); __syncthreads(); const unsigned v = *cnt; WSP(float*, WS_XB)[gtid] = (float)v; }
#endif
    }
    SEAM();
#ifdef DIAGMODE
    { GEOM; const float* dg = WSP(const float*, WS_XB); float* o = KARG(float*, 24); for (size_t i = gtid; i < (size_t)M_TOK * DM; i += nth) o[i] = dg[i % nth]; return; }
#endif
    if (STOP_AFTER == 4) { GEOM; dump_bf16(KARG(float*, 24), WSP(const bf16*, WS_BIG), PLD, DUMPC, gtid, nth); return; }
#ifdef P5_TWICE
    for (int rep = 0; rep < 2; ++rep) {
#endif
    { GEOM; const bf16* BIG = WSP(const bf16*, WS_BIG);
      for (int u = bx; u < 1536; u += G) {
        if (u < 1024) ret_a_unit(lds, BIG, WSP(bf16*, WS_RETS), u >> 9, (u >> 2) & 127, u & 3, tid);
        else { const int v = u - 1024; ssd_a_unit(lds, BIG, WSP(const float*, WS_DT), KF(10), KF(11), KF(12), KF(13), WSP(bf16*, WS_SSDS), WSP(float*, WS_TOT), v >> 8, (v >> 1) & 127, v & 1, tid); }
      } }
#ifdef P5_TWICE
    if (rep == 0) SEAM(); }
#endif
#ifdef DBG_FLAG
    { GEOM; unsigned* FL = (unsigned*)WSP(unsigned char*, WS_CTL + 32768); if (tid == 511) FL[bx * 16] = 5u; }
    SEAM();
    { GEOM; const unsigned* FL = (const unsigned*)WSP(unsigned char*, WS_CTL + 32768); int bad = 0; for (int k = 0; k < G; ++k) bad += (FL[k * 16] != 5u);
      float* o = KARG(float*, 24); for (size_t i = gtid; i < (size_t)M_TOK * DM; i += nth) o[i] = 1000.0f * (float)bad; return; }
#endif
    SEAM(); if (STOP_AFTER == 5) { GEOM; dump_bf16(KARG(float*, 24), DUMPC == 2 ? WSP(const bf16*, WS_XB) : DUMPC ? WSP(const bf16*, WS_SSDS) : WSP(const bf16*, WS_RETS), DM, 0, gtid, nth); return; }
    { GEOM; scan_phase(WSP(bf16*, WS_RETS), WSP(bf16*, WS_SSDS), WSP(const float*, WS_TOT), gtid, nth); }
    SEAM(); if (STOP_AFTER == 6) { GEOM; dump_bf16(KARG(float*, 24), DUMPC ? WSP(const bf16*, WS_SSDS) : WSP(const bf16*, WS_RETS), DM, 0, gtid, nth); return; }
    { GEOM; const bf16* BIG = WSP(const bf16*, WS_BIG); bf16* XB = WSP(bf16*, WS_XB);
      for (int u = bx; u < 1536; u += G) {
        if (u < 1024) ret_c_unit(lds, BIG, WSP(const bf16*, WS_RETS), KF(8), KF(9), XB, u >> 9, (u >> 2) & 127, u & 3, tid);
        else { const int v = u - 1024; ssd_c_unit(lds, BIG, WSP(const float*, WS_DT), KF(10), KF(11), KF(12), KF(13), KF(14), KF(15), WSP(const bf16*, WS_SSDS), XB, v >> 8, (v >> 1) & 127, v & 1, tid); }
      } }
    SEAM(); if (STOP_AFTER == 7) { GEOM; dump_bf16(KARG(float*, 24), WSP(const bf16*, WS_XB), DM, 0, gtid, nth); return; }
    { GEOM; pg8::Gemm g{WSP(const bf16*, WS_XB), WSP(const bf16*, WS_WOUT), M_TOK, DM, DM}; pg8::StaticOrder S; S.init(M_TOK, DM, G, bx); float* out = KARG(float*, 24); pg8::EpiRes E{out, out, DM, ALPHA, 1.0f};
      if (!SKIP_GEMM) pg8::gemm_phase<pg8::EpiRes, pg8::StaticOrder, GEMM_ALIGN, true>(lds, g, S, E); }
    SEAM(); if (STOP_AFTER == 8) return;
    { GEOM; ln_rows<true>(KARG(float*, 24), KF(17), KF(18), WSP(bf16*, WS_XB), gw, NGW, lane);
      LAS float* scr = (LAS float*)(lds + wave * 8448);
      convert_ffn(KF(19), KF(20), KF(21), WSP(bf16*, WS_WGU), WSP(bf16*, WS_WD), scr, gw, NGW, lane); }
    SEAM(); if (STOP_AFTER == 9) return;
    { GEOM; pg8::Gemm g{WSP(const bf16*, WS_XB), WSP(const bf16*, WS_WGU), M_TOK, NGU, DM}; pg8::StaticOrder S; S.init(M_TOK, NGU, G, bx); pg8::EpiSwiglu E{WSP(bf16*, WS_BIG), DFF};
      if (!SKIP_GEMM) pg8::gemm_phase<pg8::EpiSwiglu, pg8::StaticOrder, GEMM_ALIGN, true>(lds, g, S, E); }
    SEAM(); if (STOP_AFTER == 10) return;
    { GEOM; pg8::Gemm g{WSP(const bf16*, WS_BIG), WSP(const bf16*, WS_WD), M_TOK, DM, DFF}; pg8::StaticOrder S; S.init(M_TOK, DM, G, bx); float* out = KARG(float*, 24); pg8::EpiRes E{out, out, DM, ALPHA, 0.5f};
      if (!SKIP_GEMM) pg8::gemm_phase<pg8::EpiRes, pg8::StaticOrder, GEMM_ALIGN, true>(lds, g, S, E); }
    SEAM(); if (STOP_AFTER == 11) return;
    { GEOM; ln_rows<false>(KARG(float*, 24), KF(22), KF(23), WSP(bf16*, WS_XB), gw, NGW, lane); }
}

extern "C" void kernel_launch(void* const* d_in, const int* in_sizes, int n_in, void* d_out, int out_size, void* d_ws, size_t ws_size, hipStream_t stream) {
    static int grid = 0;
    if (grid == 0) {
        if (n_in != 24 || in_sizes[0] != M_TOK * DM || out_size != M_TOK * DM || ws_size < WS_END) {
            fprintf(stderr, "kernel_launch: unexpected problem (n_in %d, in0 %d, out %d, ws %zu); nothing launched\n", n_in, n_in > 0 ? in_sizes[0] : -1, out_size, ws_size); grid = -1; return; }
        int dev = 0, cus = 0, per_cu = 0;
        (void)hipGetDevice(&dev); (void)hipDeviceGetAttribute(&cus, hipDeviceAttributeMultiprocessorCount, dev);
        (void)hipFuncSetAttribute((const void*)fwd_megakernel, hipFuncAttributeMaxDynamicSharedMemorySize, LDS_BYTES);
        if (hipOccupancyMaxActiveBlocksPerMultiprocessor(&per_cu, (const void*)fwd_megakernel, NT, LDS_BYTES) != hipSuccess || per_cu < 1) { per_cu = 1; (void)hipGetLastError(); }
        if (cus < 1) cus = 256;
        grid = cus * per_cu;
    }
    if (grid < 0) return;
    if (hipMemsetAsync((char*)d_ws + WS_CTL, 0, CTL_ZERO_BYTES, stream) != hipSuccess) { fprintf(stderr, "kernel_launch: memset of the barrier words failed\n"); return; }
    Args a{};
    for (int i = 0; i < 24; ++i) a.in[i] = d_in[i];
    a.out = (float*)d_out; a.ws = (unsigned char*)d_ws;
    void* args[] = {&a};
    hipError_t e = hipLaunchCooperativeKernel((const void*)fwd_megakernel, dim3(grid), dim3(NT), args, LDS_BYTES, stream);
    if (e != hipSuccess) fprintf(stderr, "cooperative launch failed: %s (grid %d)\n", hipGetErrorString(e), grid);
}
```

```cpp
#include <hip/hip_runtime.h>
#include <hip/hip_cooperative_groups.h>
#include <cstdio>
#include <cstdint>
namespace cg = cooperative_groups;
namespace pg8 {
#define PG8_LAS __attribute__((address_space(3)))
typedef unsigned short bf16_t;
typedef short bf16x8 __attribute__((ext_vector_type(8)));
typedef float f32x4 __attribute__((ext_vector_type(4)));
typedef unsigned u32x4 __attribute__((ext_vector_type(4)));
constexpr int BM = 256, BK = 64, HALF = 128, HTB = HALF * BK * 2  , STAGE_BYTES = 8 * HTB, NXCD = 8, WGM = 8;

__host__ __device__ __forceinline__ int lds_byte(int r, int c) { const int st = (r >> 4) * 2 + (c >> 5), rr = r & 15, cc = c & 31, ob = rr * 64 + cc * 2; return st * 1024 + (ob ^ (((ob >> 9) & 1) << 5)); }
__host__ __device__ __forceinline__ void stage_rc(int b, int& R, int& C) { const int st = b / 1024, sb = b % 1024, swz = sb ^ (((sb >> 9) & 1) << 5); R = (st >> 1) * 16 + swz / 64; C = (st & 1) * 32 + (swz % 64) / 2; }
__host__ __device__ __forceinline__ int perm32(int rho) { const int n = rho >> 4, i = rho & 15; return 8 * (i >> 2) + 4 * n + (i & 3); }

struct Unit { int pm, pn; };
struct Gemm { const bf16_t* A; const bf16_t* Bt; int M, N, K; };

struct StaticOrder {
    int nM, nN, nwg, G, c;
    __host__ __device__ void init(int M, int N, int G_, int c_) { nM = M / BM; nN = N / BM; nwg = nM * nN; G = G_; c = c_; }
    __host__ __device__ bool next(int i, Unit& u) const {
        const long L = (long)i * G + c; if (L >= nwg) return false;
        int wgid = (int)L; { const int q = nwg / NXCD, r = nwg % NXCD, xcd = wgid % NXCD, off = wgid / NXCD; wgid = (xcd < r ? xcd * (q + 1) : r * (q + 1) + (xcd - r) * q) + off; }
        const int nig = WGM * nN, gid = wgid / nig, fm = gid * WGM, gsz = (nM - fm) < WGM ? (nM - fm) : WGM;
        u.pm = fm + ((wgid % nig) % gsz); u.pn = (wgid % nig) / gsz; return true;
    }
    __device__ __forceinline__ void a_ready(const Unit&) const {}
    __device__ __forceinline__ void done(const Unit&) const {}
};

typedef float cvt_f32x2 __attribute__((ext_vector_type(2)));
typedef __bf16 cvt_bf16x2 __attribute__((ext_vector_type(2)));
__device__ __forceinline__ unsigned cvt_pk_bf16(float lo, float hi) { const cvt_f32x2 v = {lo, hi}; return __builtin_bit_cast(unsigned, __builtin_convertvector(v, cvt_bf16x2)); }

__device__ __forceinline__ float swi(float g, float u) { return g * u * __builtin_amdgcn_rcpf(1.0f + __expf(-g)); }
struct EpiSwiglu {
    static constexpr bool PERM = true, AFTER_DRAIN = false;
    bf16_t* H; int ldh;
    __device__ __forceinline__ void operator()(const f32x4 (&acc)[2][2][4][2], const Unit& u, int wr, int wc, int fr, int fq) const {
        const int row0 = u.pm * BM + wr * 64 + fr, col0 = u.pn * 128 + wc * 32 + 8 * fq;
#pragma unroll
        for (int ai = 0; ai < 2; ++ai)
#pragma unroll
            for (int m = 0; m < 4; ++m) {
                bf16_t* p = H + (size_t)(row0 + ai * HALF + m * 16) * ldh + col0;
                const f32x4 g0 = acc[ai][0][m][0], g1 = acc[ai][0][m][1], u0 = acc[ai][1][m][0], u1 = acc[ai][1][m][1];
                u32x4 w;
                w.x = cvt_pk_bf16(swi(g0[0], u0[0]), swi(g0[1], u0[1])); w.y = cvt_pk_bf16(swi(g0[2], u0[2]), swi(g0[3], u0[3]));
                w.z = cvt_pk_bf16(swi(g1[0], u1[0]), swi(g1[1], u1[1])); w.w = cvt_pk_bf16(swi(g1[2], u1[2]), swi(g1[3], u1[3]));
                *(u32x4*)p = w;
            }
    }
};
struct EpiRes {
    static constexpr bool PERM = false, AFTER_DRAIN = false;
    const float* res; float* out; int ld; float alpha, s;
    __device__ __forceinline__ void operator()(const f32x4 (&acc)[2][2][4][2], const Unit& u, int wr, int wc, int fr, int fq) const {
        const int row0 = u.pm * BM + wr * 64 + fr, col0 = u.pn * BM + wc * 32 + 4 * fq;
#pragma unroll
        for (int ai = 0; ai < 2; ++ai)
#pragma unroll
            for (int m = 0; m < 4; ++m) {
                const size_t off = (size_t)(row0 + ai * HALF + m * 16) * ld + col0;
#pragma unroll
                for (int bj = 0; bj < 2; ++bj)
#pragma unroll
                    for (int n = 0; n < 2; ++n) {
                        const f32x4 r = *(const f32x4*)(res + off + bj * HALF + n * 16);
                        *(f32x4*)(out + off + bj * HALF + n * 16) = r * alpha + acc[ai][bj][m][n] * s;
                    }
            }
    }
};
struct EpiInProj {
    static constexpr bool PERM = true, AFTER_DRAIN = false;
    bf16_t* P; const float* cs; const float* sn; float* DT;
    __device__ __forceinline__ void operator()(const f32x4 (&acc)[2][2][4][2], const Unit& u, int wr, int wc, int fr, int fq) const {
        const int row0 = u.pm * BM + wr * 64 + fr, pn = u.pn;
#pragma unroll
        for (int ai = 0; ai < 2; ++ai)
#pragma unroll
            for (int m = 0; m < 4; ++m) {
                const int row = row0 + ai * HALF + m * 16;
#pragma unroll
                for (int bj = 0; bj < 2; ++bj) {
                    const int colt = bj * HALF + wc * 32 + 8 * fq;
                    f32x4 v0 = acc[ai][bj][m][0], v1 = acc[ai][bj][m][1];
                    if (pn < 8) {
                        const f32x4 c = *(const f32x4*)(cs + (size_t)row * 128 + (colt >> 1)), s = *(const f32x4*)(sn + (size_t)row * 128 + (colt >> 1));
                        const float sc = pn >= 4 ? 0.0625f : 1.0f;
                        f32x4 a, b;
                        a[0] = (v0[0] * c[0] - v0[1] * s[0]) * sc; a[1] = (v0[1] * c[0] + v0[0] * s[0]) * sc;
                        a[2] = (v0[2] * c[1] - v0[3] * s[1]) * sc; a[3] = (v0[3] * c[1] + v0[2] * s[1]) * sc;
                        b[0] = (v1[0] * c[2] - v1[1] * s[2]) * sc; b[1] = (v1[1] * c[2] + v1[0] * s[2]) * sc;
                        b[2] = (v1[2] * c[3] - v1[3] * s[3]) * sc; b[3] = (v1[3] * c[3] + v1[2] * s[3]) * sc;
                        v0 = a; v1 = b;
                    }
                    if (pn < 26) {
                        u32x4 w; w.x = cvt_pk_bf16(v0[0], v0[1]); w.y = cvt_pk_bf16(v0[2], v0[3]); w.z = cvt_pk_bf16(v1[0], v1[1]); w.w = cvt_pk_bf16(v1[2], v1[3]);
                        *(u32x4*)(P + (size_t)row * 6672 + pn * BM + colt) = w;
                    } else if (colt < 16) {
                        *(f32x4*)(DT + (size_t)row * 16 + colt) = v0; *(f32x4*)(DT + (size_t)row * 16 + colt + 4) = v1;
                    }
                }
            }
    }
};
template <class Epi, class Sched, bool ALIGN_EPI = false, bool SP2 = false>
__device__ __forceinline__ void gemm_phase(PG8_LAS unsigned char* lds, const Gemm g, const Sched& S, const Epi& E) {
    int tid_o = threadIdx.x; asm volatile("" : "+v"(tid_o));
    const int tid = tid_o, wid = __builtin_amdgcn_readfirstlane(tid >> 6), lane = tid & 63, wr = wid >> 2, wc = wid & 3, fr = lane & 15, fq = lane >> 4;
    const int K = g.K, nt = K / BK;
    unsigned voffA[2], voffB[2];
#pragma unroll
    for (int i = 0; i < 2; ++i) { int R, C; stage_rc(tid * 16 + i * 8192, R, C); const int Rb = Epi::PERM ? ((R & ~31) + perm32(R & 31)) : R;
        voffA[i] = (unsigned)(R * K + C) * 2u; voffB[i] = (unsigned)(Rb * K + C) * 2u; }
    const size_t kstep = (size_t)(BK * 2);
    const size_t hstep = (size_t)HALF * K * 2;
    const size_t tstep = 2 * hstep;
    const unsigned ldsw = (unsigned)wid * 1024u;
    const int aoff = lds_byte(wr * 64 + fr, fq * 8), boff = lds_byte(wc * 32 + fr, fq * 8);
#define PG8_SA(b, h) (((b) * 2 + (h)) * HTB)
#define PG8_SB(b, h) ((4 + (b) * 2 + (h)) * HTB)
#define PG8_STAGE(bufoff, gbase, voff) do { _Pragma("unroll") for (int _i = 0; _i < 2; ++_i) \
        __builtin_amdgcn_global_load_lds((const unsigned*)((const char*)(gbase) + (voff)[_i]), (PG8_LAS unsigned*)(lds + (bufoff) + ldsw + _i * 8192), 16, 0, 0); } while (0)
#define PG8_LDA(dst, b, h) do { _Pragma("unroll") for (int m = 0; m < 4; ++m) _Pragma("unroll") for (int k = 0; k < 2; ++k) dst[m][k] = *(const PG8_LAS bf16x8*)(lds + PG8_SA(b, h) + aoff + m * 2048 + k * 1024); } while (0)
#define PG8_LDB(dst, b, h) do { _Pragma("unroll") for (int n = 0; n < 2; ++n) _Pragma("unroll") for (int k = 0; k < 2; ++k) dst[n][k] = *(const PG8_LAS bf16x8*)(lds + PG8_SB(b, h) + boff + n * 2048 + k * 1024); } while (0)
#define PG8_MMA(ai, bj, At, Bt) do { __builtin_amdgcn_s_setprio(1); _Pragma("unroll") for (int m = 0; m < 4; ++m) _Pragma("unroll") for (int n = 0; n < 2; ++n) _Pragma("unroll") for (int k = 0; k < 2; ++k) \
        acc[ai][bj][m][n] = __builtin_amdgcn_mfma_f32_16x16x32_bf16(Bt[n][k], At[m][k], acc[ai][bj][m][n], 0, 0, 0); __builtin_amdgcn_s_setprio(0); } while (0)
#define PG8_WAIT_V(n) asm volatile("s_waitcnt vmcnt(" #n ")" ::: "memory")
#define PG8_WAIT_L(n) asm volatile("s_waitcnt lgkmcnt(" #n ")" ::: "memory")
#define PG8_BAR __builtin_amdgcn_s_barrier()
#define PG8_SCHED __builtin_amdgcn_sched_barrier(0)
    Unit cur, nxt; int ui = 0;
    if (!S.next(0, cur)) return;
    f32x4 acc[2][2][4][2];
#pragma unroll
    for (int a = 0; a < 2; ++a)
#pragma unroll
        for (int b = 0; b < 2; ++b)
#pragma unroll
            for (int m = 0; m < 4; ++m)
#pragma unroll
                for (int n = 0; n < 2; ++n) acc[a][b][m][n] = (f32x4){0.f, 0.f, 0.f, 0.f};
    bf16x8 At[4][2], B0[2][2], B1[2][2];
    const char* cA = (const char*)g.A + (size_t)cur.pm * tstep; const char* cB = (const char*)g.Bt + (size_t)cur.pn * tstep;
    S.a_ready(cur);
    if constexpr (SP2) {
        PG8_STAGE(PG8_SB(0, 0), cB, voffB); PG8_STAGE(PG8_SB(0, 1), cB + hstep, voffB); PG8_STAGE(PG8_SA(0, 0), cA, voffA); PG8_STAGE(PG8_SA(0, 1), cA + hstep, voffA);
        if (wr == 1) PG8_BAR;
        PG8_WAIT_V(2); PG8_BAR;
        PG8_STAGE(PG8_SB(1, 0), cB + kstep, voffB); PG8_STAGE(PG8_SA(1, 0), cA + kstep, voffA); PG8_STAGE(PG8_SB(1, 1), cB + hstep + kstep, voffB);
        PG8_WAIT_V(6); PG8_BAR;
    } else {
        PG8_STAGE(PG8_SB(0, 0), cB, voffB); PG8_STAGE(PG8_SA(0, 0), cA, voffA); PG8_STAGE(PG8_SB(0, 1), cB + hstep, voffB); PG8_STAGE(PG8_SA(0, 1), cA + hstep, voffA);
        if (wr == 1) PG8_BAR;
        PG8_WAIT_V(4); PG8_BAR;
        PG8_STAGE(PG8_SB(1, 0), cB + kstep, voffB); PG8_STAGE(PG8_SA(1, 0), cA + kstep, voffA); PG8_STAGE(PG8_SB(1, 1), cB + hstep + kstep, voffB);
        PG8_WAIT_V(6); PG8_BAR;
    }
    for (;;) {
        const bool has_next = S.next(ui + 1, nxt);
        const char* nA = has_next ? (const char*)g.A + (size_t)nxt.pm * tstep : cA; const char* nB = has_next ? (const char*)g.Bt + (size_t)nxt.pn * tstep : cB;
        for (int t = 0; t < nt; t += 2) {
            const bool last = (t == nt - 2);
            const char* a1 = cA + (size_t)(t + 1) * kstep;
            const char* a2 = last ? nA : cA + (size_t)(t + 2) * kstep; const char* b2 = last ? nB : cB + (size_t)(t + 2) * kstep;
            const char* a3 = a2 + kstep; const char* b3 = b2 + kstep;
            if (last && has_next) S.a_ready(nxt);
            if constexpr (SP2) {
            PG8_LDB(B0, 0, 0); PG8_LDB(B1, 0, 1); PG8_SCHED; PG8_LDA(At, 0, 0); PG8_STAGE(PG8_SA(1, 1), a1 + hstep, voffA);
            PG8_WAIT_V(8); PG8_WAIT_L(0); PG8_BAR; PG8_MMA(0, 0, At, B0); PG8_MMA(0, 1, At, B1); PG8_BAR; PG8_SCHED;
            PG8_LDA(At, 0, 1); PG8_STAGE(PG8_SB(0, 0), b2, voffB); PG8_STAGE(PG8_SB(0, 1), b2 + hstep, voffB); PG8_STAGE(PG8_SA(0, 0), a2, voffA);
            PG8_WAIT_V(8); PG8_WAIT_L(0); PG8_BAR; PG8_MMA(1, 0, At, B0); PG8_MMA(1, 1, At, B1); PG8_BAR; PG8_SCHED;
            PG8_LDB(B0, 1, 0); PG8_LDB(B1, 1, 1); PG8_SCHED; PG8_LDA(At, 1, 0); PG8_STAGE(PG8_SA(0, 1), a2 + hstep, voffA);
            PG8_WAIT_V(8); PG8_WAIT_L(0); PG8_BAR; PG8_MMA(0, 0, At, B0); PG8_MMA(0, 1, At, B1); PG8_BAR; PG8_SCHED;
            PG8_LDA(At, 1, 1); PG8_STAGE(PG8_SB(1, 0), b3, voffB); PG8_STAGE(PG8_SB(1, 1), b3 + hstep, voffB); PG8_STAGE(PG8_SA(1, 0), a3, voffA);
            PG8_WAIT_V(8); PG8_WAIT_L(0); PG8_BAR; PG8_MMA(1, 0, At, B0); PG8_MMA(1, 1, At, B1); PG8_BAR; PG8_SCHED;
            } else {
            PG8_LDB(B0, 0, 0); PG8_SCHED; PG8_LDA(At, 0, 0); PG8_STAGE(PG8_SA(1, 1), a1 + hstep, voffA);
            PG8_WAIT_L(8); PG8_BAR; PG8_WAIT_L(0); PG8_MMA(0, 0, At, B0); PG8_BAR; PG8_SCHED;
            PG8_LDB(B1, 0, 1); PG8_STAGE(PG8_SB(0, 0), b2, voffB);
            PG8_BAR; PG8_WAIT_L(0); PG8_MMA(0, 1, At, B1); PG8_BAR;
            PG8_LDA(At, 0, 1); PG8_STAGE(PG8_SA(0, 0), a2, voffA);
            PG8_BAR; PG8_WAIT_L(0); PG8_MMA(1, 0, At, B0); PG8_BAR; PG8_SCHED;
            PG8_STAGE(PG8_SB(0, 1), b2 + hstep, voffB);
            PG8_WAIT_V(6); PG8_BAR; PG8_MMA(1, 1, At, B1); PG8_BAR;
            PG8_LDB(B0, 1, 0); PG8_SCHED; PG8_LDA(At, 1, 0); PG8_STAGE(PG8_SA(0, 1), a2 + hstep, voffA);
            PG8_WAIT_L(8); PG8_BAR; PG8_WAIT_L(0); PG8_MMA(0, 0, At, B0); PG8_BAR; PG8_SCHED;
            PG8_LDB(B1, 1, 1); PG8_STAGE(PG8_SB(1, 0), b3, voffB);
            PG8_BAR; PG8_WAIT_L(0); PG8_MMA(0, 1, At, B1); PG8_BAR;
            PG8_LDA(At, 1, 1); PG8_STAGE(PG8_SA(1, 0), a3, voffA);
            PG8_BAR; PG8_WAIT_L(0); PG8_MMA(1, 0, At, B0); PG8_BAR; PG8_SCHED;
            PG8_STAGE(PG8_SB(1, 1), b3 + hstep, voffB);
            PG8_WAIT_V(6); PG8_BAR; PG8_MMA(1, 1, At, B1); PG8_BAR;
            }
        }
        if constexpr (ALIGN_EPI) { if (wr == 0) PG8_BAR; }
        if constexpr (!Epi::AFTER_DRAIN) { E(acc, cur, wr, wc, fr, fq); S.done(cur); }
        if (!has_next) break;
#pragma unroll
        for (int a = 0; a < 2; ++a)
#pragma unroll
            for (int b = 0; b < 2; ++b)
#pragma unroll
                for (int m = 0; m < 4; ++m)
#pragma unroll
                    for (int n = 0; n < 2; ++n) acc[a][b][m][n] = (f32x4){0.f, 0.f, 0.f, 0.f};
        cur = nxt; cA = nA; cB = nB; ++ui;
        if constexpr (ALIGN_EPI) { if (wr == 1) PG8_BAR; }
    }
    PG8_WAIT_V(0);
    if constexpr (!ALIGN_EPI) { if (wr == 0) PG8_BAR; }
    PG8_BAR;
    if constexpr (Epi::AFTER_DRAIN) { E.fused(acc, cur, wr, wc, fr, fq, lds, wid, lane); S.done(cur); }
#undef PG8_SA
#undef PG8_SB
#undef PG8_STAGE
#undef PG8_LDA
#undef PG8_LDB
#undef PG8_MMA
#undef PG8_WAIT_V
#undef PG8_WAIT_L
#undef PG8_BAR
#undef PG8_SCHED
}
}

#define LAS __attribute__((address_space(3)))
typedef unsigned short bf16;
typedef unsigned u32x4 __attribute__((ext_vector_type(4)));
typedef unsigned u32x2 __attribute__((ext_vector_type(2)));
typedef float f32x4 __attribute__((ext_vector_type(4)));
typedef short bf16x8 __attribute__((ext_vector_type(8)));

constexpr int NT = 512;
constexpr int M_TOK = 16384, SEQ = 8192, DM = 2048, DFF = 5632, NGU = 11264, NIN = 6672, NINP = 6912, PLD = 6672;
constexpr float LN_EPS = 1e-5f;
constexpr float ALPHA = 1.189207115002721f;
constexpr size_t MiB = (size_t)1 << 20;
constexpr size_t WS_RETS = 0, WS_SSDS = 128 * MiB, WS_WGU = 0, WS_WD = 44 * MiB, WS_WIN = 66 * MiB, WS_COS = 93 * MiB, WS_SIN = 101 * MiB,
                 WS_WOUT = 192 * MiB, WS_XB = 200 * MiB, WS_BIG = 264 * MiB, WS_DT = 473 * MiB, WS_TOT = 474 * MiB, WS_CTL = 475 * MiB, WS_END = 476 * MiB;
constexpr size_t CTL_ZERO_BYTES = 65536;
constexpr int MISC_OFF = 152064;
constexpr int LDS_BYTES = 153600;

__device__ __forceinline__ float lo16(unsigned w) { return __uint_as_float(w << 16); }
__device__ __forceinline__ float hi16(unsigned w) { return __uint_as_float(w & 0xffff0000u); }
__device__ __forceinline__ float bf2f(bf16 h) { return __uint_as_float((unsigned)h << 16); }
__device__ __forceinline__ bf16 f2bf(float f) { unsigned u = __float_as_uint(f); return (bf16)((u + 0x7fffu + ((u >> 16) & 1u)) >> 16); }
__device__ __forceinline__ unsigned pk2(float a, float b) { return pg8::cvt_pk_bf16(a, b); }
__device__ __forceinline__ float wave_sum(float v) {
#pragma unroll
    for (int o = 1; o < 64; o <<= 1) v += __shfl_xor(v, o);
    return v;
}
__device__ __forceinline__ float silu_f(float x) { return x * __builtin_amdgcn_rcpf(1.0f + __expf(-x)); }
__device__ __forceinline__ f32x4 mma(bf16x8 y, bf16x8 x, f32x4 c) { return __builtin_amdgcn_mfma_f32_16x16x32_bf16(y, x, c, 0, 0, 0); }
__device__ __forceinline__ unsigned opaque0() { unsigned z; asm volatile("s_mov_b32 %0, 0" : "=s"(z)); return z; }
#define LDS_WAIT() asm volatile("s_waitcnt lgkmcnt(0)" ::: "memory")
#define FRAG(p) (*(const LAS bf16x8*)(p))

__device__ __forceinline__ void xpose_item(const float* W, int Nsrc, int K, bf16* WT, int k0, int n0, int drow0, LAS float* scr, int lane) {
    const int nn = n0 + (lane & 31);
#pragma unroll 8
    for (int i = 0; i < 32; ++i) { const int kk = 2 * i + (lane >> 5); scr[kk * 33 + (lane & 31)] = nn < Nsrc ? W[(size_t)(k0 + kk) * Nsrc + nn] : 0.0f; }
    LDS_WAIT();
    const int c = lane & 7;
#pragma unroll
    for (int j = 0; j < 4; ++j) { const int n = (lane >> 3) + 8 * j; const LAS float* s = scr + (8 * c) * 33 + n;
        u32x4 o; o.x = pk2(s[0 * 33], s[1 * 33]); o.y = pk2(s[2 * 33], s[3 * 33]); o.z = pk2(s[4 * 33], s[5 * 33]); o.w = pk2(s[6 * 33], s[7 * 33]);
        *(u32x4*)(WT + (size_t)(drow0 + n) * K + k0 + 8 * c) = o; }
    LDS_WAIT();
}
__device__ __forceinline__ void convert_ffn(const float* wg, const float* wu, const float* wd, bf16* WGU, bf16* WD, LAS float* scr, int gw, int NGW, int lane) {
    for (int it = gw; it < 3 * 5632; it += NGW) {
        int r = it;
        if (r < 2 * 5632) { const int up = r >= 5632 ? 1 : 0; r -= up * 5632; const int kb = r / 176, nb = r % 176, n0 = nb * 32;
            xpose_item(up ? wu : wg, DFF, DM, WGU, kb * 64, n0, 256 * (n0 >> 7) + (n0 & 127) + up * 128, scr, lane); }
        else { r -= 2 * 5632; const int kb = r / 64, nb = r % 64; xpose_item(wd, DM, DFF, WD, kb * 64, nb * 32, nb * 32, scr, lane); }
    }
}
template <bool WBF>
__device__ __forceinline__ void ln_rows(float* io, const float* gain, const float* bias, bf16* xb, int gw, int NGW, int lane) {
    for (int row = gw; row < M_TOK; row += NGW) {
        f32x4* p = (f32x4*)(io + (size_t)row * DM) + lane;
        f32x4 v[8]; float s = 0.f;
#pragma unroll
        for (int j = 0; j < 8; ++j) { v[j] = p[64 * j]; s += (v[j][0] + v[j][1]) + (v[j][2] + v[j][3]); }
        const float mean = wave_sum(s) * (1.0f / DM); float s2 = 0.f;
#pragma unroll
        for (int j = 0; j < 8; ++j) { v[j] = v[j] - mean; s2 += (v[j][0] * v[j][0] + v[j][1] * v[j][1]) + (v[j][2] * v[j][2] + v[j][3] * v[j][3]); }
        const float rstd = 1.0f / sqrtf(wave_sum(s2) * (1.0f / DM) + LN_EPS);
#pragma unroll
        for (int j = 0; j < 8; ++j) {
            const f32x4 g = ((const f32x4*)gain)[lane + 64 * j], b = ((const f32x4*)bias)[lane + 64 * j];
            const f32x4 o = v[j] * rstd * g + b;
            p[64 * j] = o;
            if (WBF) { u32x2 w; w.x = pk2(o[0], o[1]); w.y = pk2(o[2], o[3]); ((u32x2*)(xb + (size_t)row * DM))[lane + 64 * j] = w; }
        }
    }
}

__device__ __forceinline__ void conv8(const bf16* PROJ, const float* cw, const float* cb, size_t tokrow, int t, int ch, f32x4& a0, f32x4& a1) {
    a0 = *(const f32x4*)(cb + ch); a1 = *(const f32x4*)(cb + ch + 4);
#pragma unroll
    for (int k = 0; k < 4; ++k) {
        if (t - 3 + k >= 0) {
            const u32x4 raw = *(const u32x4*)(PROJ + (tokrow - 3 + k) * PLD + 5120 + ch);
            const f32x4 w0 = *(const f32x4*)(cw + k * 1536 + ch), w1 = *(const f32x4*)(cw + k * 1536 + ch + 4);
            a0[0] += w0[0] * lo16(raw.x); a0[1] += w0[1] * hi16(raw.x); a0[2] += w0[2] * lo16(raw.y); a0[3] += w0[3] * hi16(raw.y);
            a1[0] += w1[0] * lo16(raw.z); a1[1] += w1[1] * hi16(raw.z); a1[2] += w1[2] * lo16(raw.w); a1[3] += w1[3] * hi16(raw.w);
        }
    }
#pragma unroll
    for (int i = 0; i < 4; ++i) { a0[i] = silu_f(a0[i]); a1[i] = silu_f(a1[i]); }
}
__device__ __forceinline__ void dt_acum(const float* DT, const float* dt_bias, const float* a_log, size_t tok0, int head, int lane, float& dt, float& ac) {
    const float x = DT[(tok0 + lane) * 16 + head] + dt_bias[head];
    dt = x > 20.0f ? x : log1pf(expf(x));
    float s = dt * (-expf(a_log[head]));
#pragma unroll
    for (int o = 1; o < 64; o <<= 1) { const float t = __shfl_up(s, o); if (lane >= o) s += t; }
    ac = s;
}

template <int I> __device__ __forceinline__ float bfel(const u32x4& w) { const unsigned x = (I >> 1) == 0 ? w.x : (I >> 1) == 1 ? w.y : (I >> 1) == 2 ? w.z : w.w; return (I & 1) ? hi16(x) : lo16(x); }
template <int I> __device__ __forceinline__ void xp_row(const u32x4 (&raw)[8], const float (&sc)[8], LAS bf16* dst, int stride) {
    u32x4 w; w.x = pk2(bfel<I>(raw[0]) * sc[0], bfel<I>(raw[1]) * sc[1]); w.y = pk2(bfel<I>(raw[2]) * sc[2], bfel<I>(raw[3]) * sc[3]);
    w.z = pk2(bfel<I>(raw[4]) * sc[4], bfel<I>(raw[5]) * sc[5]); w.w = pk2(bfel<I>(raw[6]) * sc[6], bfel<I>(raw[7]) * sc[7]);
    *(LAS u32x4*)(dst + I * stride) = w;
}
__device__ __forceinline__ void xpose8_store(const u32x4 (&raw)[8], const float (&sc)[8], LAS bf16* dst, int stride) {
    xp_row<0>(raw, sc, dst, stride); xp_row<1>(raw, sc, dst, stride); xp_row<2>(raw, sc, dst, stride); xp_row<3>(raw, sc, dst, stride);
    xp_row<4>(raw, sc, dst, stride); xp_row<5>(raw, sc, dst, stride); xp_row<6>(raw, sc, dst, stride); xp_row<7>(raw, sc, dst, stride);
}
__device__ __forceinline__ void conv_tile8(const bf16* PROJ, const float* cw, const float* cb, size_t tok0, int t0, int tg, int chn, f32x4 (&o0)[8], f32x4 (&o1)[8]) {
    u32x4 rw[11];
#pragma unroll
    for (int k = 0; k < 11; ++k) { const int tt = t0 + tg * 8 - 3 + k; rw[k] = (u32x4){0u, 0u, 0u, 0u}; if (tt >= 0) rw[k] = *(const u32x4*)(PROJ + (tok0 + tg * 8 + k - 3) * PLD + 5120 + chn); }
    f32x4 w0[4], w1[4];
#pragma unroll
    for (int k = 0; k < 4; ++k) { w0[k] = *(const f32x4*)(cw + k * 1536 + chn); w1[k] = *(const f32x4*)(cw + k * 1536 + chn + 4); }
    const f32x4 b0 = *(const f32x4*)(cb + chn), b1 = *(const f32x4*)(cb + chn + 4);
#pragma unroll
    for (int r = 0; r < 8; ++r) {
        f32x4 a0 = b0, a1 = b1;
#pragma unroll
        for (int k = 0; k < 4; ++k) { const u32x4 x = rw[r + k];
            a0[0] += w0[k][0] * lo16(x.x); a0[1] += w0[k][1] * hi16(x.x); a0[2] += w0[k][2] * lo16(x.y); a0[3] += w0[k][3] * hi16(x.y);
            a1[0] += w1[k][0] * lo16(x.z); a1[1] += w1[k][1] * hi16(x.z); a1[2] += w1[k][2] * lo16(x.w); a1[3] += w1[k][3] * hi16(x.w); }
#pragma unroll
        for (int i = 0; i < 4; ++i) { a0[i] = silu_f(a0[i]); a1[i] = silu_f(a1[i]); }
        o0[r] = a0; o1[r] = a1;
    }
}
template <int I> __device__ __forceinline__ void ct_row(const f32x4 (&o0)[8], const f32x4 (&o1)[8], const float (&sc)[8], LAS bf16* dst, int stride) {
    float v[8];
#pragma unroll
    for (int r = 0; r < 8; ++r) v[r] = (I < 4 ? o0[r][I & 3] : o1[r][I & 3]) * sc[r];
    u32x4 w; w.x = pk2(v[0], v[1]); w.y = pk2(v[2], v[3]); w.z = pk2(v[4], v[5]); w.w = pk2(v[6], v[7]);
    *(LAS u32x4*)(dst + I * stride) = w;
}
__device__ __forceinline__ void conv_store_t(const f32x4 (&o0)[8], const f32x4 (&o1)[8], const float (&sc)[8], LAS bf16* dst, int stride) {
    ct_row<0>(o0, o1, sc, dst, stride); ct_row<1>(o0, o1, sc, dst, stride); ct_row<2>(o0, o1, sc, dst, stride); ct_row<3>(o0, o1, sc, dst, stride);
    ct_row<4>(o0, o1, sc, dst, stride); ct_row<5>(o0, o1, sc, dst, stride); ct_row<6>(o0, o1, sc, dst, stride); ct_row<7>(o0, o1, sc, dst, stride);
}

__device__ __forceinline__ void ret_a_unit(LAS unsigned char* lds, const bf16* PROJ, bf16* RETS, int b, int z, int h, int tid) {
    asm volatile("" : "+v"(tid));
    const int wave = tid >> 6, lane = tid & 63, l15 = lane & 15, l4 = lane >> 4;
    const size_t tok0 = (size_t)b * SEQ + (size_t)z * 64;
    const float lg2 = log2f(1.0f - exp2f(-5.0f - (float)h));
    LAS bf16* Kt = (LAS bf16*)lds;
    LAS bf16* Vt = (LAS bf16*)(lds + 36864);
    {
        const int mat = tid >> 8, ch = (tid >> 3) & 31, tg = tid & 7;
        u32x4 raw[8]; float sc[8];
#pragma unroll
        for (int r = 0; r < 8; ++r) raw[r] = *(const u32x4*)(PROJ + (tok0 + tg * 8 + r) * PLD + (mat ? 2048 : 1024) + h * 256 + ch * 8);
#pragma unroll
        for (int r = 0; r < 8; ++r) sc[r] = mat ? 1.0f : exp2f(lg2 * (float)(63 - (tg * 8 + r)));
        xpose8_store(raw, sc, (mat ? Vt : Kt) + (ch * 8) * 72 + tg * 8, 72);
    }
    __syncthreads();
#ifdef DBG_LDS
#define DBG_CHECK(slot) { int bad = 0; \
    for (int it = 0; it < 8; ++it) { const int q = it * NT + tid, j = q & 63, ch = (q >> 6) & 31, mat = q >> 11; \
        const u32x4 raw = *(const u32x4*)(PROJ + (tok0 + j) * PLD + (mat ? 2048 : 1024) + h * 256 + ch * 8); \
        const float sc = mat ? 1.0f : exp2f(lg2 * (float)(63 - j)); \
        volatile LAS bf16* dst = (mat ? Vt : Kt) + (ch * 8) * 72 + j; \
        bad += (dst[0 * 72] != f2bf(lo16(raw.x) * sc)) + (dst[1 * 72] != f2bf(hi16(raw.x) * sc)) + (dst[2 * 72] != f2bf(lo16(raw.y) * sc)) + (dst[3 * 72] != f2bf(hi16(raw.y) * sc)) \
             + (dst[4 * 72] != f2bf(lo16(raw.z) * sc)) + (dst[5 * 72] != f2bf(hi16(raw.z) * sc)) + (dst[6 * 72] != f2bf(lo16(raw.w) * sc)) + (dst[7 * 72] != f2bf(hi16(raw.w) * sc)); } \
    (RETS + (size_t)200 * 1024 * 1024 / 2)[(size_t)((b * 128 + z) * 4 + h) * 1024 + (slot) * 512 + tid] = f2bf(1000.0f * (float)bad); }
    DBG_CHECK(0)
#endif
    bf16* out = RETS + ((size_t)((b * 4 + h) * 128 + z)) * 65536;
#pragma unroll 1
    for (int dh = 0; dh < 2; ++dh) {
        f32x4 acc[2][8];
#pragma unroll
        for (int mt = 0; mt < 2; ++mt)
#pragma unroll
            for (int nt = 0; nt < 8; ++nt) acc[mt][nt] = (f32x4){0.f, 0.f, 0.f, 0.f};
#pragma unroll
        for (int ks = 0; ks < 2; ++ks) {
            bf16x8 xa[2];
#pragma unroll
            for (int mt = 0; mt < 2; ++mt) xa[mt] = FRAG(Vt + (32 * wave + 16 * mt + l15) * 72 + ks * 32 + 8 * l4);
#pragma unroll
            for (int nt = 0; nt < 8; ++nt) { const bf16x8 yb = FRAG(Kt + (128 * dh + 64 * (nt >> 2) + 16 * (l15 >> 2) + 4 * (nt & 3) + (l15 & 3)) * 72 + ks * 32 + 8 * l4);
#pragma unroll
                for (int mt = 0; mt < 2; ++mt) acc[mt][nt] = mma(yb, xa[mt], acc[mt][nt]); }
        }
#pragma unroll
        for (int mt = 0; mt < 2; ++mt)
#pragma unroll
            for (int gq = 0; gq < 2; ++gq) { const int e = 32 * wave + 16 * mt + l15, d = 128 * dh + 64 * gq + 16 * l4;
#pragma unroll
                for (int hh = 0; hh < 2; ++hh) { const f32x4 a = acc[mt][4 * gq + 2 * hh], c = acc[mt][4 * gq + 2 * hh + 1];
                    u32x4 w; w.x = pk2(a[0], a[1]); w.y = pk2(a[2], a[3]); w.z = pk2(c[0], c[1]); w.w = pk2(c[2], c[3]); *(u32x4*)(out + e * 256 + d + 8 * hh) = w; } }
    }
#ifdef DBG_LDS
    DBG_CHECK(1)
#endif
    __syncthreads();
}

__device__ __forceinline__ void ssd_a_unit(LAS unsigned char* lds, const bf16* PROJ, const float* DT, const float* cw, const float* cb, const float* dt_bias, const float* a_log,
                                           bf16* SSDS, float* TOT, int b, int z, int g, int tid) {
    asm volatile("" : "+v"(tid));
    const int wave = tid >> 6, lane = tid & 63, l15 = lane & 15, l4 = lane >> 4;
    const size_t tok0 = (size_t)b * SEQ + (size_t)z * 64;
    LAS bf16* Bt = (LAS bf16*)lds;
    LAS bf16* Xt = (LAS bf16*)(lds + 18432);
    LAS float* coef = (LAS float*)(lds + 92160);
    { float dt, ac; dt_acum(DT, dt_bias, a_log, tok0, g * 8 + wave, lane, dt, ac); const float last = __shfl(ac, 63);
      coef[wave * 64 + lane] = dt * expf(last - ac); if (lane == 63) TOT[(size_t)(b * 128 + z) * 16 + g * 8 + wave] = expf(last); }
    __syncthreads();
    {
        const int chx = tid >> 3, tg = tid & 7; f32x4 o0[8], o1[8]; float sc[8];
        conv_tile8(PROJ, cw, cb, tok0, z * 64, tg, g * 512 + chx * 8, o0, o1);
#pragma unroll
        for (int r = 0; r < 8; ++r) sc[r] = coef[(chx >> 3) * 64 + tg * 8 + r];
        conv_store_t(o0, o1, sc, Xt + (chx * 8) * 72 + tg * 8, 72);
    }
    if (tid < 128) {
        const int chb = tid >> 3, tg = tid & 7; f32x4 o0[8], o1[8]; float sc[8];
        conv_tile8(PROJ, cw, cb, tok0, z * 64, tg, 1024 + g * 128 + chb * 8, o0, o1);
#pragma unroll
        for (int r = 0; r < 8; ++r) sc[r] = 1.0f;
        conv_store_t(o0, o1, sc, Bt + (chb * 8) * 72 + tg * 8, 72);
    }
    __syncthreads();
    bf16* out = SSDS + ((size_t)((b * 16 + g * 8 + wave) * 128 + z)) * 8192;
#pragma unroll 1
    for (int nh = 0; nh < 2; ++nh) {
        f32x4 acc[4][4];
#pragma unroll
        for (int mt = 0; mt < 4; ++mt)
#pragma unroll
            for (int nt = 0; nt < 4; ++nt) acc[mt][nt] = (f32x4){0.f, 0.f, 0.f, 0.f};
#pragma unroll
        for (int ks = 0; ks < 2; ++ks) {
            bf16x8 xa[4];
#pragma unroll
            for (int mt = 0; mt < 4; ++mt) xa[mt] = FRAG(Xt + (64 * wave + 16 * mt + l15) * 72 + ks * 32 + 8 * l4);
#pragma unroll
            for (int nt = 0; nt < 4; ++nt) { const bf16x8 yb = FRAG(Bt + (64 * nh + 16 * (l15 >> 2) + 4 * nt + (l15 & 3)) * 72 + ks * 32 + 8 * l4);
#pragma unroll
                for (int mt = 0; mt < 4; ++mt) acc[mt][nt] = mma(yb, xa[mt], acc[mt][nt]); }
        }
#pragma unroll
        for (int mt = 0; mt < 4; ++mt)
#pragma unroll
            for (int hh = 0; hh < 2; ++hh) { const int p = 16 * mt + l15, n = 64 * nh + 16 * l4 + 8 * hh; const f32x4 a = acc[mt][2 * hh], c = acc[mt][2 * hh + 1];
                u32x4 w; w.x = pk2(a[0], a[1]); w.y = pk2(a[2], a[3]); w.z = pk2(c[0], c[1]); w.w = pk2(c[2], c[3]); *(u32x4*)(out + p * 128 + n) = w; }
    }
    __syncthreads();
}

__device__ __forceinline__ void scan_phase(bf16* RETS, bf16* SSDS, const float* TOT, int gtid, int nth) {
    for (int task = gtid; task < 98304; task += nth) {
        bf16* base; size_t stride; float cdec = 0.f; const float* totp = nullptr;
        if (task < 65536) { const int bh = task >> 13, e8 = task & 8191; base = RETS + (size_t)bh * 128 * 65536 + (size_t)e8 * 8; stride = 65536;
            cdec = exp2f(64.0f * log2f(1.0f - exp2f(-5.0f - (float)(bh & 3)))); }
        else { const int t2 = task - 65536, bhd = t2 >> 10, e8 = t2 & 1023; base = SSDS + (size_t)bhd * 128 * 8192 + (size_t)e8 * 8; stride = 8192;
            totp = TOT + (size_t)(bhd >> 4) * 128 * 16 + (bhd & 15); }
        float s0 = 0.f, s1 = 0.f, s2 = 0.f, s3 = 0.f, s4 = 0.f, s5 = 0.f, s6 = 0.f, s7 = 0.f;
#pragma unroll 1
        for (int z0 = 0; z0 < 128; z0 += 8) {
            u32x4 v[8]; float dec[8];
#pragma unroll
            for (int i = 0; i < 8; ++i) { v[i] = *(const u32x4*)(base + (size_t)(z0 + i) * stride); dec[i] = totp ? totp[(z0 + i) * 16] : cdec; }
#pragma unroll
            for (int i = 0; i < 8; ++i) {
                u32x4 o; o.x = pk2(s0, s1); o.y = pk2(s2, s3); o.z = pk2(s4, s5); o.w = pk2(s6, s7);
                *(u32x4*)(base + (size_t)(z0 + i) * stride) = o;
                const float d = dec[i];
                s0 = s0 * d + lo16(v[i].x); s1 = s1 * d + hi16(v[i].x); s2 = s2 * d + lo16(v[i].y); s3 = s3 * d + hi16(v[i].y);
                s4 = s4 * d + lo16(v[i].z); s5 = s5 * d + hi16(v[i].z); s6 = s6 * d + lo16(v[i].w); s7 = s7 * d + hi16(v[i].w);
            }
        }
    }
}

__device__ __forceinline__ void ret_c_unit(LAS unsigned char* lds, const bf16* PROJ, const bf16* RETS, const float* gn_g, const float* gn_b, bf16* MIX, int b, int z, int h, int tid) {
    asm volatile("" : "+v"(tid));
    const int wave = tid >> 6, lane = tid & 63, l15 = lane & 15, l4 = lane >> 4;
    const size_t tok0 = (size_t)b * SEQ + (size_t)z * 64;
    const float lg2 = log2f(1.0f - exp2f(-5.0f - (float)h));
    LAS bf16* Q = (LAS bf16*)lds;
    LAS bf16* Kn = (LAS bf16*)(lds + 33792);
    LAS bf16* Vt = (LAS bf16*)(lds + 67584);
    LAS bf16* Pm = (LAS bf16*)(lds + 104448);
    LAS float* st1 = (LAS float*)(lds + 113664);
    LAS float* st2 = (LAS float*)(lds + 115712);
    {
        u32x4 qk[8];
#pragma unroll
        for (int it = 0; it < 8; ++it) { const int q = it * NT + tid, ch = q & 31, j = (q >> 5) & 63, mat = q >> 11; qk[it] = *(const u32x4*)(PROJ + (tok0 + j) * PLD + mat * 1024 + h * 256 + ch * 8); }
        if (tid < 256) {
            const int ch = tid >> 3, tg = tid & 7; u32x4 raw[8]; float sc[8];
#pragma unroll
            for (int r = 0; r < 8; ++r) { raw[r] = *(const u32x4*)(PROJ + (tok0 + tg * 8 + r) * PLD + 2048 + h * 256 + ch * 8); sc[r] = 1.0f; }
            xpose8_store(raw, sc, Vt + (ch * 8) * 72 + tg * 8, 72);
        }
#pragma unroll
        for (int it = 0; it < 8; ++it) { const int q = it * NT + tid, ch = q & 31, j = (q >> 5) & 63, mat = q >> 11; *(LAS u32x4*)((mat ? Kn : Q) + j * 264 + ch * 8) = qk[it]; }
    }
    __syncthreads();
    {
        const int mt = wave >> 1, nt0 = 2 * (wave & 1);
        f32x4 sc[2] = {(f32x4){0.f, 0.f, 0.f, 0.f}, (f32x4){0.f, 0.f, 0.f, 0.f}};
#pragma unroll
        for (int ks = 0; ks < 8; ++ks) {
            const bf16x8 xa = FRAG(Q + (16 * mt + l15) * 264 + ks * 32 + 8 * l4);
#pragma unroll
            for (int n2 = 0; n2 < 2; ++n2) { const bf16x8 yb = FRAG(Kn + (16 * (nt0 + n2) + l15) * 264 + ks * 32 + 8 * l4); sc[n2] = mma(yb, xa, sc[n2]); }
        }
#pragma unroll
        for (int n2 = 0; n2 < 2; ++n2) {
            const int i = 16 * mt + l15 + (int)opaque0(), j0 = 16 * (nt0 + n2) + 4 * l4; float p[4];
#pragma unroll
            for (int ii = 0; ii < 4; ++ii) { const int j = j0 + ii; p[ii] = (j <= i) ? sc[n2][ii] * exp2f(lg2 * (float)(i - j)) : 0.0f; }
            u32x2 w; w.x = pk2(p[0], p[1]); w.y = pk2(p[2], p[3]); *(LAS u32x2*)(Pm + i * 72 + j0) = w;
        }
    }
    __syncthreads();
    f32x4 acc[4][2];
#pragma unroll
    for (int mt = 0; mt < 4; ++mt)
#pragma unroll
        for (int nt = 0; nt < 2; ++nt) acc[mt][nt] = (f32x4){0.f, 0.f, 0.f, 0.f};
    const bf16* S = RETS + ((size_t)((b * 4 + h) * 128 + z)) * 65536;
#pragma unroll
    for (int ks = 0; ks < 8; ++ks) {
        bf16x8 yb[2];
#pragma unroll
        for (int nt = 0; nt < 2; ++nt) yb[nt] = *(const bf16x8*)(S + (32 * wave + 8 * (l15 >> 2) + 4 * nt + (l15 & 3)) * 256 + ks * 32 + 8 * l4);
#pragma unroll
        for (int mt = 0; mt < 4; ++mt) { const bf16x8 xa = FRAG(Q + (16 * mt + l15) * 264 + ks * 32 + 8 * l4);
#pragma unroll
            for (int nt = 0; nt < 2; ++nt) acc[mt][nt] = mma(yb[nt], xa, acc[mt][nt]); }
    }
#pragma unroll
    for (int mt = 0; mt < 4; ++mt) { const float qd = exp2f(lg2 * (float)(16 * mt + l15 + 1));
#pragma unroll
        for (int nt = 0; nt < 2; ++nt) acc[mt][nt] = acc[mt][nt] * qd; }
#pragma unroll
    for (int ks = 0; ks < 2; ++ks) {
        bf16x8 yb[2];
#pragma unroll
        for (int nt = 0; nt < 2; ++nt) yb[nt] = FRAG(Vt + (32 * wave + 8 * (l15 >> 2) + 4 * nt + (l15 & 3)) * 72 + ks * 32 + 8 * l4);
#pragma unroll
        for (int mt = 0; mt < 4; ++mt) { const bf16x8 xa = FRAG(Pm + (16 * mt + l15) * 72 + ks * 32 + 8 * l4);
#pragma unroll
            for (int nt = 0; nt < 2; ++nt) acc[mt][nt] = mma(yb[nt], xa, acc[mt][nt]); }
    }
#pragma unroll
    for (int mt = 0; mt < 4; ++mt) {
        float s = 0.f;
#pragma unroll
        for (int nt = 0; nt < 2; ++nt) s += (acc[mt][nt][0] + acc[mt][nt][1]) + (acc[mt][nt][2] + acc[mt][nt][3]);
        s += __shfl_xor(s, 16); s += __shfl_xor(s, 32);
        if (l4 == 0) st1[wave * 64 + 16 * mt + l15] = s;
    }
    __syncthreads();
    float mean[4];
#pragma unroll
    for (int mt = 0; mt < 4; ++mt) { float m = 0.f;
#pragma unroll
        for (int w = 0; w < 8; ++w) m += st1[w * 64 + 16 * mt + l15];
        mean[mt] = m * (1.0f / 256.0f);
        float s = 0.f;
#pragma unroll
        for (int nt = 0; nt < 2; ++nt) { acc[mt][nt] = acc[mt][nt] - mean[mt]; s += (acc[mt][nt][0] * acc[mt][nt][0] + acc[mt][nt][1] * acc[mt][nt][1]) + (acc[mt][nt][2] * acc[mt][nt][2] + acc[mt][nt][3] * acc[mt][nt][3]); }
        s += __shfl_xor(s, 16); s += __shfl_xor(s, 32);
        if (l4 == 0) st2[wave * 64 + 16 * mt + l15] = s;
    }
    __syncthreads();
#pragma unroll
    for (int mt = 0; mt < 4; ++mt) { float q = 0.f; const int i = 16 * mt + l15;
#pragma unroll
        for (int w = 0; w < 8; ++w) q += st2[w * 64 + i];
        const float rstd = 1.0f / sqrtf(q * (1.0f / 256.0f) + LN_EPS);
        {
            const int col = h * 256 + 32 * wave + 8 * l4;
            const f32x4 g0 = *(const f32x4*)(gn_g + col), g1 = *(const f32x4*)(gn_g + col + 4), b0 = *(const f32x4*)(gn_b + col), b1 = *(const f32x4*)(gn_b + col + 4);
            const u32x4 graw = *(const u32x4*)(PROJ + (tok0 + i) * PLD + 3072 + col);
            const f32x4 o0 = acc[mt][0] * rstd * g0 + b0, o1 = acc[mt][1] * rstd * g1 + b1;
            u32x4 w; w.x = pk2(o0[0] * silu_f(lo16(graw.x)), o0[1] * silu_f(hi16(graw.x))); w.y = pk2(o0[2] * silu_f(lo16(graw.y)), o0[3] * silu_f(hi16(graw.y)));
            w.z = pk2(o1[0] * silu_f(lo16(graw.z)), o1[1] * silu_f(hi16(graw.z))); w.w = pk2(o1[2] * silu_f(lo16(graw.w)), o1[3] * silu_f(hi16(graw.w)));
            *(u32x4*)(MIX + (tok0 + i) * DM + col) = w;
        }
    }
    __syncthreads();
}

__device__ __forceinline__ void ssd_c_unit(LAS unsigned char* lds, const bf16* PROJ, const float* DT, const float* cw, const float* cb, const float* dt_bias, const float* a_log,
                                           const float* dskip, const float* ngain, const bf16* SSDS, bf16* MIX, int b, int z, int g, int tid) {
    asm volatile("" : "+v"(tid));
    const int wave = tid >> 6, lane = tid & 63, l15 = lane & 15, l4 = lane >> 4;
    const size_t tok0 = (size_t)b * SEQ + (size_t)z * 64;
    LAS bf16* Cm = (LAS bf16*)lds;
    LAS bf16* Bm = (LAS bf16*)(lds + 17408);
    LAS bf16* Xt = (LAS bf16*)(lds + 34816);
    LAS float* CB = (LAS float*)(lds + 108544);
    LAS float* dts = (LAS float*)(lds + 125184);
    LAS float* acs = (LAS float*)(lds + 127232);
    LAS bf16* Lw = (LAS bf16*)(lds + 129280 + wave * 2304);
    LAS float* ssq = (LAS float*)(lds + 147712);
    { float dt, ac; dt_acum(DT, dt_bias, a_log, tok0, g * 8 + wave, lane, dt, ac); dts[wave * 64 + lane] = dt; acs[wave * 64 + lane] = ac; }
    __syncthreads();
    {
        const int chx = tid >> 3, tg = tid & 7; f32x4 o0[8], o1[8]; float sc[8];
        conv_tile8(PROJ, cw, cb, tok0, z * 64, tg, g * 512 + chx * 8, o0, o1);
#pragma unroll
        for (int r = 0; r < 8; ++r) sc[r] = dts[(chx >> 3) * 64 + tg * 8 + r];
        conv_store_t(o0, o1, sc, Xt + (chx * 8) * 72 + tg * 8, 72);
    }
    if (tid < 256) {
        const int mat = tid >> 7, chb = (tid >> 3) & 15, tg = tid & 7; f32x4 o0[8], o1[8];
        conv_tile8(PROJ, cw, cb, tok0, z * 64, tg, 1024 + mat * 256 + g * 128 + chb * 8, o0, o1);
#pragma unroll
        for (int r = 0; r < 8; ++r) { u32x4 w; w.x = pk2(o0[r][0], o0[r][1]); w.y = pk2(o0[r][2], o0[r][3]); w.z = pk2(o1[r][0], o1[r][1]); w.w = pk2(o1[r][2], o1[r][3]);
            *(LAS u32x4*)((mat ? Cm : Bm) + (tg * 8 + r) * 136 + chb * 8) = w; }
    }
    __syncthreads();
    {
        const int mt = wave >> 1, nt0 = 2 * (wave & 1);
        f32x4 sc[2] = {(f32x4){0.f, 0.f, 0.f, 0.f}, (f32x4){0.f, 0.f, 0.f, 0.f}};
#pragma unroll
        for (int ks = 0; ks < 4; ++ks) {
            const bf16x8 xa = FRAG(Cm + (16 * mt + l15) * 136 + ks * 32 + 8 * l4);
#pragma unroll
            for (int n2 = 0; n2 < 2; ++n2) { const bf16x8 yb = FRAG(Bm + (16 * (nt0 + n2) + l15) * 136 + ks * 32 + 8 * l4); sc[n2] = mma(yb, xa, sc[n2]); }
        }
#pragma unroll
        for (int n2 = 0; n2 < 2; ++n2) { const int i = 16 * mt + l15, j0 = 16 * (nt0 + n2) + 4 * l4;
#pragma unroll
            for (int ii = 0; ii < 4; ++ii) CB[i * 65 + j0 + ii] = sc[n2][ii]; }
    }
    __syncthreads();
    const int r = wave, head = g * 8 + r;
    f32x4 acc[4][4];
#pragma unroll
    for (int mt = 0; mt < 4; ++mt)
#pragma unroll
        for (int nt = 0; nt < 4; ++nt) acc[mt][nt] = (f32x4){0.f, 0.f, 0.f, 0.f};
    const bf16* S = SSDS + ((size_t)((b * 16 + head) * 128 + z)) * 8192;
#pragma unroll
    for (int ks = 0; ks < 4; ++ks) {
        bf16x8 yb[4];
#pragma unroll
        for (int nt = 0; nt < 4; ++nt) yb[nt] = *(const bf16x8*)(S + (16 * (l15 >> 2) + 4 * nt + (l15 & 3)) * 128 + ks * 32 + 8 * l4);
#pragma unroll
        for (int mt = 0; mt < 4; ++mt) { const bf16x8 xa = FRAG(Cm + (16 * mt + l15) * 136 + ks * 32 + 8 * l4);
#pragma unroll
            for (int nt = 0; nt < 4; ++nt) acc[mt][nt] = mma(yb[nt], xa, acc[mt][nt]); }
    }
#pragma unroll
    for (int mt = 0; mt < 4; ++mt) { const float fs = expf(acs[r * 64 + 16 * mt + l15]);
#pragma unroll
        for (int nt = 0; nt < 4; ++nt) acc[mt][nt] = acc[mt][nt] * fs; }
#pragma unroll
    for (int mt = 0; mt < 4; ++mt) {
        const int i = 16 * mt + l15 + (int)opaque0(); const float ai = acs[r * 64 + i];
#pragma unroll
        for (int hh = 0; hh < 2; ++hh) {
            float lv[8];
#pragma unroll
            for (int k = 0; k < 8; ++k) { const int j = 16 * l4 + 8 * hh + k; const float e = expf(ai - acs[r * 64 + j]); lv[k] = (j <= i) ? CB[i * 65 + j] * e : 0.0f; }
            u32x4 w; w.x = pk2(lv[0], lv[1]); w.y = pk2(lv[2], lv[3]); w.z = pk2(lv[4], lv[5]); w.w = pk2(lv[6], lv[7]);
            *(LAS u32x4*)(Lw + l15 * 72 + 16 * l4 + 8 * hh) = w;
        }
        LDS_WAIT(); __builtin_amdgcn_wave_barrier();
#pragma unroll
        for (int ks = 0; ks < 2; ++ks) {
            const bf16x8 xa = FRAG(Lw + l15 * 72 + ks * 32 + 8 * l4);
#pragma unroll
            for (int nt = 0; nt < 4; ++nt) { const bf16x8 yb = FRAG(Xt + (64 * r + 16 * (l15 >> 2) + 4 * nt + (l15 & 3)) * 72 + ks * 32 + 8 * l4); acc[mt][nt] = mma(yb, xa, acc[mt][nt]); }
        }
        LDS_WAIT(); __builtin_amdgcn_wave_barrier();
    }
    const float dsk = dskip[head];
#pragma unroll
    for (int mt = 0; mt < 4; ++mt) {
        const int i = 16 * mt + l15; const float rdt = 1.0f / dts[r * 64 + i]; float sq = 0.f;
        const u32x4 zr0 = *(const u32x4*)(PROJ + (tok0 + i) * PLD + 4096 + g * 512 + r * 64 + 16 * l4), zr1 = *(const u32x4*)(PROJ + (tok0 + i) * PLD + 4096 + g * 512 + r * 64 + 16 * l4 + 8);
#pragma unroll
        for (int nt = 0; nt < 4; ++nt) {
            const int p0 = 16 * l4 + 4 * nt;
            const unsigned zw0 = nt == 0 ? zr0.x : nt == 1 ? zr0.z : nt == 2 ? zr1.x : zr1.z, zw1 = nt == 0 ? zr0.y : nt == 1 ? zr0.w : nt == 2 ? zr1.y : zr1.w;
            const float zz[4] = {lo16(zw0), hi16(zw0), lo16(zw1), hi16(zw1)};
#pragma unroll
            for (int ii = 0; ii < 4; ++ii) { const float x = bf2f(Xt[(64 * r + p0 + ii) * 72 + i]) * rdt; const float y = (acc[mt][nt][ii] + dsk * x) * silu_f(zz[ii]); acc[mt][nt][ii] = y; sq += y * y; }
        }
        sq += __shfl_xor(sq, 16); sq += __shfl_xor(sq, 32);
        if (l4 == 0) ssq[r * 64 + i] = sq;
    }
    __syncthreads();
#pragma unroll
    for (int mt = 0; mt < 4; ++mt) {
        const int i = 16 * mt + l15; float t = 0.f;
#pragma unroll
        for (int w = 0; w < 8; ++w) t += ssq[w * 64 + i];
        const float rstd = 1.0f / sqrtf(t * (1.0f / 512.0f) + LN_EPS);
#pragma unroll
        for (int hh = 0; hh < 2; ++hh) {
            const int col = g * 512 + r * 64 + 16 * l4 + 8 * hh;
            const f32x4 gn0 = *(const f32x4*)(ngain + col), gn1 = *(const f32x4*)(ngain + col + 4);
            const f32x4 o0 = acc[mt][2 * hh] * rstd * gn0, o1 = acc[mt][2 * hh + 1] * rstd * gn1;
            u32x4 w; w.x = pk2(o0[0], o0[1]); w.y = pk2(o0[2], o0[3]); w.z = pk2(o1[0], o1[1]); w.w = pk2(o1[2], o1[3]);
            *(u32x4*)(MIX + (tok0 + i) * DM + 1024 + col) = w;
        }
    }
    __syncthreads();
}

#define XB_TMO      128
#define XB_XCNT(j)  (256  + 64 * (j))
#define XB_XSUB(j)  (1280 + 64 * (j))
#define XB_XGEN(j)  (2304 + 64 * (j))
#define XB_TOP      3328
#define XB_TOPGEN   3392
#define XCD_BAR_WORDS 3456
#define XB_SPIN_CAP (1u << 18)

__device__ __forceinline__ unsigned xb_ld(unsigned* p)              { return __hip_atomic_load(p, __ATOMIC_RELAXED, __HIP_MEMORY_SCOPE_AGENT); }
__device__ __forceinline__ unsigned xb_add(unsigned* p, unsigned v) { return __hip_atomic_fetch_add(p, v, __ATOMIC_RELAXED, __HIP_MEMORY_SCOPE_AGENT); }
__device__ __forceinline__ unsigned xb_xcc_id() { return (unsigned)__builtin_amdgcn_s_getreg((3 << 11) | 20) & 0xFu; }
#define XB_SPIN(cond, bar) do { unsigned _sp = 0; while (cond) { __builtin_amdgcn_s_sleep(1); \
    if ((++_sp & 255u) == 0u) { if (xb_ld(&(bar)[XB_TMO])) break; if (_sp > XB_SPIN_CAP) { atomicAdd(&(bar)[XB_TMO], 1u); break; } } } } while (0)

struct XcdBarrier {
    unsigned* bar; unsigned x;
    volatile LAS unsigned* st;
};

__device__ __forceinline__ XcdBarrier xcd_barrier_post(unsigned* bar, volatile LAS unsigned* st) {
    XcdBarrier b; b.bar = bar; b.x = xb_xcc_id(); b.st = st;
    if (threadIdx.x == 0) (void)xb_add(&bar[XB_XCNT(b.x)], 1u);
    return b;
}
__device__ __forceinline__ void xcd_barrier_complete(unsigned* bar, unsigned x, unsigned& nloc, unsigned& nx) {
    const unsigned G = gridDim.x * gridDim.y * gridDim.z;
    unsigned sum, cnt, mine, sp = 0u;
    for (;;) {
        sum = 0u; cnt = 0u; mine = 0u;
#pragma unroll
        for (unsigned j = 0; j < 16; ++j) { const unsigned c = xb_ld(&bar[XB_XCNT(j)]); sum += c; cnt += (c > 0u) ? 1u : 0u; mine = (j == x) ? c : mine; }
        if (sum == G) break;
        __builtin_amdgcn_s_sleep(1);
        if ((++sp & 255u) == 0u) { if (xb_ld(&bar[XB_TMO])) break; if (sp > XB_SPIN_CAP) { atomicAdd(&bar[XB_TMO], 1u); break; } }
    }
    nloc = mine > 0u ? mine : 1u; nx = cnt > 0u ? cnt : 1u;
}

__device__ __forceinline__ void xcd_barrier(const XcdBarrier& b) {
    asm volatile("s_waitcnt vmcnt(0)" ::: "memory");
    __syncthreads();
    if (threadIdx.x == 0) {
        unsigned* bar = b.bar;
        __builtin_amdgcn_s_waitcnt(0);
        unsigned nloc = b.st[0], nx = b.st[1];
        if (nloc == 0u) { xcd_barrier_complete(bar, b.x, nloc, nx); b.st[0] = nloc; b.st[1] = nx; }
        const unsigned old = xb_add(&bar[XB_XSUB(b.x)], 1u);
        const unsigned gen = old / nloc;
        if (old + 1u == (gen + 1u) * nloc) {
            __builtin_amdgcn_fence(__ATOMIC_RELEASE, "agent");
            asm volatile("s_waitcnt vmcnt(0)" ::: "memory");
            const unsigned og = xb_add(&bar[XB_TOP], 1u);
            const unsigned tg = og / nx;
            if (og + 1u == (tg + 1u) * nx) xb_add(&bar[XB_TOPGEN], 1u);
            else XB_SPIN(xb_ld(&bar[XB_TOPGEN]) == tg, bar);
            __builtin_amdgcn_fence(__ATOMIC_ACQUIRE, "agent");
            xb_add(&bar[XB_XGEN(b.x)], 1u);
            asm volatile("s_waitcnt vmcnt(0)" ::: "memory");
        } else {
            XB_SPIN(xb_ld(&bar[XB_XGEN(b.x)]) == gen, bar);
            __builtin_amdgcn_fence(__ATOMIC_ACQUIRE, "agent");
            asm volatile("s_waitcnt vmcnt(0)" ::: "memory");
        }
    }
    __syncthreads();
}


#ifndef DUMPC
#define DUMPC 0
#endif
__device__ __forceinline__ void dump_bf16(float* out, const bf16* src, size_t ld, size_t col0, int gtid, int nth) {
    for (size_t i = gtid; i < (size_t)M_TOK * DM; i += nth) { const size_t r = i >> 11, c = i & 2047; float v = bf2f(src[r * ld + col0 + c]); if (!(fabsf(v) < 1e30f)) v = 12345.0f; out[i] = v; }
}
struct Args { const void* in[24]; float* out; unsigned char* ws; };
typedef __attribute__((address_space(4))) const unsigned long long karg_t;
#define KARG(T, i) ((T)(__attribute__((address_space(1))) char*)(((karg_t*)__builtin_amdgcn_kernarg_segment_ptr())[(i) + oz]))
#define KF(i) KARG(const float*, i)
#define WSP(T, off) ((T)(KARG(unsigned char*, 25) + (off)))
__global__ void __launch_bounds__(NT, 2) fwd_megakernel(Args a_unused) {
    extern __shared__ __attribute__((aligned(16))) unsigned char lds_raw[];
    LAS unsigned char* lds = (LAS unsigned char*)lds_raw;
    cg::grid_group grid = cg::this_grid();
    XcdBarrier bar;
    { volatile LAS unsigned* misc = (volatile LAS unsigned*)(lds + MISC_OFF); if (threadIdx.x < 2) misc[threadIdx.x] = 0u; if (threadIdx.x == 2) *(volatile LAS unsigned*)(lds + 140000) = 0u; __syncthreads();
      const unsigned oz = opaque0(); bar = xcd_barrier_post((unsigned*)WSP(unsigned char*, WS_CTL), misc); }
    grid.sync();
#define SEAM() xcd_barrier(bar)
#ifndef GEMM_ALIGN
#define GEMM_ALIGN true
#endif
#ifndef SKIP_GEMM
#define SKIP_GEMM 0
#endif
#ifndef STOP_AFTER
#define STOP_AFTER 99
#endif
#define GEOM int tid_o = threadIdx.x; asm volatile("" : "+v"(tid_o)); const int tid = tid_o, lane = tid & 63, wave = __builtin_amdgcn_readfirstlane(tid >> 6); (void)lane; (void)wave; const int G = gridDim.x, bx = blockIdx.x, gw = bx * 8 + wave, NGW = G * 8, gtid = bx * NT + tid, nth = G * NT; (void)gw; (void)NGW; (void)gtid; (void)nth; const unsigned oz = opaque0()

    { GEOM; LAS float* scr = (LAS float*)(lds + wave * 8448);
      convert_ffn(KF(2), KF(3), KF(4), WSP(bf16*, WS_WGU), WSP(bf16*, WS_WD), scr, gw, NGW, lane);
      { const float* win = KF(7); const float* wout = KF(16); bf16* WIN = WSP(bf16*, WS_WIN); bf16* WOUT = WSP(bf16*, WS_WOUT);
        for (int it = gw; it < 32 * 216 + 32 * 64; it += NGW) {
            if (it < 32 * 216) { const int kb = it / 216, nb = it % 216; xpose_item(win, NIN, DM, WIN, kb * 64, nb * 32, nb * 32, scr, lane); }
            else { const int r = it - 32 * 216, kb = r / 64, nb = r % 64; xpose_item(wout, DM, DM, WOUT, kb * 64, nb * 32, nb * 32, scr, lane); }
        } }
      { const float* x = KF(0); bf16* XB = WSP(bf16*, WS_XB);
        for (size_t i = gtid; i < (size_t)M_TOK * DM / 8; i += nth) {
            const f32x4 p = ((const f32x4*)x)[2 * i], q = ((const f32x4*)x)[2 * i + 1];
            u32x4 w; w.x = pk2(p[0], p[1]); w.y = pk2(p[2], p[3]); w.z = pk2(q[0], q[1]); w.w = pk2(q[2], q[3]);
            ((u32x4*)XB)[i] = w;
        } }
      { const int* pos = KARG(const int*, 1); float* COS = WSP(float*, WS_COS); float* SIN = WSP(float*, WS_SIN);
        for (int idx = gtid; idx < M_TOK * 128; idx += nth) {
            const int tok = idx >> 7, f = idx & 127;
            const float invf = exp2f(-((float)f * (1.0f / 127.0f)) * 13.287712379549449f);
            const double rev = (double)pos[tok] * (double)invf * 0.15915494309189535;
            const float fr = (float)(rev - rint(rev));
            COS[idx] = __builtin_amdgcn_cosf(fr); SIN[idx] = __builtin_amdgcn_sinf(fr);
        } }
      if (SKIP_GEMM) { bf16* BIGW = WSP(bf16*, WS_BIG); float* DTW = WSP(float*, WS_DT);
        for (size_t i = gtid; i < (size_t)M_TOK * PLD; i += nth) { unsigned hsh = (unsigned)i * 2654435761u; hsh ^= hsh >> 15; hsh *= 2246822519u; hsh ^= hsh >> 13; BIGW[i] = f2bf((float)(hsh & 0xffffu) * (1.0f / 65536.0f) - 0.5f); }
        for (size_t i = gtid; i < (size_t)M_TOK * 16; i += nth) { unsigned hsh = (unsigned)i * 2654435761u; hsh ^= hsh >> 15; hsh *= 2246822519u; hsh ^= hsh >> 13; DTW[i] = (float)(hsh & 0xffffu) * (1.0f / 65536.0f) - 0.5f; } }
    }
    SEAM(); if (STOP_AFTER == 0) return;

    { GEOM; pg8::Gemm g{WSP(const bf16*, WS_XB), WSP(const bf16*, WS_WGU), M_TOK, NGU, DM}; pg8::StaticOrder S; S.init(M_TOK, NGU, G, bx); pg8::EpiSwiglu E{WSP(bf16*, WS_BIG), DFF};
      if (!SKIP_GEMM) pg8::gemm_phase<pg8::EpiSwiglu, pg8::StaticOrder, GEMM_ALIGN, true>(lds, g, S, E); }
    SEAM(); if (STOP_AFTER == 1) return;
    { GEOM; pg8::Gemm g{WSP(const bf16*, WS_BIG), WSP(const bf16*, WS_WD), M_TOK, DM, DFF}; pg8::StaticOrder S; S.init(M_TOK, DM, G, bx); pg8::EpiRes E{KF(0), KARG(float*, 24), DM, ALPHA, 0.5f};
      if (!SKIP_GEMM) pg8::gemm_phase<pg8::EpiRes, pg8::StaticOrder, GEMM_ALIGN, true>(lds, g, S, E); }
    SEAM(); if (STOP_AFTER == 2) return;
    { GEOM; ln_rows<true>(KARG(float*, 24), KF(5), KF(6), WSP(bf16*, WS_XB), gw, NGW, lane); }
    SEAM(); if (STOP_AFTER == 3) return;
    { GEOM; pg8::Gemm g{WSP(const bf16*, WS_XB), WSP(const bf16*, WS_WIN), M_TOK, NINP, DM}; pg8::StaticOrder S; S.init(M_TOK, NINP, G, bx);
      pg8::EpiInProj E{WSP(bf16*, WS_BIG), WSP(const float*, WS_COS), WSP(const float*, WS_SIN), WSP(float*, WS_DT)};
      if (!SKIP_GEMM) pg8::gemm_phase<pg8::EpiInProj, pg8::StaticOrder, GEMM_ALIGN, true>(lds, g, S, E);
#ifdef DIAGMODE
      { volatile LAS unsigned* cnt = (volatile LAS unsigned*)(lds + 140000); if (lane == 0) atomicAdd((unsigned*)(lds_raw + 140000), 1u); __syncthreads(); const unsigned v = *cnt; WSP(float*, WS_XB)[gtid] = (float)v; }
#endif
    }
    SEAM();
#ifdef DIAGMODE
    { GEOM; const float* dg = WSP(const float*, WS_XB); float* o = KARG(float*, 24); for (size_t i = gtid; i < (size_t)M_TOK * DM; i += nth) o[i] = dg[i % nth]; return; }
#endif
    if (STOP_AFTER == 4) { GEOM; dump_bf16(KARG(float*, 24), WSP(const bf16*, WS_BIG), PLD, DUMPC, gtid, nth); return; }
#ifdef P5_TWICE
    for (int rep = 0; rep < 2; ++rep) {
#endif
    { GEOM; const bf16* BIG = WSP(const bf16*, WS_BIG);
      for (int u = bx; u < 1536; u += G) {
        if (u < 1024) ret_a_unit(lds, BIG, WSP(bf16*, WS_RETS), u >> 9, (u >> 2) & 127, u & 3, tid);
        else { const int v = u - 1024; ssd_a_unit(lds, BIG, WSP(const float*, WS_DT), KF(10), KF(11), KF(12), KF(13), WSP(bf16*, WS_SSDS), WSP(float*, WS_TOT), v >> 8, (v >> 1) & 127, v & 1, tid); }
      } }
#ifdef P5_TWICE
    if (rep == 0) SEAM(); }
#endif
#ifdef DBG_FLAG
    { GEOM; unsigned* FL = (unsigned*)WSP(unsigned char*, WS_CTL + 32768); if (tid == 511) FL[bx * 16] = 5u; }
    SEAM();
    { GEOM; const unsigned* FL = (const unsigned*)WSP(unsigned char*, WS_CTL + 32768); int bad = 0; for (int k = 0; k < G; ++k) bad += (FL[k * 16] != 5u);
      float* o = KARG(float*, 24); for (size_t i = gtid; i < (size_t)M_TOK * DM; i += nth) o[i] = 1000.0f * (float)bad; return; }
#endif
    SEAM(); if (STOP_AFTER == 5) { GEOM; dump_bf16(KARG(float*, 24), DUMPC == 2 ? WSP(const bf16*, WS_XB) : DUMPC ? WSP(const bf16*, WS_SSDS) : WSP(const bf16*, WS_RETS), DM, 0, gtid, nth); return; }
    { GEOM; scan_phase(WSP(bf16*, WS_RETS), WSP(bf16*, WS_SSDS), WSP(const float*, WS_TOT), gtid, nth); }
    SEAM(); if (STOP_AFTER == 6) { GEOM; dump_bf16(KARG(float*, 24), DUMPC ? WSP(const bf16*, WS_SSDS) : WSP(const bf16*, WS_RETS), DM, 0, gtid, nth); return; }
#ifdef P7_TWICE
    for (int rep7 = 0; rep7 < 2; ++rep7)
#endif
    { GEOM; const bf16* BIG = WSP(const bf16*, WS_BIG); bf16* XB = WSP(bf16*, WS_XB);
      for (int u = bx; u < 1536; u += G) {
        if (u < 1024) ret_c_unit(lds, BIG, WSP(const bf16*, WS_RETS), KF(8), KF(9), XB, u >> 9, (u >> 2) & 127, u & 3, tid);
        else { const int v = u - 1024; ssd_c_unit(lds, BIG, WSP(const float*, WS_DT), KF(10), KF(11), KF(12), KF(13), KF(14), KF(15), WSP(const bf16*, WS_SSDS), XB, v >> 8, (v >> 1) & 127, v & 1, tid); }
      } }
    SEAM(); if (STOP_AFTER == 7) { GEOM; dump_bf16(KARG(float*, 24), WSP(const bf16*, WS_XB), DM, 0, gtid, nth); return; }
    { GEOM; pg8::Gemm g{WSP(const bf16*, WS_XB), WSP(const bf16*, WS_WOUT), M_TOK, DM, DM}; pg8::StaticOrder S; S.init(M_TOK, DM, G, bx); float* out = KARG(float*, 24); pg8::EpiRes E{out, out, DM, ALPHA, 1.0f};
      if (!SKIP_GEMM) pg8::gemm_phase<pg8::EpiRes, pg8::StaticOrder, GEMM_ALIGN, true>(lds, g, S, E); }
    SEAM(); if (STOP_AFTER == 8) return;
    { GEOM; ln_rows<true>(KARG(float*, 24), KF(17), KF(18), WSP(bf16*, WS_XB), gw, NGW, lane);
      LAS float* scr = (LAS float*)(lds + wave * 8448);
      convert_ffn(KF(19), KF(20), KF(21), WSP(bf16*, WS_WGU), WSP(bf16*, WS_WD), scr, gw, NGW, lane); }
    SEAM(); if (STOP_AFTER == 9) return;
    { GEOM; pg8::Gemm g{WSP(const bf16*, WS_XB), WSP(const bf16*, WS_WGU), M_TOK, NGU, DM}; pg8::StaticOrder S; S.init(M_TOK, NGU, G, bx); pg8::EpiSwiglu E{WSP(bf16*, WS_BIG), DFF};
      if (!SKIP_GEMM) pg8::gemm_phase<pg8::EpiSwiglu, pg8::StaticOrder, GEMM_ALIGN, true>(lds, g, S, E); }
    SEAM(); if (STOP_AFTER == 10) return;
    { GEOM; pg8::Gemm g{WSP(const bf16*, WS_BIG), WSP(const bf16*, WS_WD), M_TOK, DM, DFF}; pg8::StaticOrder S; S.init(M_TOK, DM, G, bx); float* out = KARG(float*, 24); pg8::EpiRes E{out, out, DM, ALPHA, 0.5f};
      if (!SKIP_GEMM) pg8::gemm_phase<pg8::EpiRes, pg8::StaticOrder, GEMM_ALIGN, true>(lds, g, S, E); }
    SEAM(); if (STOP_AFTER == 11) return;
    { GEOM; ln_rows<false>(KARG(float*, 24), KF(22), KF(23), WSP(bf16*, WS_XB), gw, NGW, lane); }
}

extern "C" void kernel_launch(void* const* d_in, const int* in_sizes, int n_in, void* d_out, int out_size, void* d_ws, size_t ws_size, hipStream_t stream) {
    static int grid = 0;
    if (grid == 0) {
        if (n_in != 24 || in_sizes[0] != M_TOK * DM || out_size != M_TOK * DM || ws_size < WS_END) {
            fprintf(stderr, "kernel_launch: unexpected problem (n_in %d, in0 %d, out %d, ws %zu); nothing launched\n", n_in, n_in > 0 ? in_sizes[0] : -1, out_size, ws_size); grid = -1; return; }
        int dev = 0, cus = 0, per_cu = 0;
        (void)hipGetDevice(&dev); (void)hipDeviceGetAttribute(&cus, hipDeviceAttributeMultiprocessorCount, dev);
        (void)hipFuncSetAttribute((const void*)fwd_megakernel, hipFuncAttributeMaxDynamicSharedMemorySize, LDS_BYTES);
        if (hipOccupancyMaxActiveBlocksPerMultiprocessor(&per_cu, (const void*)fwd_megakernel, NT, LDS_BYTES) != hipSuccess || per_cu < 1) { per_cu = 1; (void)hipGetLastError(); }
        if (cus < 1) cus = 256;
        grid = cus * per_cu;
    }
    if (grid < 0) return;
    if (hipMemsetAsync((char*)d_ws + WS_CTL, 0, CTL_ZERO_BYTES, stream) != hipSuccess) { fprintf(stderr, "kernel_launch: memset of the barrier words failed\n"); return; }
    Args a{};
    for (int i = 0; i < 24; ++i) a.in[i] = d_in[i];
    a.out = (float*)d_out; a.ws = (unsigned char*)d_ws;
    void* args[] = {&a};
    hipError_t e = hipLaunchCooperativeKernel((const void*)fwd_megakernel, dim3(grid), dim3(NT), args, LDS_BYTES, stream);
    if (e != hipSuccess) fprintf(stderr, "cooperative launch failed: %s (grid %d)\n", hipGetErrorString(e), grid);
}
```

```cpp
#include <hip/hip_runtime.h>
#include <hip/hip_cooperative_groups.h>
#include <cstdio>
#include <cstdint>
namespace cg = cooperative_groups;
namespace pg8 {
#define PG8_LAS __attribute__((address_space(3)))
typedef unsigned short bf16_t;
typedef short bf16x8 __attribute__((ext_vector_type(8)));
typedef float f32x4 __attribute__((ext_vector_type(4)));
typedef unsigned u32x4 __attribute__((ext_vector_type(4)));
constexpr int BM = 256, BK = 64, HALF = 128, HTB = HALF * BK * 2  , STAGE_BYTES = 8 * HTB, NXCD = 8, WGM = 8;

__host__ __device__ __forceinline__ int lds_byte(int r, int c) { const int st = (r >> 4) * 2 + (c >> 5), rr = r & 15, cc = c & 31, ob = rr * 64 + cc * 2; return st * 1024 + (ob ^ (((ob >> 9) & 1) << 5)); }
__host__ __device__ __forceinline__ void stage_rc(int b, int& R, int& C) { const int st = b / 1024, sb = b % 1024, swz = sb ^ (((sb >> 9) & 1) << 5); R = (st >> 1) * 16 + swz / 64; C = (st & 1) * 32 + (swz % 64) / 2; }
__host__ __device__ __forceinline__ int perm32(int rho) { const int n = rho >> 4, i = rho & 15; return 8 * (i >> 2) + 4 * n + (i & 3); }

struct Unit { int pm, pn; };
struct Gemm { const bf16_t* A; const bf16_t* Bt; int M, N, K; };

struct StaticOrder {
    int nM, nN, nwg, G, c;
    __host__ __device__ void init(int M, int N, int G_, int c_) { nM = M / BM; nN = N / BM; nwg = nM * nN; G = G_; c = c_; }
    __host__ __device__ bool next(int i, Unit& u) const {
        const long L = (long)i * G + c; if (L >= nwg) return false;
        int wgid = (int)L; { const int q = nwg / NXCD, r = nwg % NXCD, xcd = wgid % NXCD, off = wgid / NXCD; wgid = (xcd < r ? xcd * (q + 1) : r * (q + 1) + (xcd - r) * q) + off; }
        const int nig = WGM * nN, gid = wgid / nig, fm = gid * WGM, gsz = (nM - fm) < WGM ? (nM - fm) : WGM;
        u.pm = fm + ((wgid % nig) % gsz); u.pn = (wgid % nig) / gsz; return true;
    }
    __device__ __forceinline__ void a_ready(const Unit&) const {}
    __device__ __forceinline__ void done(const Unit&) const {}
};

typedef float cvt_f32x2 __attribute__((ext_vector_type(2)));
typedef __bf16 cvt_bf16x2 __attribute__((ext_vector_type(2)));
__device__ __forceinline__ unsigned cvt_pk_bf16(float lo, float hi) { const cvt_f32x2 v = {lo, hi}; return __builtin_bit_cast(unsigned, __builtin_convertvector(v, cvt_bf16x2)); }

__device__ __forceinline__ float swi(float g, float u) { return g * u * __builtin_amdgcn_rcpf(1.0f + __expf(-g)); }
struct EpiSwiglu {
    static constexpr bool PERM = true, AFTER_DRAIN = false;
    bf16_t* H; int ldh;
    __device__ __forceinline__ void operator()(const f32x4 (&acc)[2][2][4][2], const Unit& u, int wr, int wc, int fr, int fq) const {
        const int row0 = u.pm * BM + wr * 64 + fr, col0 = u.pn * 128 + wc * 32 + 8 * fq;
#pragma unroll
        for (int ai = 0; ai < 2; ++ai)
#pragma unroll
            for (int m = 0; m < 4; ++m) {
                bf16_t* p = H + (size_t)(row0 + ai * HALF + m * 16) * ldh + col0;
                const f32x4 g0 = acc[ai][0][m][0], g1 = acc[ai][0][m][1], u0 = acc[ai][1][m][0], u1 = acc[ai][1][m][1];
                u32x4 w;
                w.x = cvt_pk_bf16(swi(g0[0], u0[0]), swi(g0[1], u0[1])); w.y = cvt_pk_bf16(swi(g0[2], u0[2]), swi(g0[3], u0[3]));
                w.z = cvt_pk_bf16(swi(g1[0], u1[0]), swi(g1[1], u1[1])); w.w = cvt_pk_bf16(swi(g1[2], u1[2]), swi(g1[3], u1[3]));
                *(u32x4*)p = w;
            }
    }
};
struct EpiRes {
    static constexpr bool PERM = false, AFTER_DRAIN = false;
    const float* res; float* out; int ld; float alpha, s;
    __device__ __forceinline__ void operator()(const f32x4 (&acc)[2][2][4][2], const Unit& u, int wr, int wc, int fr, int fq) const {
        const int row0 = u.pm * BM + wr * 64 + fr, col0 = u.pn * BM + wc * 32 + 4 * fq;
#pragma unroll
        for (int ai = 0; ai < 2; ++ai)
#pragma unroll
            for (int m = 0; m < 4; ++m) {
                const size_t off = (size_t)(row0 + ai * HALF + m * 16) * ld + col0;
#pragma unroll
                for (int bj = 0; bj < 2; ++bj)
#pragma unroll
                    for (int n = 0; n < 2; ++n) {
                        const f32x4 r = *(const f32x4*)(res + off + bj * HALF + n * 16);
                        *(f32x4*)(out + off + bj * HALF + n * 16) = r * alpha + acc[ai][bj][m][n] * s;
                    }
            }
    }
};
struct EpiInProj {
    static constexpr bool PERM = true, AFTER_DRAIN = false;
    bf16_t* P; const float* cs; const float* sn; float* DT;
    __device__ __forceinline__ void operator()(const f32x4 (&acc)[2][2][4][2], const Unit& u, int wr, int wc, int fr, int fq) const {
        const int row0 = u.pm * BM + wr * 64 + fr, pn = u.pn;
#pragma unroll
        for (int ai = 0; ai < 2; ++ai)
#pragma unroll
            for (int m = 0; m < 4; ++m) {
                const int row = row0 + ai * HALF + m * 16;
#pragma unroll
                for (int bj = 0; bj < 2; ++bj) {
                    const int colt = bj * HALF + wc * 32 + 8 * fq;
                    f32x4 v0 = acc[ai][bj][m][0], v1 = acc[ai][bj][m][1];
                    if (pn < 8) {
                        const f32x4 c = *(const f32x4*)(cs + (size_t)row * 128 + (colt >> 1)), s = *(const f32x4*)(sn + (size_t)row * 128 + (colt >> 1));
                        const float sc = pn >= 4 ? 0.0625f : 1.0f;
                        f32x4 a, b;
                        a[0] = (v0[0] * c[0] - v0[1] * s[0]) * sc; a[1] = (v0[1] * c[0] + v0[0] * s[0]) * sc;
                        a[2] = (v0[2] * c[1] - v0[3] * s[1]) * sc; a[3] = (v0[3] * c[1] + v0[2] * s[1]) * sc;
                        b[0] = (v1[0] * c[2] - v1[1] * s[2]) * sc; b[1] = (v1[1] * c[2] + v1[0] * s[2]) * sc;
                        b[2] = (v1[2] * c[3] - v1[3] * s[3]) * sc; b[3] = (v1[3] * c[3] + v1[2] * s[3]) * sc;
                        v0 = a; v1 = b;
                    }
                    if (pn < 26) {
                        u32x4 w; w.x = cvt_pk_bf16(v0[0], v0[1]); w.y = cvt_pk_bf16(v0[2], v0[3]); w.z = cvt_pk_bf16(v1[0], v1[1]); w.w = cvt_pk_bf16(v1[2], v1[3]);
                        *(u32x4*)(P + (size_t)row * 6672 + pn * BM + colt) = w;
                    } else if (colt < 16) {
                        *(f32x4*)(DT + (size_t)row * 16 + colt) = v0; *(f32x4*)(DT + (size_t)row * 16 + colt + 4) = v1;
                    }
                }
            }
    }
};

typedef float f32x2e __attribute__((ext_vector_type(2)));
struct EpiResLN {
    static constexpr bool PERM = false, AFTER_DRAIN = false;
    float* out; int ld; const float* stats; const float* gain; const float* bias; float alpha, s;
    __device__ __forceinline__ void operator()(const f32x4 (&acc)[2][2][4][2], const Unit& u, int wr, int wc, int fr, int fq) const {
        const int row0 = u.pm * BM + wr * 64 + fr, col0 = u.pn * BM + wc * 32 + 4 * fq;
#pragma unroll
        for (int bj = 0; bj < 2; ++bj)
#pragma unroll
            for (int n = 0; n < 2; ++n) {
                const f32x4 g = *(const f32x4*)(gain + col0 + bj * HALF + n * 16), b = *(const f32x4*)(bias + col0 + bj * HALF + n * 16);
#pragma unroll
                for (int ai = 0; ai < 2; ++ai)
#pragma unroll
                    for (int m = 0; m < 4; ++m) {
                        const int row = row0 + ai * HALF + m * 16;
                        const f32x2e st = *(const f32x2e*)(stats + 2 * (size_t)row);
                        float* p = out + (size_t)row * ld + col0 + bj * HALF + n * 16;
                        const f32x4 y = *(const f32x4*)p;
                        const f32x4 x = (y - st.x) * st.y * g + b;
                        *(f32x4*)p = x * alpha + acc[ai][bj][m][n] * s;
                    }
            }
    }
};
template <class Epi, class Sched, bool ALIGN_EPI = false, bool SP2 = false>
__device__ __forceinline__ void gemm_phase(PG8_LAS unsigned char* lds, const Gemm g, const Sched& S, const Epi& E) {
    int tid_o = threadIdx.x; asm volatile("" : "+v"(tid_o));
    const int tid = tid_o, wid = __builtin_amdgcn_readfirstlane(tid >> 6), lane = tid & 63, wr = wid >> 2, wc = wid & 3, fr = lane & 15, fq = lane >> 4;
    const int K = g.K, nt = K / BK;
    unsigned voffA[2], voffB[2];
#pragma unroll
    for (int i = 0; i < 2; ++i) { int R, C; stage_rc(tid * 16 + i * 8192, R, C); const int Rb = Epi::PERM ? ((R & ~31) + perm32(R & 31)) : R;
        voffA[i] = (unsigned)(R * K + C) * 2u; voffB[i] = (unsigned)(Rb * K + C) * 2u; }
    const size_t kstep = (size_t)(BK * 2);
    const size_t hstep = (size_t)HALF * K * 2;
    const size_t tstep = 2 * hstep;
    const unsigned ldsw = (unsigned)wid * 1024u;
    const int aoff = lds_byte(wr * 64 + fr, fq * 8), boff = lds_byte(wc * 32 + fr, fq * 8);
#define PG8_SA(b, h) (((b) * 2 + (h)) * HTB)
#define PG8_SB(b, h) ((4 + (b) * 2 + (h)) * HTB)
#define PG8_STAGE(bufoff, gbase, voff) do { _Pragma("unroll") for (int _i = 0; _i < 2; ++_i) \
        __builtin_amdgcn_global_load_lds((const unsigned*)((const char*)(gbase) + (voff)[_i]), (PG8_LAS unsigned*)(lds + (bufoff) + ldsw + _i * 8192), 16, 0, 0); } while (0)
#define PG8_LDA(dst, b, h) do { _Pragma("unroll") for (int m = 0; m < 4; ++m) _Pragma("unroll") for (int k = 0; k < 2; ++k) dst[m][k] = *(const PG8_LAS bf16x8*)(lds + PG8_SA(b, h) + aoff + m * 2048 + k * 1024); } while (0)
#define PG8_LDB(dst, b, h) do { _Pragma("unroll") for (int n = 0; n < 2; ++n) _Pragma("unroll") for (int k = 0; k < 2; ++k) dst[n][k] = *(const PG8_LAS bf16x8*)(lds + PG8_SB(b, h) + boff + n * 2048 + k * 1024); } while (0)
#define PG8_MMA(ai, bj, At, Bt) do { __builtin_amdgcn_s_setprio(1); _Pragma("unroll") for (int m = 0; m < 4; ++m) _Pragma("unroll") for (int n = 0; n < 2; ++n) _Pragma("unroll") for (int k = 0; k < 2; ++k) \
        acc[ai][bj][m][n] = __builtin_amdgcn_mfma_f32_16x16x32_bf16(Bt[n][k], At[m][k], acc[ai][bj][m][n], 0, 0, 0); __builtin_amdgcn_s_setprio(0); } while (0)
#define PG8_WAIT_V(n) asm volatile("s_waitcnt vmcnt(" #n ")" ::: "memory")
#define PG8_WAIT_L(n) asm volatile("s_waitcnt lgkmcnt(" #n ")" ::: "memory")
#define PG8_BAR __builtin_amdgcn_s_barrier()
#define PG8_SCHED __builtin_amdgcn_sched_barrier(0)
    Unit cur, nxt; int ui = 0;
    if (!S.next(0, cur)) return;
    f32x4 acc[2][2][4][2];
#pragma unroll
    for (int a = 0; a < 2; ++a)
#pragma unroll
        for (int b = 0; b < 2; ++b)
#pragma unroll
            for (int m = 0; m < 4; ++m)
#pragma unroll
                for (int n = 0; n < 2; ++n) acc[a][b][m][n] = (f32x4){0.f, 0.f, 0.f, 0.f};
    bf16x8 At[4][2], B0[2][2], B1[2][2];
    const char* cA = (const char*)g.A + (size_t)cur.pm * tstep; const char* cB = (const char*)g.Bt + (size_t)cur.pn * tstep;
    S.a_ready(cur);
    if constexpr (SP2) {
        PG8_STAGE(PG8_SB(0, 0), cB, voffB); PG8_STAGE(PG8_SB(0, 1), cB + hstep, voffB); PG8_STAGE(PG8_SA(0, 0), cA, voffA); PG8_STAGE(PG8_SA(0, 1), cA + hstep, voffA);
        if (wr == 1) PG8_BAR;
        PG8_WAIT_V(2); PG8_BAR;
        PG8_STAGE(PG8_SB(1, 0), cB + kstep, voffB); PG8_STAGE(PG8_SA(1, 0), cA + kstep, voffA); PG8_STAGE(PG8_SB(1, 1), cB + hstep + kstep, voffB);
        PG8_WAIT_V(6); PG8_BAR;
    } else {
        PG8_STAGE(PG8_SB(0, 0), cB, voffB); PG8_STAGE(PG8_SA(0, 0), cA, voffA); PG8_STAGE(PG8_SB(0, 1), cB + hstep, voffB); PG8_STAGE(PG8_SA(0, 1), cA + hstep, voffA);
        if (wr == 1) PG8_BAR;
        PG8_WAIT_V(4); PG8_BAR;
        PG8_STAGE(PG8_SB(1, 0), cB + kstep, voffB); PG8_STAGE(PG8_SA(1, 0), cA + kstep, voffA); PG8_STAGE(PG8_SB(1, 1), cB + hstep + kstep, voffB);
        PG8_WAIT_V(6); PG8_BAR;
    }
    for (;;) {
        const bool has_next = S.next(ui + 1, nxt);
        const char* nA = has_next ? (const char*)g.A + (size_t)nxt.pm * tstep : cA; const char* nB = has_next ? (const char*)g.Bt + (size_t)nxt.pn * tstep : cB;
        for (int t = 0; t < nt; t += 2) {
            const bool last = (t == nt - 2);
            const char* a1 = cA + (size_t)(t + 1) * kstep;
            const char* a2 = last ? nA : cA + (size_t)(t + 2) * kstep; const char* b2 = last ? nB : cB + (size_t)(t + 2) * kstep;
            const char* a3 = a2 + kstep; const char* b3 = b2 + kstep;
            if (last && has_next) S.a_ready(nxt);
            if constexpr (SP2) {
            PG8_LDB(B0, 0, 0); PG8_LDB(B1, 0, 1); PG8_SCHED; PG8_LDA(At, 0, 0); PG8_STAGE(PG8_SA(1, 1), a1 + hstep, voffA);
            PG8_WAIT_V(8); PG8_WAIT_L(0); PG8_BAR; PG8_MMA(0, 0, At, B0); PG8_MMA(0, 1, At, B1); PG8_BAR; PG8_SCHED;
            PG8_LDA(At, 0, 1); PG8_STAGE(PG8_SB(0, 0), b2, voffB); PG8_STAGE(PG8_SB(0, 1), b2 + hstep, voffB); PG8_STAGE(PG8_SA(0, 0), a2, voffA);
            PG8_WAIT_V(8); PG8_WAIT_L(0); PG8_BAR; PG8_MMA(1, 0, At, B0); PG8_MMA(1, 1, At, B1); PG8_BAR; PG8_SCHED;
            PG8_LDB(B0, 1, 0); PG8_LDB(B1, 1, 1); PG8_SCHED; PG8_LDA(At, 1, 0); PG8_STAGE(PG8_SA(0, 1), a2 + hstep, voffA);
            PG8_WAIT_V(8); PG8_WAIT_L(0); PG8_BAR; PG8_MMA(0, 0, At, B0); PG8_MMA(0, 1, At, B1); PG8_BAR; PG8_SCHED;
            PG8_LDA(At, 1, 1); PG8_STAGE(PG8_SB(1, 0), b3, voffB); PG8_STAGE(PG8_SB(1, 1), b3 + hstep, voffB); PG8_STAGE(PG8_SA(1, 0), a3, voffA);
            PG8_WAIT_V(8); PG8_WAIT_L(0); PG8_BAR; PG8_MMA(1, 0, At, B0); PG8_MMA(1, 1, At, B1); PG8_BAR; PG8_SCHED;
            } else {
            PG8_LDB(B0, 0, 0); PG8_SCHED; PG8_LDA(At, 0, 0); PG8_STAGE(PG8_SA(1, 1), a1 + hstep, voffA);
            PG8_WAIT_L(8); PG8_BAR; PG8_WAIT_L(0); PG8_MMA(0, 0, At, B0); PG8_BAR; PG8_SCHED;
            PG8_LDB(B1, 0, 1); PG8_STAGE(PG8_SB(0, 0), b2, voffB);
            PG8_BAR; PG8_WAIT_L(0); PG8_MMA(0, 1, At, B1); PG8_BAR;
            PG8_LDA(At, 0, 1); PG8_STAGE(PG8_SA(0, 0), a2, voffA);
            PG8_BAR; PG8_WAIT_L(0); PG8_MMA(1, 0, At, B0); PG8_BAR; PG8_SCHED;
            PG8_STAGE(PG8_SB(0, 1), b2 + hstep, voffB);
            PG8_WAIT_V(6); PG8_BAR; PG8_MMA(1, 1, At, B1); PG8_BAR;
            PG8_LDB(B0, 1, 0); PG8_SCHED; PG8_LDA(At, 1, 0); PG8_STAGE(PG8_SA(0, 1), a2 + hstep, voffA);
            PG8_WAIT_L(8); PG8_BAR; PG8_WAIT_L(0); PG8_MMA(0, 0, At, B0); PG8_BAR; PG8_SCHED;
            PG8_LDB(B1, 1, 1); PG8_STAGE(PG8_SB(1, 0), b3, voffB);
            PG8_BAR; PG8_WAIT_L(0); PG8_MMA(0, 1, At, B1); PG8_BAR;
            PG8_LDA(At, 1, 1); PG8_STAGE(PG8_SA(1, 0), a3, voffA);
            PG8_BAR; PG8_WAIT_L(0); PG8_MMA(1, 0, At, B0); PG8_BAR; PG8_SCHED;
            PG8_STAGE(PG8_SB(1, 1), b3 + hstep, voffB);
            PG8_WAIT_V(6); PG8_BAR; PG8_MMA(1, 1, At, B1); PG8_BAR;
            }
        }
        if constexpr (ALIGN_EPI) { if (wr == 0) PG8_BAR; }
        if constexpr (!Epi::AFTER_DRAIN) { E(acc, cur, wr, wc, fr, fq); S.done(cur); }
        if (!has_next) break;
#pragma unroll
        for (int a = 0; a < 2; ++a)
#pragma unroll
            for (int b = 0; b < 2; ++b)
#pragma unroll
                for (int m = 0; m < 4; ++m)
#pragma unroll
                    for (int n = 0; n < 2; ++n) acc[a][b][m][n] = (f32x4){0.f, 0.f, 0.f, 0.f};
        cur = nxt; cA = nA; cB = nB; ++ui;
        if constexpr (ALIGN_EPI) { if (wr == 1) PG8_BAR; }
    }
    PG8_WAIT_V(0);
    if constexpr (!ALIGN_EPI) { if (wr == 0) PG8_BAR; }
    PG8_BAR;
    if constexpr (Epi::AFTER_DRAIN) { E.fused(acc, cur, wr, wc, fr, fq, lds, wid, lane); S.done(cur); }
#undef PG8_SA
#undef PG8_SB
#undef PG8_STAGE
#undef PG8_LDA
#undef PG8_LDB
#undef PG8_MMA
#undef PG8_WAIT_V
#undef PG8_WAIT_L
#undef PG8_BAR
#undef PG8_SCHED
}
}

#define LAS __attribute__((address_space(3)))
typedef unsigned short bf16;
typedef unsigned u32x4 __attribute__((ext_vector_type(4)));
typedef unsigned u32x2 __attribute__((ext_vector_type(2)));
typedef float f32x4 __attribute__((ext_vector_type(4)));
typedef short bf16x8 __attribute__((ext_vector_type(8)));

constexpr int NT = 512;
constexpr int M_TOK = 16384, SEQ = 8192, DM = 2048, DFF = 5632, NGU = 11264, NIN = 6672, NINP = 6912, PLD = 6672;
constexpr float LN_EPS = 1e-5f;
constexpr float ALPHA = 1.189207115002721f;
constexpr size_t MiB = (size_t)1 << 20;
constexpr size_t WS_RETS = 0, WS_SSDS = 128 * MiB, WS_WGU = 0, WS_WD = 44 * MiB, WS_WIN = 66 * MiB, WS_COS = 93 * MiB, WS_SIN = 101 * MiB,
                 WS_WOUT = 192 * MiB, WS_XB = 200 * MiB, WS_BIG = 264 * MiB, WS_DT = 473 * MiB, WS_TOT = 474 * MiB, WS_STATS = 474 * MiB + 65536, WS_CTL = 475 * MiB, WS_END = 476 * MiB;
constexpr size_t CTL_ZERO_BYTES = 65536;
constexpr int MISC_OFF = 152064;
constexpr int LDS_BYTES = 153600;

__device__ __forceinline__ float lo16(unsigned w) { return __uint_as_float(w << 16); }
__device__ __forceinline__ float hi16(unsigned w) { return __uint_as_float(w & 0xffff0000u); }
__device__ __forceinline__ float bf2f(bf16 h) { return __uint_as_float((unsigned)h << 16); }
__device__ __forceinline__ bf16 f2bf(float f) { unsigned u = __float_as_uint(f); return (bf16)((u + 0x7fffu + ((u >> 16) & 1u)) >> 16); }
__device__ __forceinline__ unsigned pk2(float a, float b) { return pg8::cvt_pk_bf16(a, b); }
__device__ __forceinline__ float wave_sum(float v) {
#pragma unroll
    for (int o = 1; o < 64; o <<= 1) v += __shfl_xor(v, o);
    return v;
}
__device__ __forceinline__ float silu_f(float x) { return x * __builtin_amdgcn_rcpf(1.0f + __expf(-x)); }
__device__ __forceinline__ f32x4 mma(bf16x8 y, bf16x8 x, f32x4 c) { return __builtin_amdgcn_mfma_f32_16x16x32_bf16(y, x, c, 0, 0, 0); }
__device__ __forceinline__ unsigned opaque0() { unsigned z; asm volatile("s_mov_b32 %0, 0" : "=s"(z)); return z; }
#define LDS_WAIT() asm volatile("s_waitcnt lgkmcnt(0)" ::: "memory")
#define FRAG(p) (*(const LAS bf16x8*)(p))

__device__ __forceinline__ void xpose_item(const float* W, int Nsrc, int K, bf16* WT, int k0, int n0, int drow0, LAS float* scr, int lane) {
    const int nn = n0 + (lane & 31);
#pragma unroll 8
    for (int i = 0; i < 32; ++i) { const int kk = 2 * i + (lane >> 5); scr[kk * 33 + (lane & 31)] = nn < Nsrc ? W[(size_t)(k0 + kk) * Nsrc + nn] : 0.0f; }
    LDS_WAIT();
    const int c = lane & 7;
#pragma unroll
    for (int j = 0; j < 4; ++j) { const int n = (lane >> 3) + 8 * j; const LAS float* s = scr + (8 * c) * 33 + n;
        u32x4 o; o.x = pk2(s[0 * 33], s[1 * 33]); o.y = pk2(s[2 * 33], s[3 * 33]); o.z = pk2(s[4 * 33], s[5 * 33]); o.w = pk2(s[6 * 33], s[7 * 33]);
        *(u32x4*)(WT + (size_t)(drow0 + n) * K + k0 + 8 * c) = o; }
    LDS_WAIT();
}
__device__ __forceinline__ void convert_ffn(const float* wg, const float* wu, const float* wd, bf16* WGU, bf16* WD, LAS float* scr, int gw, int NGW, int lane) {
    for (int it = gw; it < 3 * 5632; it += NGW) {
        int r = it;
        if (r < 2 * 5632) { const int up = r >= 5632 ? 1 : 0; r -= up * 5632; const int kb = r / 176, nb = r % 176, n0 = nb * 32;
            xpose_item(up ? wu : wg, DFF, DM, WGU, kb * 64, n0, 256 * (n0 >> 7) + (n0 & 127) + up * 128, scr, lane); }
        else { r -= 2 * 5632; const int kb = r / 64, nb = r % 64; xpose_item(wd, DM, DFF, WD, kb * 64, nb * 32, nb * 32, scr, lane); }
    }
}
template <bool WBF>
__device__ __forceinline__ void ln_rows(float* io, const float* gain, const float* bias, bf16* xb, float* stats, int gw, int NGW, int lane) {
    for (int row = gw; row < M_TOK; row += NGW) {
        f32x4* p = (f32x4*)(io + (size_t)row * DM) + lane;
        f32x4 v[8]; float s = 0.f;
#pragma unroll
        for (int j = 0; j < 8; ++j) { v[j] = p[64 * j]; s += (v[j][0] + v[j][1]) + (v[j][2] + v[j][3]); }
        const float mean = wave_sum(s) * (1.0f / DM); float s2 = 0.f;
#pragma unroll
        for (int j = 0; j < 8; ++j) { v[j] = v[j] - mean; s2 += (v[j][0] * v[j][0] + v[j][1] * v[j][1]) + (v[j][2] * v[j][2] + v[j][3] * v[j][3]); }
        const float rstd = 1.0f / sqrtf(wave_sum(s2) * (1.0f / DM) + LN_EPS);
#pragma unroll
        for (int j = 0; j < 8; ++j) {
            const f32x4 g = ((const f32x4*)gain)[lane + 64 * j], b = ((const f32x4*)bias)[lane + 64 * j];
            const f32x4 o = v[j] * rstd * g + b;
            if (!WBF) p[64 * j] = o;
            if (WBF) { u32x2 w; w.x = pk2(o[0], o[1]); w.y = pk2(o[2], o[3]); ((u32x2*)(xb + (size_t)row * DM))[lane + 64 * j] = w; }
        }
        if (WBF && lane == 0) { stats[2 * (size_t)row] = mean; stats[2 * (size_t)row + 1] = rstd; }
    }
}

__device__ __forceinline__ void conv8(const bf16* PROJ, const float* cw, const float* cb, size_t tokrow, int t, int ch, f32x4& a0, f32x4& a1) {
    a0 = *(const f32x4*)(cb + ch); a1 = *(const f32x4*)(cb + ch + 4);
#pragma unroll
    for (int k = 0; k < 4; ++k) {
        if (t - 3 + k >= 0) {
            const u32x4 raw = *(const u32x4*)(PROJ + (tokrow - 3 + k) * PLD + 5120 + ch);
            const f32x4 w0 = *(const f32x4*)(cw + k * 1536 + ch), w1 = *(const f32x4*)(cw + k * 1536 + ch + 4);
            a0[0] += w0[0] * lo16(raw.x); a0[1] += w0[1] * hi16(raw.x); a0[2] += w0[2] * lo16(raw.y); a0[3] += w0[3] * hi16(raw.y);
            a1[0] += w1[0] * lo16(raw.z); a1[1] += w1[1] * hi16(raw.z); a1[2] += w1[2] * lo16(raw.w); a1[3] += w1[3] * hi16(raw.w);
        }
    }
#pragma unroll
    for (int i = 0; i < 4; ++i) { a0[i] = silu_f(a0[i]); a1[i] = silu_f(a1[i]); }
}
__device__ __forceinline__ void dt_acum(const float* DT, const float* dt_bias, const float* a_log, size_t tok0, int head, int lane, float& dt, float& ac) {
    const float x = DT[(tok0 + lane) * 16 + head] + dt_bias[head];
    dt = x > 20.0f ? x : log1pf(expf(x));
    float s = dt * (-expf(a_log[head]));
#pragma unroll
    for (int o = 1; o < 64; o <<= 1) { const float t = __shfl_up(s, o); if (lane >= o) s += t; }
    ac = s;
}

template <int I> __device__ __forceinline__ float bfel(const u32x4& w) { const unsigned x = (I >> 1) == 0 ? w.x : (I >> 1) == 1 ? w.y : (I >> 1) == 2 ? w.z : w.w; return (I & 1) ? hi16(x) : lo16(x); }
template <int I> __device__ __forceinline__ void xp_row(const u32x4 (&raw)[8], const float (&sc)[8], LAS bf16* dst, int stride) {
    u32x4 w; w.x = pk2(bfel<I>(raw[0]) * sc[0], bfel<I>(raw[1]) * sc[1]); w.y = pk2(bfel<I>(raw[2]) * sc[2], bfel<I>(raw[3]) * sc[3]);
    w.z = pk2(bfel<I>(raw[4]) * sc[4], bfel<I>(raw[5]) * sc[5]); w.w = pk2(bfel<I>(raw[6]) * sc[6], bfel<I>(raw[7]) * sc[7]);
    *(LAS u32x4*)(dst + I * stride) = w;
}
__device__ __forceinline__ void xpose8_store(const u32x4 (&raw)[8], const float (&sc)[8], LAS bf16* dst, int stride) {
    xp_row<0>(raw, sc, dst, stride); xp_row<1>(raw, sc, dst, stride); xp_row<2>(raw, sc, dst, stride); xp_row<3>(raw, sc, dst, stride);
    xp_row<4>(raw, sc, dst, stride); xp_row<5>(raw, sc, dst, stride); xp_row<6>(raw, sc, dst, stride); xp_row<7>(raw, sc, dst, stride);
}
__device__ __forceinline__ void conv_tile8(const bf16* PROJ, const float* cw, const float* cb, size_t tok0, int t0, int tg, int chn, f32x4 (&o0)[8], f32x4 (&o1)[8]) {
    u32x4 rw[11];
#pragma unroll
    for (int k = 0; k < 11; ++k) {
        const int tt = t0 + tg * 8 - 3 + k; const bool ok = tt >= 0; const int rel = ok ? (tg * 8 + k - 3) : -t0;
        const u32x4 v = *(const u32x4*)(PROJ + (size_t)((long)tok0 + rel) * PLD + 5120 + chn);
        rw[k].x = ok ? v.x : 0u; rw[k].y = ok ? v.y : 0u; rw[k].z = ok ? v.z : 0u; rw[k].w = ok ? v.w : 0u; }
    f32x4 w0[4], w1[4];
#pragma unroll
    for (int k = 0; k < 4; ++k) { w0[k] = *(const f32x4*)(cw + k * 1536 + chn); w1[k] = *(const f32x4*)(cw + k * 1536 + chn + 4); }
    const f32x4 b0 = *(const f32x4*)(cb + chn), b1 = *(const f32x4*)(cb + chn + 4);
#pragma unroll
    for (int r = 0; r < 8; ++r) {
        f32x4 a0 = b0, a1 = b1;
#pragma unroll
        for (int k = 0; k < 4; ++k) { const u32x4 x = rw[r + k];
            a0[0] += w0[k][0] * lo16(x.x); a0[1] += w0[k][1] * hi16(x.x); a0[2] += w0[k][2] * lo16(x.y); a0[3] += w0[k][3] * hi16(x.y);
            a1[0] += w1[k][0] * lo16(x.z); a1[1] += w1[k][1] * hi16(x.z); a1[2] += w1[k][2] * lo16(x.w); a1[3] += w1[k][3] * hi16(x.w); }
#pragma unroll
        for (int i = 0; i < 4; ++i) { a0[i] = silu_f(a0[i]); a1[i] = silu_f(a1[i]); }
        o0[r] = a0; o1[r] = a1;
    }
}
template <int I> __device__ __forceinline__ void ct_row(const f32x4 (&o0)[8], const f32x4 (&o1)[8], const float (&sc)[8], LAS bf16* dst, int stride) {
    float v[8];
#pragma unroll
    for (int r = 0; r < 8; ++r) v[r] = (I < 4 ? o0[r][I & 3] : o1[r][I & 3]) * sc[r];
    u32x4 w; w.x = pk2(v[0], v[1]); w.y = pk2(v[2], v[3]); w.z = pk2(v[4], v[5]); w.w = pk2(v[6], v[7]);
    *(LAS u32x4*)(dst + I * stride) = w;
}
__device__ __forceinline__ void conv_store_t(const f32x4 (&o0)[8], const f32x4 (&o1)[8], const float (&sc)[8], LAS bf16* dst, int stride) {
    ct_row<0>(o0, o1, sc, dst, stride); ct_row<1>(o0, o1, sc, dst, stride); ct_row<2>(o0, o1, sc, dst, stride); ct_row<3>(o0, o1, sc, dst, stride);
    ct_row<4>(o0, o1, sc, dst, stride); ct_row<5>(o0, o1, sc, dst, stride); ct_row<6>(o0, o1, sc, dst, stride); ct_row<7>(o0, o1, sc, dst, stride);
}

__device__ __forceinline__ void ret_a_unit(LAS unsigned char* lds, const bf16* PROJ, bf16* RETS, int b, int z, int h, int tid, bool P5_DO_STORE = true) {
    asm volatile("" : "+v"(tid));
    const int wave = tid >> 6, lane = tid & 63, l15 = lane & 15, l4 = lane >> 4;
    const size_t tok0 = (size_t)b * SEQ + (size_t)z * 64;
    const float lg2 = log2f(1.0f - exp2f(-5.0f - (float)h));
    LAS bf16* Kt = (LAS bf16*)lds;
    LAS bf16* Vt = (LAS bf16*)(lds + 36864);
    {
        const int mat = tid >> 8, ch = (tid >> 3) & 31, tg = tid & 7;
        u32x4 raw[8]; float sc[8];
#pragma unroll
        for (int r = 0; r < 8; ++r) raw[r] = *(const u32x4*)(PROJ + (tok0 + tg * 8 + r) * PLD + (mat ? 2048 : 1024) + h * 256 + ch * 8);
#pragma unroll
        for (int r = 0; r < 8; ++r) sc[r] = mat ? 1.0f : exp2f(lg2 * (float)(63 - (tg * 8 + r)));
        xpose8_store(raw, sc, (mat ? Vt : Kt) + (ch * 8) * 72 + tg * 8, 72);
    }
    __syncthreads();
#ifdef DBG_LDS
#define DBG_CHECK(slot) { int bad = 0; \
    for (int it = 0; it < 8; ++it) { const int q = it * NT + tid, j = q & 63, ch = (q >> 6) & 31, mat = q >> 11; \
        const u32x4 raw = *(const u32x4*)(PROJ + (tok0 + j) * PLD + (mat ? 2048 : 1024) + h * 256 + ch * 8); \
        const float sc = mat ? 1.0f : exp2f(lg2 * (float)(63 - j)); \
        volatile LAS bf16* dst = (mat ? Vt : Kt) + (ch * 8) * 72 + j; \
        bad += (dst[0 * 72] != f2bf(lo16(raw.x) * sc)) + (dst[1 * 72] != f2bf(hi16(raw.x) * sc)) + (dst[2 * 72] != f2bf(lo16(raw.y) * sc)) + (dst[3 * 72] != f2bf(hi16(raw.y) * sc)) \
             + (dst[4 * 72] != f2bf(lo16(raw.z) * sc)) + (dst[5 * 72] != f2bf(hi16(raw.z) * sc)) + (dst[6 * 72] != f2bf(lo16(raw.w) * sc)) + (dst[7 * 72] != f2bf(hi16(raw.w) * sc)); } \
    (RETS + (size_t)200 * 1024 * 1024 / 2)[(size_t)((b * 128 + z) * 4 + h) * 1024 + (slot) * 512 + tid] = f2bf(1000.0f * (float)bad); }
    DBG_CHECK(0)
#endif
    bf16* out = RETS + ((size_t)((b * 4 + h) * 128 + z)) * 65536;
#pragma unroll 1
    for (int dh = 0; dh < 2; ++dh) {
        f32x4 acc[2][8];
#pragma unroll
        for (int mt = 0; mt < 2; ++mt)
#pragma unroll
            for (int nt = 0; nt < 8; ++nt) acc[mt][nt] = (f32x4){0.f, 0.f, 0.f, 0.f};
#pragma unroll
        for (int ks = 0; ks < 2; ++ks) {
            bf16x8 xa[2];
#pragma unroll
            for (int mt = 0; mt < 2; ++mt) xa[mt] = FRAG(Vt + (32 * wave + 16 * mt + l15) * 72 + ks * 32 + 8 * l4);
#pragma unroll
            for (int nt = 0; nt < 8; ++nt) { const bf16x8 yb = FRAG(Kt + (128 * dh + 64 * (nt >> 2) + 16 * (l15 >> 2) + 4 * (nt & 3) + (l15 & 3)) * 72 + ks * 32 + 8 * l4);
#pragma unroll
                for (int mt = 0; mt < 2; ++mt) acc[mt][nt] = mma(yb, xa[mt], acc[mt][nt]); }
        }
#pragma unroll
        for (int mt = 0; mt < 2; ++mt)
#pragma unroll
            for (int gq = 0; gq < 2; ++gq) { const int e = 32 * wave + 16 * mt + l15, d = 128 * dh + 64 * gq + 16 * l4;
#pragma unroll
                for (int hh = 0; hh < 2; ++hh) { const f32x4 a = acc[mt][4 * gq + 2 * hh], c = acc[mt][4 * gq + 2 * hh + 1];
                    u32x4 w; w.x = pk2(a[0], a[1]); w.y = pk2(a[2], a[3]); w.z = pk2(c[0], c[1]); w.w = pk2(c[2], c[3]); if (P5_DO_STORE) *(u32x4*)(out + e * 256 + d + 8 * hh) = w; } }
    }
#ifdef DBG_LDS
    DBG_CHECK(1)
#endif
    __syncthreads();
}

__device__ __forceinline__ void ssd_a_unit(LAS unsigned char* lds, const bf16* PROJ, const float* DT, const float* cw, const float* cb, const float* dt_bias, const float* a_log,
                                           bf16* SSDS, float* TOT, int b, int z, int g, int tid, bool P5_DO_STORE = true) {
    asm volatile("" : "+v"(tid));
    const int wave = tid >> 6, lane = tid & 63, l15 = lane & 15, l4 = lane >> 4;
    const size_t tok0 = (size_t)b * SEQ + (size_t)z * 64;
    LAS bf16* Bt = (LAS bf16*)lds;
    LAS bf16* Xt = (LAS bf16*)(lds + 18432);
    LAS float* coef = (LAS float*)(lds + 92160);
    { float dt, ac; dt_acum(DT, dt_bias, a_log, tok0, g * 8 + wave, lane, dt, ac); const float last = __shfl(ac, 63);
      coef[wave * 64 + lane] = dt * expf(last - ac); if (lane == 63) TOT[(size_t)(b * 128 + z) * 16 + g * 8 + wave] = expf(last); }
    __syncthreads();
    {
        const int chx = tid >> 3, tg = tid & 7; f32x4 o0[8], o1[8]; float sc[8];
        conv_tile8(PROJ, cw, cb, tok0, z * 64, tg, g * 512 + chx * 8, o0, o1);
#pragma unroll
        for (int r = 0; r < 8; ++r) sc[r] = coef[(chx >> 3) * 64 + tg * 8 + r];
        conv_store_t(o0, o1, sc, Xt + (chx * 8) * 72 + tg * 8, 72);
    }
    if (tid < 128) {
        const int chb = tid >> 3, tg = tid & 7; f32x4 o0[8], o1[8]; float sc[8];
        conv_tile8(PROJ, cw, cb, tok0, z * 64, tg, 1024 + g * 128 + chb * 8, o0, o1);
#pragma unroll
        for (int r = 0; r < 8; ++r) sc[r] = 1.0f;
        conv_store_t(o0, o1, sc, Bt + (chb * 8) * 72 + tg * 8, 72);
    }
    __syncthreads();
    bf16* out = SSDS + ((size_t)((b * 16 + g * 8 + wave) * 128 + z)) * 8192;
#pragma unroll 1
    for (int nh = 0; nh < 2; ++nh) {
        f32x4 acc[4][4];
#pragma unroll
        for (int mt = 0; mt < 4; ++mt)
#pragma unroll
            for (int nt = 0; nt < 4; ++nt) acc[mt][nt] = (f32x4){0.f, 0.f, 0.f, 0.f};
#pragma unroll
        for (int ks = 0; ks < 2; ++ks) {
            bf16x8 xa[4];
#pragma unroll
            for (int mt = 0; mt < 4; ++mt) xa[mt] = FRAG(Xt + (64 * wave + 16 * mt + l15) * 72 + ks * 32 + 8 * l4);
#pragma unroll
            for (int nt = 0; nt < 4; ++nt) { const bf16x8 yb = FRAG(Bt + (64 * nh + 16 * (l15 >> 2) + 4 * nt + (l15 & 3)) * 72 + ks * 32 + 8 * l4);
#pragma unroll
                for (int mt = 0; mt < 4; ++mt) acc[mt][nt] = mma(yb, xa[mt], acc[mt][nt]); }
        }
#pragma unroll
        for (int mt = 0; mt < 4; ++mt)
#pragma unroll
            for (int hh = 0; hh < 2; ++hh) { const int p = 16 * mt + l15, n = 64 * nh + 16 * l4 + 8 * hh; const f32x4 a = acc[mt][2 * hh], c = acc[mt][2 * hh + 1];
                u32x4 w; w.x = pk2(a[0], a[1]); w.y = pk2(a[2], a[3]); w.z = pk2(c[0], c[1]); w.w = pk2(c[2], c[3]); if (P5_DO_STORE) *(u32x4*)(out + p * 128 + n) = w; }
    }
    __syncthreads();
}

__device__ __forceinline__ void scan_phase(bf16* RETS, bf16* SSDS, const float* TOT, int gtid, int nth) {
    for (int task = gtid; task < 98304; task += nth) {
        bf16* base; size_t stride; float cdec = 0.f; const float* totp = nullptr;
        if (task < 65536) { const int bh = task >> 13, e8 = task & 8191; base = RETS + (size_t)bh * 128 * 65536 + (size_t)e8 * 8; stride = 65536;
            cdec = exp2f(64.0f * log2f(1.0f - exp2f(-5.0f - (float)(bh & 3)))); }
        else { const int t2 = task - 65536, bhd = t2 >> 10, e8 = t2 & 1023; base = SSDS + (size_t)bhd * 128 * 8192 + (size_t)e8 * 8; stride = 8192;
            totp = TOT + (size_t)(bhd >> 4) * 128 * 16 + (bhd & 15); }
        float s0 = 0.f, s1 = 0.f, s2 = 0.f, s3 = 0.f, s4 = 0.f, s5 = 0.f, s6 = 0.f, s7 = 0.f;
#pragma unroll 1
        for (int z0 = 0; z0 < 128; z0 += 8) {
            u32x4 v[8]; float dec[8];
#pragma unroll
            for (int i = 0; i < 8; ++i) { v[i] = *(const u32x4*)(base + (size_t)(z0 + i) * stride); dec[i] = totp ? totp[(z0 + i) * 16] : cdec; }
#pragma unroll
            for (int i = 0; i < 8; ++i) {
                u32x4 o; o.x = pk2(s0, s1); o.y = pk2(s2, s3); o.z = pk2(s4, s5); o.w = pk2(s6, s7);
                *(u32x4*)(base + (size_t)(z0 + i) * stride) = o;
                const float d = dec[i];
                s0 = s0 * d + lo16(v[i].x); s1 = s1 * d + hi16(v[i].x); s2 = s2 * d + lo16(v[i].y); s3 = s3 * d + hi16(v[i].y);
                s4 = s4 * d + lo16(v[i].z); s5 = s5 * d + hi16(v[i].z); s6 = s6 * d + lo16(v[i].w); s7 = s7 * d + hi16(v[i].w);
            }
        }
    }
}

__device__ __forceinline__ void ret_c_unit(LAS unsigned char* lds, const bf16* PROJ, const bf16* RETS, const float* gn_g, const float* gn_b, bf16* MIX, int b, int z, int h, int tid) {
    asm volatile("" : "+v"(tid));
    const int wave = tid >> 6, lane = tid & 63, l15 = lane & 15, l4 = lane >> 4;
    const size_t tok0 = (size_t)b * SEQ + (size_t)z * 64;
    const float lg2 = log2f(1.0f - exp2f(-5.0f - (float)h));
    LAS bf16* Q = (LAS bf16*)lds;
    LAS bf16* Kn = (LAS bf16*)(lds + 33792);
    LAS bf16* Vt = (LAS bf16*)(lds + 67584);
    LAS bf16* Pm = (LAS bf16*)(lds + 104448);
    LAS float* st1 = (LAS float*)(lds + 113664);
    LAS float* st2 = (LAS float*)(lds + 115712);
    {
        u32x4 qk[8];
#pragma unroll
        for (int it = 0; it < 8; ++it) { const int q = it * NT + tid, ch = q & 31, j = (q >> 5) & 63, mat = q >> 11; qk[it] = *(const u32x4*)(PROJ + (tok0 + j) * PLD + mat * 1024 + h * 256 + ch * 8); }
        if (tid < 256) {
            const int ch = tid >> 3, tg = tid & 7; u32x4 raw[8]; float sc[8];
#pragma unroll
            for (int r = 0; r < 8; ++r) { raw[r] = *(const u32x4*)(PROJ + (tok0 + tg * 8 + r) * PLD + 2048 + h * 256 + ch * 8); sc[r] = 1.0f; }
            xpose8_store(raw, sc, Vt + (ch * 8) * 72 + tg * 8, 72);
        }
#pragma unroll
        for (int it = 0; it < 8; ++it) { const int q = it * NT + tid, ch = q & 31, j = (q >> 5) & 63, mat = q >> 11; *(LAS u32x4*)((mat ? Kn : Q) + j * 264 + ch * 8) = qk[it]; }
    }
    __syncthreads();
    {
        const int mt = wave >> 1, nt0 = 2 * (wave & 1);
        f32x4 sc[2] = {(f32x4){0.f, 0.f, 0.f, 0.f}, (f32x4){0.f, 0.f, 0.f, 0.f}};
#pragma unroll
        for (int ks = 0; ks < 8; ++ks) {
            const bf16x8 xa = FRAG(Q + (16 * mt + l15) * 264 + ks * 32 + 8 * l4);
#pragma unroll
            for (int n2 = 0; n2 < 2; ++n2) { const bf16x8 yb = FRAG(Kn + (16 * (nt0 + n2) + l15) * 264 + ks * 32 + 8 * l4); sc[n2] = mma(yb, xa, sc[n2]); }
        }
#pragma unroll
        for (int n2 = 0; n2 < 2; ++n2) {
            const int i = 16 * mt + l15 + (int)opaque0(), j0 = 16 * (nt0 + n2) + 4 * l4; float p[4];
#pragma unroll
            for (int ii = 0; ii < 4; ++ii) { const int j = j0 + ii; p[ii] = (j <= i) ? sc[n2][ii] * exp2f(lg2 * (float)(i - j)) : 0.0f; }
            u32x2 w; w.x = pk2(p[0], p[1]); w.y = pk2(p[2], p[3]); *(LAS u32x2*)(Pm + i * 72 + j0) = w;
        }
    }
    __syncthreads();
    f32x4 acc[4][2];
#pragma unroll
    for (int mt = 0; mt < 4; ++mt)
#pragma unroll
        for (int nt = 0; nt < 2; ++nt) acc[mt][nt] = (f32x4){0.f, 0.f, 0.f, 0.f};
    const bf16* S = RETS + ((size_t)((b * 4 + h) * 128 + z)) * 65536;
#pragma unroll
    for (int ks = 0; ks < 8; ++ks) {
        bf16x8 yb[2];
#pragma unroll
        for (int nt = 0; nt < 2; ++nt) yb[nt] = *(const bf16x8*)(S + (32 * wave + 8 * (l15 >> 2) + 4 * nt + (l15 & 3)) * 256 + ks * 32 + 8 * l4);
#pragma unroll
        for (int mt = 0; mt < 4; ++mt) { const bf16x8 xa = FRAG(Q + (16 * mt + l15) * 264 + ks * 32 + 8 * l4);
#pragma unroll
            for (int nt = 0; nt < 2; ++nt) acc[mt][nt] = mma(yb[nt], xa, acc[mt][nt]); }
    }
#pragma unroll
    for (int mt = 0; mt < 4; ++mt) { const float qd = exp2f(lg2 * (float)(16 * mt + l15 + 1));
#pragma unroll
        for (int nt = 0; nt < 2; ++nt) acc[mt][nt] = acc[mt][nt] * qd; }
#pragma unroll
    for (int ks = 0; ks < 2; ++ks) {
        bf16x8 yb[2];
#pragma unroll
        for (int nt = 0; nt < 2; ++nt) yb[nt] = FRAG(Vt + (32 * wave + 8 * (l15 >> 2) + 4 * nt + (l15 & 3)) * 72 + ks * 32 + 8 * l4);
#pragma unroll
        for (int mt = 0; mt < 4; ++mt) { const bf16x8 xa = FRAG(Pm + (16 * mt + l15) * 72 + ks * 32 + 8 * l4);
#pragma unroll
            for (int nt = 0; nt < 2; ++nt) acc[mt][nt] = mma(yb[nt], xa, acc[mt][nt]); }
    }
#pragma unroll
    for (int mt = 0; mt < 4; ++mt) {
        float s = 0.f;
#pragma unroll
        for (int nt = 0; nt < 2; ++nt) s += (acc[mt][nt][0] + acc[mt][nt][1]) + (acc[mt][nt][2] + acc[mt][nt][3]);
        s += __shfl_xor(s, 16); s += __shfl_xor(s, 32);
        if (l4 == 0) st1[wave * 64 + 16 * mt + l15] = s;
    }
    __syncthreads();
    float mean[4];
#pragma unroll
    for (int mt = 0; mt < 4; ++mt) { float m = 0.f;
#pragma unroll
        for (int w = 0; w < 8; ++w) m += st1[w * 64 + 16 * mt + l15];
        mean[mt] = m * (1.0f / 256.0f);
        float s = 0.f;
#pragma unroll
        for (int nt = 0; nt < 2; ++nt) { acc[mt][nt] = acc[mt][nt] - mean[mt]; s += (acc[mt][nt][0] * acc[mt][nt][0] + acc[mt][nt][1] * acc[mt][nt][1]) + (acc[mt][nt][2] * acc[mt][nt][2] + acc[mt][nt][3] * acc[mt][nt][3]); }
        s += __shfl_xor(s, 16); s += __shfl_xor(s, 32);
        if (l4 == 0) st2[wave * 64 + 16 * mt + l15] = s;
    }
    __syncthreads();
#pragma unroll
    for (int mt = 0; mt < 4; ++mt) { float q = 0.f; const int i = 16 * mt + l15;
#pragma unroll
        for (int w = 0; w < 8; ++w) q += st2[w * 64 + i];
        const float rstd = 1.0f / sqrtf(q * (1.0f / 256.0f) + LN_EPS);
        {
            const int col = h * 256 + 32 * wave + 8 * l4;
            const f32x4 g0 = *(const f32x4*)(gn_g + col), g1 = *(const f32x4*)(gn_g + col + 4), b0 = *(const f32x4*)(gn_b + col), b1 = *(const f32x4*)(gn_b + col + 4);
            const u32x4 graw = *(const u32x4*)(PROJ + (tok0 + i) * PLD + 3072 + col);
            const f32x4 o0 = acc[mt][0] * rstd * g0 + b0, o1 = acc[mt][1] * rstd * g1 + b1;
            u32x4 w; w.x = pk2(o0[0] * silu_f(lo16(graw.x)), o0[1] * silu_f(hi16(graw.x))); w.y = pk2(o0[2] * silu_f(lo16(graw.y)), o0[3] * silu_f(hi16(graw.y)));
            w.z = pk2(o1[0] * silu_f(lo16(graw.z)), o1[1] * silu_f(hi16(graw.z))); w.w = pk2(o1[2] * silu_f(lo16(graw.w)), o1[3] * silu_f(hi16(graw.w)));
            *(u32x4*)(MIX + (tok0 + i) * DM + col) = w;
        }
    }
    __syncthreads();
}

__device__ __forceinline__ void ssd_c_unit(LAS unsigned char* lds, const bf16* PROJ, const float* DT, const float* cw, const float* cb, const float* dt_bias, const float* a_log,
                                           const float* dskip, const float* ngain, const bf16* SSDS, bf16* MIX, int b, int z, int g, int tid) {
    asm volatile("" : "+v"(tid));
    const int wave = tid >> 6, lane = tid & 63, l15 = lane & 15, l4 = lane >> 4;
    const size_t tok0 = (size_t)b * SEQ + (size_t)z * 64;
    LAS bf16* Cm = (LAS bf16*)lds;
    LAS bf16* Bm = (LAS bf16*)(lds + 17408);
    LAS bf16* Xt = (LAS bf16*)(lds + 34816);
    LAS float* CB = (LAS float*)(lds + 108544);
    LAS float* dts = (LAS float*)(lds + 125184);
    LAS float* acs = (LAS float*)(lds + 127232);
    LAS bf16* Lw = (LAS bf16*)(lds + 129280 + wave * 2304);
    LAS float* ssq = (LAS float*)(lds + 147712);
    { float dt, ac; dt_acum(DT, dt_bias, a_log, tok0, g * 8 + wave, lane, dt, ac); dts[wave * 64 + lane] = dt; acs[wave * 64 + lane] = ac; }
    __syncthreads();
    {
        const int chx = tid >> 3, tg = tid & 7; f32x4 o0[8], o1[8]; float sc[8];
        conv_tile8(PROJ, cw, cb, tok0, z * 64, tg, g * 512 + chx * 8, o0, o1);
#pragma unroll
        for (int r = 0; r < 8; ++r) sc[r] = dts[(chx >> 3) * 64 + tg * 8 + r];
        conv_store_t(o0, o1, sc, Xt + (chx * 8) * 72 + tg * 8, 72);
    }
    if (tid < 256) {
        const int mat = tid >> 7, chb = (tid >> 3) & 15, tg = tid & 7; f32x4 o0[8], o1[8];
        conv_tile8(PROJ, cw, cb, tok0, z * 64, tg, 1024 + mat * 256 + g * 128 + chb * 8, o0, o1);
#pragma unroll
        for (int r = 0; r < 8; ++r) { u32x4 w; w.x = pk2(o0[r][0], o0[r][1]); w.y = pk2(o0[r][2], o0[r][3]); w.z = pk2(o1[r][0], o1[r][1]); w.w = pk2(o1[r][2], o1[r][3]);
            *(LAS u32x4*)((mat ? Cm : Bm) + (tg * 8 + r) * 136 + chb * 8) = w; }
    }
    __syncthreads();
    {
        const int mt = wave >> 1, nt0 = 2 * (wave & 1);
        f32x4 sc[2] = {(f32x4){0.f, 0.f, 0.f, 0.f}, (f32x4){0.f, 0.f, 0.f, 0.f}};
#pragma unroll
        for (int ks = 0; ks < 4; ++ks) {
            const bf16x8 xa = FRAG(Cm + (16 * mt + l15) * 136 + ks * 32 + 8 * l4);
#pragma unroll
            for (int n2 = 0; n2 < 2; ++n2) { const bf16x8 yb = FRAG(Bm + (16 * (nt0 + n2) + l15) * 136 + ks * 32 + 8 * l4); sc[n2] = mma(yb, xa, sc[n2]); }
        }
#pragma unroll
        for (int n2 = 0; n2 < 2; ++n2) { const int i = 16 * mt + l15, j0 = 16 * (nt0 + n2) + 4 * l4;
#pragma unroll
            for (int ii = 0; ii < 4; ++ii) CB[i * 65 + j0 + ii] = sc[n2][ii]; }
    }
    __syncthreads();
    const int r = wave, head = g * 8 + r;
    f32x4 acc[4][4];
#pragma unroll
    for (int mt = 0; mt < 4; ++mt)
#pragma unroll
        for (int nt = 0; nt < 4; ++nt) acc[mt][nt] = (f32x4){0.f, 0.f, 0.f, 0.f};
    const bf16* S = SSDS + ((size_t)((b * 16 + head) * 128 + z)) * 8192;
#pragma unroll
    for (int ks = 0; ks < 4; ++ks) {
        bf16x8 yb[4];
#pragma unroll
        for (int nt = 0; nt < 4; ++nt) yb[nt] = *(const bf16x8*)(S + (16 * (l15 >> 2) + 4 * nt + (l15 & 3)) * 128 + ks * 32 + 8 * l4);
#pragma unroll
        for (int mt = 0; mt < 4; ++mt) { const bf16x8 xa = FRAG(Cm + (16 * mt + l15) * 136 + ks * 32 + 8 * l4);
#pragma unroll
            for (int nt = 0; nt < 4; ++nt) acc[mt][nt] = mma(yb[nt], xa, acc[mt][nt]); }
    }
#pragma unroll
    for (int mt = 0; mt < 4; ++mt) { const float fs = expf(acs[r * 64 + 16 * mt + l15]);
#pragma unroll
        for (int nt = 0; nt < 4; ++nt) acc[mt][nt] = acc[mt][nt] * fs; }
#pragma unroll
    for (int mt = 0; mt < 4; ++mt) {
        const int i = 16 * mt + l15 + (int)opaque0(); const float ai = acs[r * 64 + i];
#pragma unroll
        for (int hh = 0; hh < 2; ++hh) {
            float lv[8];
#pragma unroll
            for (int k = 0; k < 8; ++k) { const int j = 16 * l4 + 8 * hh + k; const float e = expf(ai - acs[r * 64 + j]); lv[k] = (j <= i) ? CB[i * 65 + j] * e : 0.0f; }
            u32x4 w; w.x = pk2(lv[0], lv[1]); w.y = pk2(lv[2], lv[3]); w.z = pk2(lv[4], lv[5]); w.w = pk2(lv[6], lv[7]);
            *(LAS u32x4*)(Lw + l15 * 72 + 16 * l4 + 8 * hh) = w;
        }
        LDS_WAIT(); __builtin_amdgcn_wave_barrier();
#pragma unroll
        for (int ks = 0; ks < 2; ++ks) {
            const bf16x8 xa = FRAG(Lw + l15 * 72 + ks * 32 + 8 * l4);
#pragma unroll
            for (int nt = 0; nt < 4; ++nt) { const bf16x8 yb = FRAG(Xt + (64 * r + 16 * (l15 >> 2) + 4 * nt + (l15 & 3)) * 72 + ks * 32 + 8 * l4); acc[mt][nt] = mma(yb, xa, acc[mt][nt]); }
        }
        LDS_WAIT(); __builtin_amdgcn_wave_barrier();
    }
    const float dsk = dskip[head];
#pragma unroll
    for (int mt = 0; mt < 4; ++mt) {
        const int i = 16 * mt + l15; const float rdt = 1.0f / dts[r * 64 + i]; float sq = 0.f;
        const u32x4 zr0 = *(const u32x4*)(PROJ + (tok0 + i) * PLD + 4096 + g * 512 + r * 64 + 16 * l4), zr1 = *(const u32x4*)(PROJ + (tok0 + i) * PLD + 4096 + g * 512 + r * 64 + 16 * l4 + 8);
#pragma unroll
        for (int nt = 0; nt < 4; ++nt) {
            const int p0 = 16 * l4 + 4 * nt;
            const unsigned zw0 = nt == 0 ? zr0.x : nt == 1 ? zr0.z : nt == 2 ? zr1.x : zr1.z, zw1 = nt == 0 ? zr0.y : nt == 1 ? zr0.w : nt == 2 ? zr1.y : zr1.w;
            const float zz[4] = {lo16(zw0), hi16(zw0), lo16(zw1), hi16(zw1)};
#pragma unroll
            for (int ii = 0; ii < 4; ++ii) { const float x = bf2f(Xt[(64 * r + p0 + ii) * 72 + i]) * rdt; const float y = (acc[mt][nt][ii] + dsk * x) * silu_f(zz[ii]); acc[mt][nt][ii] = y; sq += y * y; }
        }
        sq += __shfl_xor(sq, 16); sq += __shfl_xor(sq, 32);
        if (l4 == 0) ssq[r * 64 + i] = sq;
    }
    __syncthreads();
#pragma unroll
    for (int mt = 0; mt < 4; ++mt) {
        const int i = 16 * mt + l15; float t = 0.f;
#pragma unroll
        for (int w = 0; w < 8; ++w) t += ssq[w * 64 + i];
        const float rstd = 1.0f / sqrtf(t * (1.0f / 512.0f) + LN_EPS);
#pragma unroll
        for (int hh = 0; hh < 2; ++hh) {
            const int col = g * 512 + r * 64 + 16 * l4 + 8 * hh;
            const f32x4 gn0 = *(const f32x4*)(ngain + col), gn1 = *(const f32x4*)(ngain + col + 4);
            const f32x4 o0 = acc[mt][2 * hh] * rstd * gn0, o1 = acc[mt][2 * hh + 1] * rstd * gn1;
            u32x4 w; w.x = pk2(o0[0], o0[1]); w.y = pk2(o0[2], o0[3]); w.z = pk2(o1[0], o1[1]); w.w = pk2(o1[2], o1[3]);
            *(u32x4*)(MIX + (tok0 + i) * DM + 1024 + col) = w;
        }
    }
    __syncthreads();
}

#define XB_TMO      128
#define XB_XCNT(j)  (256  + 64 * (j))
#define XB_XSUB(j)  (1280 + 64 * (j))
#define XB_XGEN(j)  (2304 + 64 * (j))
#define XB_TOP      3328
#define XB_TOPGEN   3392
#define XCD_BAR_WORDS 3456
#define XB_SPIN_CAP (1u << 18)

__device__ __forceinline__ unsigned xb_ld(unsigned* p)              { return __hip_atomic_load(p, __ATOMIC_RELAXED, __HIP_MEMORY_SCOPE_AGENT); }
__device__ __forceinline__ unsigned xb_add(unsigned* p, unsigned v) { return __hip_atomic_fetch_add(p, v, __ATOMIC_RELAXED, __HIP_MEMORY_SCOPE_AGENT); }
__device__ __forceinline__ unsigned xb_xcc_id() { return (unsigned)__builtin_amdgcn_s_getreg((3 << 11) | 20) & 0xFu; }
#define XB_SPIN(cond, bar) do { unsigned _sp = 0; while (cond) { __builtin_amdgcn_s_sleep(1); \
    if ((++_sp & 255u) == 0u) { if (xb_ld(&(bar)[XB_TMO])) break; if (_sp > XB_SPIN_CAP) { atomicAdd(&(bar)[XB_TMO], 1u); break; } } } } while (0)

struct XcdBarrier {
    unsigned* bar; unsigned x;
    volatile LAS unsigned* st;
};

__device__ __forceinline__ XcdBarrier xcd_barrier_post(unsigned* bar, volatile LAS unsigned* st) {
    XcdBarrier b; b.bar = bar; b.x = xb_xcc_id(); b.st = st;
    if (threadIdx.x == 0) (void)xb_add(&bar[XB_XCNT(b.x)], 1u);
    return b;
}
__device__ __forceinline__ void xcd_barrier_complete(unsigned* bar, unsigned x, unsigned& nloc, unsigned& nx) {
    const unsigned G = gridDim.x * gridDim.y * gridDim.z;
    unsigned sum, cnt, mine, sp = 0u;
    for (;;) {
        sum = 0u; cnt = 0u; mine = 0u;
#pragma unroll
        for (unsigned j = 0; j < 16; ++j) { const unsigned c = xb_ld(&bar[XB_XCNT(j)]); sum += c; cnt += (c > 0u) ? 1u : 0u; mine = (j == x) ? c : mine; }
        if (sum == G) break;
        __builtin_amdgcn_s_sleep(1);
        if ((++sp & 255u) == 0u) { if (xb_ld(&bar[XB_TMO])) break; if (sp > XB_SPIN_CAP) { atomicAdd(&bar[XB_TMO], 1u); break; } }
    }
    nloc = mine > 0u ? mine : 1u; nx = cnt > 0u ? cnt : 1u;
}

__device__ __forceinline__ void xcd_barrier(const XcdBarrier& b) {
    asm volatile("s_waitcnt vmcnt(0)" ::: "memory");
    __syncthreads();
    if (threadIdx.x == 0) {
        unsigned* bar = b.bar;
        __builtin_amdgcn_s_waitcnt(0);
        unsigned nloc = b.st[0], nx = b.st[1];
        if (nloc == 0u) { xcd_barrier_complete(bar, b.x, nloc, nx); b.st[0] = nloc; b.st[1] = nx; }
        const unsigned old = xb_add(&bar[XB_XSUB(b.x)], 1u);
        const unsigned gen = old / nloc;
        if (old + 1u == (gen + 1u) * nloc) {
            __builtin_amdgcn_fence(__ATOMIC_RELEASE, "agent");
            asm volatile("s_waitcnt vmcnt(0)" ::: "memory");
            const unsigned og = xb_add(&bar[XB_TOP], 1u);
            const unsigned tg = og / nx;
            if (og + 1u == (tg + 1u) * nx) xb_add(&bar[XB_TOPGEN], 1u);
            else XB_SPIN(xb_ld(&bar[XB_TOPGEN]) == tg, bar);
            __builtin_amdgcn_fence(__ATOMIC_ACQUIRE, "agent");
            xb_add(&bar[XB_XGEN(b.x)], 1u);
            asm volatile("s_waitcnt vmcnt(0)" ::: "memory");
        } else {
            XB_SPIN(xb_ld(&bar[XB_XGEN(b.x)]) == gen, bar);
            __builtin_amdgcn_fence(__ATOMIC_ACQUIRE, "agent");
            asm volatile("s_waitcnt vmcnt(0)" ::: "memory");
        }
    }
    __syncthreads();
}


#ifndef DUMPC
#define DUMPC 0
#endif
__device__ __forceinline__ void dump_bf16(float* out, const bf16* src, size_t ld, size_t col0, int gtid, int nth) {
    for (size_t i = gtid; i < (size_t)M_TOK * DM; i += nth) { const size_t r = i >> 11, c = i & 2047; float v = bf2f(src[r * ld + col0 + c]); if (!(fabsf(v) < 1e30f)) v = 12345.0f; out[i] = v; }
}
struct Args { const void* in[24]; float* out; unsigned char* ws; };
typedef __attribute__((address_space(4))) const unsigned long long karg_t;
#define KARG(T, i) ((T)(__attribute__((address_space(1))) char*)(((karg_t*)__builtin_amdgcn_kernarg_segment_ptr())[(i) + oz]))
#define KF(i) KARG(const float*, i)
#define WSP(T, off) ((T)(KARG(unsigned char*, 25) + (off)))
__global__ void __launch_bounds__(NT, 2) fwd_megakernel(Args a_unused) {
    extern __shared__ __attribute__((aligned(16))) unsigned char lds_raw[];
    LAS unsigned char* lds = (LAS unsigned char*)lds_raw;
    cg::grid_group grid = cg::this_grid();
    XcdBarrier bar;
    { volatile LAS unsigned* misc = (volatile LAS unsigned*)(lds + MISC_OFF); if (threadIdx.x < 2) misc[threadIdx.x] = 0u; if (threadIdx.x == 2) *(volatile LAS unsigned*)(lds + 140000) = 0u; __syncthreads();
      const unsigned oz = opaque0(); bar = xcd_barrier_post((unsigned*)WSP(unsigned char*, WS_CTL), misc); }
    grid.sync();
#define SEAM() xcd_barrier(bar)
#ifndef GEMM_ALIGN
#define GEMM_ALIGN true
#endif
#ifndef SKIP_GEMM
#define SKIP_GEMM 0
#endif
#ifndef STOP_AFTER
#define STOP_AFTER 99
#endif
#define GEOM int tid_o = threadIdx.x; asm volatile("" : "+v"(tid_o)); const int tid = tid_o, lane = tid & 63, wave = __builtin_amdgcn_readfirstlane(tid >> 6); (void)lane; (void)wave; const int G = gridDim.x, bx = blockIdx.x, gw = bx * 8 + wave, NGW = G * 8, gtid = bx * NT + tid, nth = G * NT; (void)gw; (void)NGW; (void)gtid; (void)nth; const unsigned oz = opaque0()

#ifdef P0_TWICE
    for (int rep0 = 0; rep0 < 2; ++rep0)
#endif
    { GEOM; LAS float* scr = (LAS float*)(lds + wave * 8448);
      convert_ffn(KF(2), KF(3), KF(4), WSP(bf16*, WS_WGU), WSP(bf16*, WS_WD), scr, gw, NGW, lane);
      { const float* win = KF(7); const float* wout = KF(16); bf16* WIN = WSP(bf16*, WS_WIN); bf16* WOUT = WSP(bf16*, WS_WOUT);
        for (int it = gw; it < 32 * 216 + 32 * 64; it += NGW) {
            if (it < 32 * 216) { const int kb = it / 216, nb = it % 216; xpose_item(win, NIN, DM, WIN, kb * 64, nb * 32, nb * 32, scr, lane); }
            else { const int r = it - 32 * 216, kb = r / 64, nb = r % 64; xpose_item(wout, DM, DM, WOUT, kb * 64, nb * 32, nb * 32, scr, lane); }
        } }
      { const float* x = KF(0); bf16* XB = WSP(bf16*, WS_XB);
        for (size_t i = gtid; i < (size_t)M_TOK * DM / 8; i += nth) {
            const f32x4 p = ((const f32x4*)x)[2 * i], q = ((const f32x4*)x)[2 * i + 1];
            u32x4 w; w.x = pk2(p[0], p[1]); w.y = pk2(p[2], p[3]); w.z = pk2(q[0], q[1]); w.w = pk2(q[2], q[3]);
            ((u32x4*)XB)[i] = w;
        } }
      { const int* pos = KARG(const int*, 1); float* COS = WSP(float*, WS_COS); float* SIN = WSP(float*, WS_SIN);
        for (int idx = gtid; idx < M_TOK * 128; idx += nth) {
            const int tok = idx >> 7, f = idx & 127;
            const float invf = exp2f(-((float)f * (1.0f / 127.0f)) * 13.287712379549449f);
            const double rev = (double)pos[tok] * (double)invf * 0.15915494309189535;
            const float fr = (float)(rev - rint(rev));
            COS[idx] = __builtin_amdgcn_cosf(fr); SIN[idx] = __builtin_amdgcn_sinf(fr);
        } }
      if (SKIP_GEMM) { bf16* BIGW = WSP(bf16*, WS_BIG); float* DTW = WSP(float*, WS_DT);
        for (size_t i = gtid; i < (size_t)M_TOK * PLD; i += nth) { unsigned hsh = (unsigned)i * 2654435761u; hsh ^= hsh >> 15; hsh *= 2246822519u; hsh ^= hsh >> 13; BIGW[i] = f2bf((float)(hsh & 0xffffu) * (1.0f / 65536.0f) - 0.5f); }
        for (size_t i = gtid; i < (size_t)M_TOK * 16; i += nth) { unsigned hsh = (unsigned)i * 2654435761u; hsh ^= hsh >> 15; hsh *= 2246822519u; hsh ^= hsh >> 13; DTW[i] = (float)(hsh & 0xffffu) * (1.0f / 65536.0f) - 0.5f; } }
    }
    SEAM(); if (STOP_AFTER == 0) return;

    { GEOM; pg8::Gemm g{WSP(const bf16*, WS_XB), WSP(const bf16*, WS_WGU), M_TOK, NGU, DM}; pg8::StaticOrder S; S.init(M_TOK, NGU, G, bx); pg8::EpiSwiglu E{WSP(bf16*, WS_BIG), DFF};
      if (!SKIP_GEMM) pg8::gemm_phase<pg8::EpiSwiglu, pg8::StaticOrder, GEMM_ALIGN, true>(lds, g, S, E); }
    SEAM(); if (STOP_AFTER == 1) return;
    { GEOM; pg8::Gemm g{WSP(const bf16*, WS_BIG), WSP(const bf16*, WS_WD), M_TOK, DM, DFF}; pg8::StaticOrder S; S.init(M_TOK, DM, G, bx); pg8::EpiRes E{KF(0), KARG(float*, 24), DM, ALPHA, 0.5f};
      if (!SKIP_GEMM) pg8::gemm_phase<pg8::EpiRes, pg8::StaticOrder, GEMM_ALIGN, true>(lds, g, S, E); }
    SEAM(); if (STOP_AFTER == 2) return;
    { GEOM; ln_rows<true>(KARG(float*, 24), KF(5), KF(6), WSP(bf16*, WS_XB), WSP(float*, WS_STATS), gw, NGW, lane); }
    SEAM(); if (STOP_AFTER == 3) return;
    { GEOM; pg8::Gemm g{WSP(const bf16*, WS_XB), WSP(const bf16*, WS_WIN), M_TOK, NINP, DM}; pg8::StaticOrder S; S.init(M_TOK, NINP, G, bx);
      pg8::EpiInProj E{WSP(bf16*, WS_BIG), WSP(const float*, WS_COS), WSP(const float*, WS_SIN), WSP(float*, WS_DT)};
      if (!SKIP_GEMM) pg8::gemm_phase<pg8::EpiInProj, pg8::StaticOrder, GEMM_ALIGN, true>(lds, g, S, E);
#ifdef DIAGMODE
      { volatile LAS unsigned* cnt = (volatile LAS unsigned*)(lds + 140000); if (lane == 0) atomicAdd((unsigned*)(lds_raw + 140000), 1u); __syncthreads(); const unsigned v = *cnt; WSP(float*, WS_XB)[gtid] = (float)v; }
#endif
    }
    SEAM();
#ifdef DIAGMODE
    { GEOM; const float* dg = WSP(const float*, WS_XB); float* o = KARG(float*, 24); for (size_t i = gtid; i < (size_t)M_TOK * DM; i += nth) o[i] = dg[i % nth]; return; }
#endif
    if (STOP_AFTER == 4) { GEOM; dump_bf16(KARG(float*, 24), WSP(const bf16*, WS_BIG), PLD, DUMPC, gtid, nth); return; }
#ifdef P5_TWICE
    for (int rep = 0; rep < 2; ++rep) {
#ifdef P5_NOSTORE2
#define P5_STORE_FLAG (rep == 0)
#else
#define P5_STORE_FLAG true
#endif
#else
#define P5_STORE_FLAG true
#endif
    { GEOM; const bf16* BIG = WSP(const bf16*, WS_BIG);
      for (int u = bx; u < 1536; u += G) {
        if (u < 1024) ret_a_unit(lds, BIG, WSP(bf16*, WS_RETS), u >> 9, (u >> 2) & 127, u & 3, tid, P5_STORE_FLAG);
        else { const int v = u - 1024; ssd_a_unit(lds, BIG, WSP(const float*, WS_DT), KF(10), KF(11), KF(12), KF(13), WSP(bf16*, WS_SSDS), WSP(float*, WS_TOT), v >> 8, (v >> 1) & 127, v & 1, tid, P5_STORE_FLAG); }
      } }
#ifdef P5_TWICE
    if (rep == 0) SEAM(); }
#endif
#ifdef DBG_FLAG
    { GEOM; unsigned* FL = (unsigned*)WSP(unsigned char*, WS_CTL + 32768); if (tid == 511) FL[bx * 16] = 5u; }
    SEAM();
    { GEOM; const unsigned* FL = (const unsigned*)WSP(unsigned char*, WS_CTL + 32768); int bad = 0; for (int k = 0; k < G; ++k) bad += (FL[k * 16] != 5u);
      float* o = KARG(float*, 24); for (size_t i = gtid; i < (size_t)M_TOK * DM; i += nth) o[i] = 1000.0f * (float)bad; return; }
#endif
    SEAM(); if (STOP_AFTER == 5) { GEOM; dump_bf16(KARG(float*, 24), DUMPC == 2 ? WSP(const bf16*, WS_XB) : DUMPC ? WSP(const bf16*, WS_SSDS) : WSP(const bf16*, WS_RETS), DM, 0, gtid, nth); return; }
    { GEOM; scan_phase(WSP(bf16*, WS_RETS), WSP(bf16*, WS_SSDS), WSP(const float*, WS_TOT), gtid, nth); }
    SEAM(); if (STOP_AFTER == 6) { GEOM; dump_bf16(KARG(float*, 24), DUMPC ? WSP(const bf16*, WS_SSDS) : WSP(const bf16*, WS_RETS), DM, 0, gtid, nth); return; }
#ifdef P7_TWICE
    for (int rep7 = 0; rep7 < 2; ++rep7)
#endif
    { GEOM; const bf16* BIG = WSP(const bf16*, WS_BIG); bf16* XB = WSP(bf16*, WS_XB);
      for (int u = bx; u < 1536; u += G) {
        if (u < 1024) ret_c_unit(lds, BIG, WSP(const bf16*, WS_RETS), KF(8), KF(9), XB, u >> 9, (u >> 2) & 127, u & 3, tid);
        else { const int v = u - 1024; ssd_c_unit(lds, BIG, WSP(const float*, WS_DT), KF(10), KF(11), KF(12), KF(13), KF(14), KF(15), WSP(const bf16*, WS_SSDS), XB, v >> 8, (v >> 1) & 127, v & 1, tid); }
      } }
    SEAM(); if (STOP_AFTER == 7) { GEOM; dump_bf16(KARG(float*, 24), WSP(const bf16*, WS_XB), DM, 0, gtid, nth); return; }
    { GEOM; pg8::Gemm g{WSP(const bf16*, WS_XB), WSP(const bf16*, WS_WOUT), M_TOK, DM, DM}; pg8::StaticOrder S; S.init(M_TOK, DM, G, bx); pg8::EpiResLN E{KARG(float*, 24), DM, WSP(const float*, WS_STATS), KF(5), KF(6), ALPHA, 1.0f};
      if (!SKIP_GEMM) pg8::gemm_phase<pg8::EpiResLN, pg8::StaticOrder, GEMM_ALIGN, true>(lds, g, S, E); }
    SEAM(); if (STOP_AFTER == 8) return;
    { GEOM; ln_rows<true>(KARG(float*, 24), KF(17), KF(18), WSP(bf16*, WS_XB), WSP(float*, WS_STATS), gw, NGW, lane);
      LAS float* scr = (LAS float*)(lds + wave * 8448);
      convert_ffn(KF(19), KF(20), KF(21), WSP(bf16*, WS_WGU), WSP(bf16*, WS_WD), scr, gw, NGW, lane); }
    SEAM(); if (STOP_AFTER == 9) return;
    { GEOM; pg8::Gemm g{WSP(const bf16*, WS_XB), WSP(const bf16*, WS_WGU), M_TOK, NGU, DM}; pg8::StaticOrder S; S.init(M_TOK, NGU, G, bx); pg8::EpiSwiglu E{WSP(bf16*, WS_BIG), DFF};
      if (!SKIP_GEMM) pg8::gemm_phase<pg8::EpiSwiglu, pg8::StaticOrder, GEMM_ALIGN, true>(lds, g, S, E); }
    SEAM(); if (STOP_AFTER == 10) return;
    { GEOM; pg8::Gemm g{WSP(const bf16*, WS_BIG), WSP(const bf16*, WS_WD), M_TOK, DM, DFF}; pg8::StaticOrder S; S.init(M_TOK, DM, G, bx); pg8::EpiResLN E{KARG(float*, 24), DM, WSP(const float*, WS_STATS), KF(17), KF(18), ALPHA, 0.5f};
      if (!SKIP_GEMM) pg8::gemm_phase<pg8::EpiResLN, pg8::StaticOrder, GEMM_ALIGN, true>(lds, g, S, E); }
    SEAM(); if (STOP_AFTER == 11) return;
    { GEOM; ln_rows<false>(KARG(float*, 24), KF(22), KF(23), WSP(bf16*, WS_XB), WSP(float*, WS_STATS), gw, NGW, lane); }
}

extern "C" void kernel_launch(void* const* d_in, const int* in_sizes, int n_in, void* d_out, int out_size, void* d_ws, size_t ws_size, hipStream_t stream) {
    static int grid = 0;
    if (grid == 0) {
        if (n_in != 24 || in_sizes[0] != M_TOK * DM || out_size != M_TOK * DM || ws_size < WS_END) {
            fprintf(stderr, "kernel_launch: unexpected problem (n_in %d, in0 %d, out %d, ws %zu); nothing launched\n", n_in, n_in > 0 ? in_sizes[0] : -1, out_size, ws_size); grid = -1; return; }
        int dev = 0, cus = 0, per_cu = 0;
        (void)hipGetDevice(&dev); (void)hipDeviceGetAttribute(&cus, hipDeviceAttributeMultiprocessorCount, dev);
        (void)hipFuncSetAttribute((const void*)fwd_megakernel, hipFuncAttributeMaxDynamicSharedMemorySize, LDS_BYTES);
        if (hipOccupancyMaxActiveBlocksPerMultiprocessor(&per_cu, (const void*)fwd_megakernel, NT, LDS_BYTES) != hipSuccess || per_cu < 1) { per_cu = 1; (void)hipGetLastError(); }
        if (cus < 1) cus = 256;
        grid = cus * per_cu;
    }
    if (grid < 0) return;
    if (hipMemsetAsync((char*)d_ws + WS_CTL, 0, CTL_ZERO_BYTES, stream) != hipSuccess) { fprintf(stderr, "kernel_launch: memset of the barrier words failed\n"); return; }
    Args a{};
    for (int i = 0; i < 24; ++i) a.in[i] = d_in[i];
    a.out = (float*)d_out; a.ws = (unsigned char*)d_ws;
    void* args[] = {&a};
    hipError_t e = hipLaunchCooperativeKernel((const void*)fwd_megakernel, dim3(grid), dim3(NT), args, LDS_BYTES, stream);
    if (e != hipSuccess) fprintf(stderr, "cooperative launch failed: %s (grid %d)\n", hipGetErrorString(e), grid);
}
```

```cpp
#include <hip/hip_runtime.h>
#include <hip/hip_cooperative_groups.h>
#include <cstdio>
#include <cstdint>
namespace cg = cooperative_groups;
#define P5_PIPE 1
namespace pg8 {
#define PG8_LAS __attribute__((address_space(3)))
typedef unsigned short bf16_t;
typedef short bf16x8 __attribute__((ext_vector_type(8)));
typedef float f32x4 __attribute__((ext_vector_type(4)));
typedef unsigned u32x4 __attribute__((ext_vector_type(4)));
constexpr int BM = 256, BK = 64, HALF = 128, HTB = HALF * BK * 2  , STAGE_BYTES = 8 * HTB, NXCD = 8, WGM = 8;

__host__ __device__ __forceinline__ int lds_byte(int r, int c) { const int st = (r >> 4) * 2 + (c >> 5), rr = r & 15, cc = c & 31, ob = rr * 64 + cc * 2; return st * 1024 + (ob ^ (((ob >> 9) & 1) << 5)); }
__host__ __device__ __forceinline__ void stage_rc(int b, int& R, int& C) { const int st = b / 1024, sb = b % 1024, swz = sb ^ (((sb >> 9) & 1) << 5); R = (st >> 1) * 16 + swz / 64; C = (st & 1) * 32 + (swz % 64) / 2; }
__host__ __device__ __forceinline__ int perm32(int rho) { const int n = rho >> 4, i = rho & 15; return 8 * (i >> 2) + 4 * n + (i & 3); }

struct Unit { int pm, pn; };
struct Gemm { const bf16_t* A; const bf16_t* Bt; int M, N, K; };

struct StaticOrder {
    int nM, nN, nwg, G, c;
    __host__ __device__ void init(int M, int N, int G_, int c_) { nM = M / BM; nN = N / BM; nwg = nM * nN; G = G_; c = c_; }
    __host__ __device__ bool next(int i, Unit& u) const {
        const long L = (long)i * G + c; if (L >= nwg) return false;
        int wgid = (int)L; { const int q = nwg / NXCD, r = nwg % NXCD, xcd = wgid % NXCD, off = wgid / NXCD; wgid = (xcd < r ? xcd * (q + 1) : r * (q + 1) + (xcd - r) * q) + off; }
        const int nig = WGM * nN, gid = wgid / nig, fm = gid * WGM, gsz = (nM - fm) < WGM ? (nM - fm) : WGM;
        u.pm = fm + ((wgid % nig) % gsz); u.pn = (wgid % nig) / gsz; return true;
    }
    __device__ __forceinline__ void a_ready(const Unit&) const {}
    __device__ __forceinline__ void done(const Unit&) const {}
};

typedef float cvt_f32x2 __attribute__((ext_vector_type(2)));
typedef __bf16 cvt_bf16x2 __attribute__((ext_vector_type(2)));
__device__ __forceinline__ unsigned cvt_pk_bf16(float lo, float hi) { const cvt_f32x2 v = {lo, hi}; return __builtin_bit_cast(unsigned, __builtin_convertvector(v, cvt_bf16x2)); }

typedef float f32x2e __attribute__((ext_vector_type(2)));
typedef unsigned u32x2 __attribute__((ext_vector_type(2)));
__device__ __forceinline__ void row_stats(const float* rows, int row, float& mu, float& rs) {
    const f32x2e s = *(const f32x2e*)(rows + 2 * (size_t)row);
    mu = s.x * (1.0f / 2048.0f); const float var = s.y * (1.0f / 2048.0f) - mu * mu; rs = 1.0f / sqrtf(fmaxf(var, 0.0f) + 1e-5f);
}
__device__ __forceinline__ float swi(float g, float u) { return g * u * __builtin_amdgcn_rcpf(1.0f + __expf(-g)); }
struct EpiSwiglu {
    static constexpr bool PERM = true, AFTER_DRAIN = false;
    bf16_t* H; int ldh;
    __device__ __forceinline__ void operator()(const f32x4 (&acc)[2][2][4][2], const Unit& u, int wr, int wc, int fr, int fq) const {
        const int row0 = u.pm * BM + wr * 64 + fr, col0 = u.pn * 128 + wc * 32 + 8 * fq;
#pragma unroll
        for (int ai = 0; ai < 2; ++ai)
#pragma unroll
            for (int m = 0; m < 4; ++m) {
                bf16_t* p = H + (size_t)(row0 + ai * HALF + m * 16) * ldh + col0;
                const f32x4 g0 = acc[ai][0][m][0], g1 = acc[ai][0][m][1], u0 = acc[ai][1][m][0], u1 = acc[ai][1][m][1];
                u32x4 w;
                w.x = cvt_pk_bf16(swi(g0[0], u0[0]), swi(g0[1], u0[1])); w.y = cvt_pk_bf16(swi(g0[2], u0[2]), swi(g0[3], u0[3]));
                w.z = cvt_pk_bf16(swi(g1[0], u1[0]), swi(g1[1], u1[1])); w.w = cvt_pk_bf16(swi(g1[2], u1[2]), swi(g1[3], u1[3]));
                *(u32x4*)p = w;
            }
    }
};
struct EpiRes {
    static constexpr bool PERM = false, AFTER_DRAIN = false;
    const float* res; float* out; int ld; float alpha, s;
    __device__ __forceinline__ void operator()(const f32x4 (&acc)[2][2][4][2], const Unit& u, int wr, int wc, int fr, int fq) const {
        const int row0 = u.pm * BM + wr * 64 + fr, col0 = u.pn * BM + wc * 32 + 4 * fq;
#pragma unroll
        for (int ai = 0; ai < 2; ++ai)
#pragma unroll
            for (int m = 0; m < 4; ++m) {
                const size_t off = (size_t)(row0 + ai * HALF + m * 16) * ld + col0;
#pragma unroll
                for (int bj = 0; bj < 2; ++bj)
#pragma unroll
                    for (int n = 0; n < 2; ++n) {
                        const f32x4 r = *(const f32x4*)(res + off + bj * HALF + n * 16);
                        *(f32x4*)(out + off + bj * HALF + n * 16) = r * alpha + acc[ai][bj][m][n] * s;
                    }
            }
    }
};
struct EpiInProj {
    static constexpr bool PERM = true, AFTER_DRAIN = false;
    bf16_t* P; const float* cs; const float* sn; float* DT; const float* rows_in; const float* cv; const float* dv;
    __device__ __forceinline__ void operator()(const f32x4 (&acc)[2][2][4][2], const Unit& u, int wr, int wc, int fr, int fq) const {
        const int row0 = u.pm * BM + wr * 64 + fr, pn = u.pn;
        f32x4 cc[2][2], dd[2][2]; float mu[2][4], rs[2][4];
#pragma unroll
        for (int bj = 0; bj < 2; ++bj) { const int nc = pn * BM + bj * HALF + wc * 32 + 8 * fq;
            cc[bj][0] = *(const f32x4*)(cv + nc); cc[bj][1] = *(const f32x4*)(cv + nc + 4); dd[bj][0] = *(const f32x4*)(dv + nc); dd[bj][1] = *(const f32x4*)(dv + nc + 4); }
#pragma unroll
        for (int ai = 0; ai < 2; ++ai)
#pragma unroll
            for (int m = 0; m < 4; ++m) row_stats(rows_in, row0 + ai * HALF + m * 16, mu[ai][m], rs[ai][m]);
#pragma unroll
        for (int ai = 0; ai < 2; ++ai)
#pragma unroll
            for (int m = 0; m < 4; ++m) {
                const int row = row0 + ai * HALF + m * 16;
#pragma unroll
                for (int bj = 0; bj < 2; ++bj) {
                    const int colt = bj * HALF + wc * 32 + 8 * fq;
                    f32x4 v0 = acc[ai][bj][m][0], v1 = acc[ai][bj][m][1];
                    v0 = (v0 - cc[bj][0] * mu[ai][m]) * rs[ai][m] + dd[bj][0]; v1 = (v1 - cc[bj][1] * mu[ai][m]) * rs[ai][m] + dd[bj][1];
                    if (pn < 8) {
                        const f32x4 c = *(const f32x4*)(cs + (size_t)row * 128 + (colt >> 1)), s = *(const f32x4*)(sn + (size_t)row * 128 + (colt >> 1));
                        const float sc = pn >= 4 ? 0.0625f : 1.0f;
                        f32x4 a, b;
                        a[0] = (v0[0] * c[0] - v0[1] * s[0]) * sc; a[1] = (v0[1] * c[0] + v0[0] * s[0]) * sc;
                        a[2] = (v0[2] * c[1] - v0[3] * s[1]) * sc; a[3] = (v0[3] * c[1] + v0[2] * s[1]) * sc;
                        b[0] = (v1[0] * c[2] - v1[1] * s[2]) * sc; b[1] = (v1[1] * c[2] + v1[0] * s[2]) * sc;
                        b[2] = (v1[2] * c[3] - v1[3] * s[3]) * sc; b[3] = (v1[3] * c[3] + v1[2] * s[3]) * sc;
                        v0 = a; v1 = b;
                    }
                    if (pn < 26) {
                        u32x4 w; w.x = cvt_pk_bf16(v0[0], v0[1]); w.y = cvt_pk_bf16(v0[2], v0[3]); w.z = cvt_pk_bf16(v1[0], v1[1]); w.w = cvt_pk_bf16(v1[2], v1[3]);
                        *(u32x4*)(P + (size_t)row * 6672 + pn * BM + colt) = w;
                    } else if (colt < 16) {
                        *(f32x4*)(DT + (size_t)row * 16 + colt) = v0; *(f32x4*)(DT + (size_t)row * 16 + colt + 4) = v1;
                    }
                }
            }
    }
};

struct EpiResLN {
    static constexpr bool PERM = false, AFTER_DRAIN = false;
    float* out; int ld; const float* stats; const float* gain; const float* bias; float alpha, s;
    __device__ __forceinline__ void operator()(const f32x4 (&acc)[2][2][4][2], const Unit& u, int wr, int wc, int fr, int fq) const {
        const int row0 = u.pm * BM + wr * 64 + fr, col0 = u.pn * BM + wc * 32 + 4 * fq;
#pragma unroll
        for (int bj = 0; bj < 2; ++bj)
#pragma unroll
            for (int n = 0; n < 2; ++n) {
                const f32x4 g = *(const f32x4*)(gain + col0 + bj * HALF + n * 16), b = *(const f32x4*)(bias + col0 + bj * HALF + n * 16);
#pragma unroll
                for (int ai = 0; ai < 2; ++ai)
#pragma unroll
                    for (int m = 0; m < 4; ++m) {
                        const int row = row0 + ai * HALF + m * 16;
                        const f32x2e st = *(const f32x2e*)(stats + 2 * (size_t)row);
                        float* p = out + (size_t)row * ld + col0 + bj * HALF + n * 16;
                        const f32x4 y = *(const f32x4*)p;
                        const f32x4 x = (y - st.x) * st.y * g + b;
                        *(f32x4*)p = x * alpha + acc[ai][bj][m][n] * s;
                    }
            }
    }
};

__device__ __forceinline__ void ld_bf8(const bf16_t* p, f32x4& a, f32x4& b) { const u32x4 w = *(const u32x4*)p;
    a = (f32x4){__uint_as_float(w.x << 16), __uint_as_float(w.x & 0xffff0000u), __uint_as_float(w.y << 16), __uint_as_float(w.y & 0xffff0000u)};
    b = (f32x4){__uint_as_float(w.z << 16), __uint_as_float(w.z & 0xffff0000u), __uint_as_float(w.w << 16), __uint_as_float(w.w & 0xffff0000u)}; }
__device__ __forceinline__ f32x4 ld_bf4(const bf16_t* p) { const u32x2 w = *(const u32x2*)p; return (f32x4){__uint_as_float(w.x << 16), __uint_as_float(w.x & 0xffff0000u), __uint_as_float(w.y << 16), __uint_as_float(w.y & 0xffff0000u)}; }
template <bool LNRES, int HS> struct EpiResEmit {
    static constexpr bool PERM = true, AFTER_DRAIN = false;
    const float* res; const bf16_t* resb; const float* rows_in; const float* gain; const float* bias; bf16_t* yb; float* rows_out;
    __device__ __forceinline__ void operator()(const f32x4 (&acc)[2][2][4][2], const Unit& u, int wr, int wc, int fr, int fq) const {
        constexpr int ld = 2048; constexpr float alpha = 1.189207115002721f, s = 0.5f * HS;
        const int row0 = u.pm * BM + wr * 64 + fr, col0 = u.pn * BM + wc * 32 + 8 * fq;
        f32x4 g[2][2], b[2][2];
#pragma unroll
        for (int bj = 0; bj < 2; ++bj)
#pragma unroll
            for (int n = 0; n < 2; ++n) { g[bj][n] = LNRES ? *(const f32x4*)(gain + col0 + bj * HALF + n * 4) : (f32x4){0.f, 0.f, 0.f, 0.f}; b[bj][n] = LNRES ? *(const f32x4*)(bias + col0 + bj * HALF + n * 4) : (f32x4){0.f, 0.f, 0.f, 0.f}; }
        f32x4 nx[2][2];
#pragma unroll
        for (int bj = 0; bj < 2; ++bj) { const size_t o = (size_t)row0 * ld + col0 + bj * HALF;
            if (LNRES) ld_bf8(resb + o, nx[bj][0], nx[bj][1]); else { nx[bj][0] = *(const f32x4*)(res + o); nx[bj][1] = *(const f32x4*)(res + o + 4); } }
#pragma unroll
        for (int ai = 0; ai < 2; ++ai)
#pragma unroll
            for (int m = 0; m < 4; ++m) {
                const int row = row0 + ai * HALF + m * 16;
                const size_t off0 = (size_t)row * ld + col0;
                f32x4 xv[2][2];
#pragma unroll
                for (int bj = 0; bj < 2; ++bj)
#pragma unroll
                    for (int n = 0; n < 2; ++n) xv[bj][n] = nx[bj][n];
                if (ai * 4 + m < 7) { const int nrow = row0 + ((ai * 4 + m + 1) >> 2) * HALF + ((ai * 4 + m + 1) & 3) * 16;
#pragma unroll
                    for (int bj = 0; bj < 2; ++bj) { const size_t o = (size_t)nrow * ld + col0 + bj * HALF;
                        if (LNRES) ld_bf8(resb + o, nx[bj][0], nx[bj][1]); else { nx[bj][0] = *(const f32x4*)(res + o); nx[bj][1] = *(const f32x4*)(res + o + 4); } } }
                float mu = 0.f, rs = 1.f; if (LNRES) row_stats(rows_in, row, mu, rs);
                float a1 = 0.f, a2 = 0.f;
#pragma unroll
                for (int bj = 0; bj < 2; ++bj) {
                    const size_t off = off0 + bj * HALF;
                    f32x4 x0 = xv[bj][0], x1 = xv[bj][1];
                    if (LNRES) { x0 = (x0 - mu) * rs * g[bj][0] + b[bj][0]; x1 = (x1 - mu) * rs * g[bj][1] + b[bj][1]; }
                    const f32x4 y0 = x0 * alpha + acc[ai][bj][m][0] * s, y1 = x1 * alpha + acc[ai][bj][m][1] * s;
                    u32x4 w; w.x = cvt_pk_bf16(y0[0], y0[1]); w.y = cvt_pk_bf16(y0[2], y0[3]); w.z = cvt_pk_bf16(y1[0], y1[1]); w.w = cvt_pk_bf16(y1[2], y1[3]);
                    *(u32x4*)(yb + off) = w;
                    a1 += ((y0[0] + y0[1]) + (y0[2] + y0[3])) + ((y1[0] + y1[1]) + (y1[2] + y1[3]));
                    a2 += ((y0[0] * y0[0] + y0[1] * y0[1]) + (y0[2] * y0[2] + y0[3] * y0[3])) + ((y1[0] * y1[0] + y1[1] * y1[1]) + (y1[2] * y1[2] + y1[3] * y1[3]));
                }
                a1 += __shfl_xor(a1, 16); a1 += __shfl_xor(a1, 32); a2 += __shfl_xor(a2, 16); a2 += __shfl_xor(a2, 32);
                if (fq == 0) { float* rp = rows_out + 2 * (size_t)row; atomicAdd(rp, a1); atomicAdd(rp + 1, a2); }
            }
    }
};
struct EpiResLN2 {
    static constexpr bool PERM = true, AFTER_DRAIN = false;
    const bf16_t* resb; const float* rows_in; const float* gain; const float* bias; bf16_t* yb;
    __device__ __forceinline__ void operator()(const f32x4 (&acc)[2][2][4][2], const Unit& u, int wr, int wc, int fr, int fq) const {
        constexpr int ld = 2048; constexpr float alpha = 1.189207115002721f, s = 0.5f;
        const int row0 = u.pm * BM + wr * 64 + fr, col0 = u.pn * BM + wc * 32 + 8 * fq;
        f32x4 g[2][2], b[2][2];
#pragma unroll
        for (int bj = 0; bj < 2; ++bj)
#pragma unroll
            for (int n = 0; n < 2; ++n) { g[bj][n] = *(const f32x4*)(gain + col0 + bj * HALF + n * 4); b[bj][n] = *(const f32x4*)(bias + col0 + bj * HALF + n * 4); }
        f32x4 nx[2][2];
#pragma unroll
        for (int bj = 0; bj < 2; ++bj) ld_bf8(resb + (size_t)row0 * ld + col0 + bj * HALF, nx[bj][0], nx[bj][1]);
#pragma unroll
        for (int ai = 0; ai < 2; ++ai)
#pragma unroll
            for (int m = 0; m < 4; ++m) {
                const int row = row0 + ai * HALF + m * 16; const bf16_t* p = resb + (size_t)row * ld + col0;
                f32x4 xv[2][2];
#pragma unroll
                for (int bj = 0; bj < 2; ++bj)
#pragma unroll
                    for (int n = 0; n < 2; ++n) xv[bj][n] = nx[bj][n];
                if (ai * 4 + m < 7) { const int nrow = row0 + ((ai * 4 + m + 1) >> 2) * HALF + ((ai * 4 + m + 1) & 3) * 16;
#pragma unroll
                    for (int bj = 0; bj < 2; ++bj) ld_bf8(resb + (size_t)nrow * ld + col0 + bj * HALF, nx[bj][0], nx[bj][1]); }
                float mu, rs; row_stats(rows_in, row, mu, rs);
#pragma unroll
                for (int bj = 0; bj < 2; ++bj) {
                    const f32x4 y0 = ((xv[bj][0] - mu) * rs * g[bj][0] + b[bj][0]) * alpha + acc[ai][bj][m][0] * s, y1 = ((xv[bj][1] - mu) * rs * g[bj][1] + b[bj][1]) * alpha + acc[ai][bj][m][1] * s;
                    u32x4 w; w.x = cvt_pk_bf16(y0[0], y0[1]); w.y = cvt_pk_bf16(y0[2], y0[3]); w.z = cvt_pk_bf16(y1[0], y1[1]); w.w = cvt_pk_bf16(y1[2], y1[3]);
                    *(u32x4*)(yb + (size_t)row * ld + col0 + bj * HALF) = w; }
                (void)p;
            }
    }
};
struct EpiSwigluLN {
    static constexpr bool PERM = true, AFTER_DRAIN = false;
    bf16_t* H; int ldh; const float* rows_in; const float* cv; const float* dv;
    __device__ __forceinline__ void operator()(const f32x4 (&acc)[2][2][4][2], const Unit& u, int wr, int wc, int fr, int fq) const {
        const int row0 = u.pm * BM + wr * 64 + fr, col0 = u.pn * 128 + wc * 32 + 8 * fq, ncol = u.pn * BM + wc * 32 + 8 * fq;
        const f32x4 cg0 = *(const f32x4*)(cv + ncol), cg1 = *(const f32x4*)(cv + ncol + 4), dg0 = *(const f32x4*)(dv + ncol), dg1 = *(const f32x4*)(dv + ncol + 4);
        const f32x4 cu0 = *(const f32x4*)(cv + ncol + HALF), cu1 = *(const f32x4*)(cv + ncol + HALF + 4), du0 = *(const f32x4*)(dv + ncol + HALF), du1 = *(const f32x4*)(dv + ncol + HALF + 4);
        float mu[2][4], rs[2][4];
#pragma unroll
        for (int ai = 0; ai < 2; ++ai)
#pragma unroll
            for (int m = 0; m < 4; ++m) row_stats(rows_in, row0 + ai * HALF + m * 16, mu[ai][m], rs[ai][m]);
#pragma unroll
        for (int ai = 0; ai < 2; ++ai)
#pragma unroll
            for (int m = 0; m < 4; ++m) {
                const int row = row0 + ai * HALF + m * 16; const float mm = mu[ai][m], rr = rs[ai][m];
                bf16_t* p = H + (size_t)row * ldh + col0;
                const f32x4 g0 = (acc[ai][0][m][0] - cg0 * mm) * rr + dg0, g1 = (acc[ai][0][m][1] - cg1 * mm) * rr + dg1;
                const f32x4 u0 = (acc[ai][1][m][0] - cu0 * mm) * rr + du0, u1 = (acc[ai][1][m][1] - cu1 * mm) * rr + du1;
                u32x4 w;
                w.x = cvt_pk_bf16(swi(g0[0], u0[0]), swi(g0[1], u0[1])); w.y = cvt_pk_bf16(swi(g0[2], u0[2]), swi(g0[3], u0[3]));
                w.z = cvt_pk_bf16(swi(g1[0], u1[0]), swi(g1[1], u1[1])); w.w = cvt_pk_bf16(swi(g1[2], u1[2]), swi(g1[3], u1[3]));
                *(u32x4*)p = w;
            }
    }
};
template <class Epi, class Sched, bool ALIGN_EPI = false, bool SP2 = false>
__device__ __forceinline__ void gemm_phase(PG8_LAS unsigned char* lds, const Gemm g, const Sched& S, const Epi& E) {
    int tid_o = threadIdx.x; asm volatile("" : "+v"(tid_o));
    const int tid = tid_o, wid = __builtin_amdgcn_readfirstlane(tid >> 6), lane = tid & 63, wr = wid >> 2, wc = wid & 3, fr = lane & 15, fq = lane >> 4;
    const int K = g.K, nt = K / BK;
    unsigned voffA[2], voffB[2];
#pragma unroll
    for (int i = 0; i < 2; ++i) { int R, C; stage_rc(tid * 16 + i * 8192, R, C); const int Rb = Epi::PERM ? ((R & ~31) + perm32(R & 31)) : R;
        voffA[i] = (unsigned)(R * K + C) * 2u; voffB[i] = (unsigned)(Rb * K + C) * 2u; }
    const size_t kstep = (size_t)(BK * 2);
    const size_t hstep = (size_t)HALF * K * 2;
    const size_t tstep = 2 * hstep;
    const unsigned ldsw = (unsigned)wid * 1024u;
    const int aoff = lds_byte(wr * 64 + fr, fq * 8), boff = lds_byte(wc * 32 + fr, fq * 8);
#define PG8_SA(b, h) (((b) * 2 + (h)) * HTB)
#define PG8_SB(b, h) ((4 + (b) * 2 + (h)) * HTB)
#define PG8_STAGE(bufoff, gbase, voff) do { _Pragma("unroll") for (int _i = 0; _i < 2; ++_i) \
        __builtin_amdgcn_global_load_lds((const unsigned*)((const char*)(gbase) + (voff)[_i]), (PG8_LAS unsigned*)(lds + (bufoff) + ldsw + _i * 8192), 16, 0, 0); } while (0)
#define PG8_LDA(dst, b, h) do { _Pragma("unroll") for (int m = 0; m < 4; ++m) _Pragma("unroll") for (int k = 0; k < 2; ++k) dst[m][k] = *(const PG8_LAS bf16x8*)(lds + PG8_SA(b, h) + aoff + m * 2048 + k * 1024); } while (0)
#define PG8_LDB(dst, b, h) do { _Pragma("unroll") for (int n = 0; n < 2; ++n) _Pragma("unroll") for (int k = 0; k < 2; ++k) dst[n][k] = *(const PG8_LAS bf16x8*)(lds + PG8_SB(b, h) + boff + n * 2048 + k * 1024); } while (0)
#define PG8_MMA(ai, bj, At, Bt) do { __builtin_amdgcn_s_setprio(1); _Pragma("unroll") for (int m = 0; m < 4; ++m) _Pragma("unroll") for (int n = 0; n < 2; ++n) _Pragma("unroll") for (int k = 0; k < 2; ++k) \
        acc[ai][bj][m][n] = __builtin_amdgcn_mfma_f32_16x16x32_bf16(Bt[n][k], At[m][k], acc[ai][bj][m][n], 0, 0, 0); __builtin_amdgcn_s_setprio(0); } while (0)
#define PG8_WAIT_V(n) asm volatile("s_waitcnt vmcnt(" #n ")" ::: "memory")
#define PG8_WAIT_L(n) asm volatile("s_waitcnt lgkmcnt(" #n ")" ::: "memory")
#define PG8_BAR __builtin_amdgcn_s_barrier()
#define PG8_SCHED __builtin_amdgcn_sched_barrier(0)
    Unit cur, nxt; int ui = 0;
    if (!S.next(0, cur)) return;
    f32x4 acc[2][2][4][2];
#pragma unroll
    for (int a = 0; a < 2; ++a)
#pragma unroll
        for (int b = 0; b < 2; ++b)
#pragma unroll
            for (int m = 0; m < 4; ++m)
#pragma unroll
                for (int n = 0; n < 2; ++n) acc[a][b][m][n] = (f32x4){0.f, 0.f, 0.f, 0.f};
    bf16x8 At[4][2], B0[2][2], B1[2][2];
    const char* cA = (const char*)g.A + (size_t)cur.pm * tstep; const char* cB = (const char*)g.Bt + (size_t)cur.pn * tstep;
    S.a_ready(cur);
    if constexpr (SP2) {
        PG8_STAGE(PG8_SB(0, 0), cB, voffB); PG8_STAGE(PG8_SB(0, 1), cB + hstep, voffB); PG8_STAGE(PG8_SA(0, 0), cA, voffA); PG8_STAGE(PG8_SA(0, 1), cA + hstep, voffA);
        if (wr == 1) PG8_BAR;
        PG8_WAIT_V(2); PG8_BAR;
        PG8_STAGE(PG8_SB(1, 0), cB + kstep, voffB); PG8_STAGE(PG8_SA(1, 0), cA + kstep, voffA); PG8_STAGE(PG8_SB(1, 1), cB + hstep + kstep, voffB);
        PG8_WAIT_V(6); PG8_BAR;
    } else {
        PG8_STAGE(PG8_SB(0, 0), cB, voffB); PG8_STAGE(PG8_SA(0, 0), cA, voffA); PG8_STAGE(PG8_SB(0, 1), cB + hstep, voffB); PG8_STAGE(PG8_SA(0, 1), cA + hstep, voffA);
        if (wr == 1) PG8_BAR;
        PG8_WAIT_V(4); PG8_BAR;
        PG8_STAGE(PG8_SB(1, 0), cB + kstep, voffB); PG8_STAGE(PG8_SA(1, 0), cA + kstep, voffA); PG8_STAGE(PG8_SB(1, 1), cB + hstep + kstep, voffB);
        PG8_WAIT_V(6); PG8_BAR;
    }
    for (;;) {
        const bool has_next = S.next(ui + 1, nxt);
        const char* nA = has_next ? (const char*)g.A + (size_t)nxt.pm * tstep : cA; const char* nB = has_next ? (const char*)g.Bt + (size_t)nxt.pn * tstep : cB;
        for (int t = 0; t < nt; t += 2) {
            const bool last = (t == nt - 2);
            const char* a1 = cA + (size_t)(t + 1) * kstep;
            const char* a2 = last ? nA : cA + (size_t)(t + 2) * kstep; const char* b2 = last ? nB : cB + (size_t)(t + 2) * kstep;
            const char* a3 = a2 + kstep; const char* b3 = b2 + kstep;
            if (last && has_next) S.a_ready(nxt);
            if constexpr (SP2) {
            PG8_LDB(B0, 0, 0); PG8_LDB(B1, 0, 1); PG8_SCHED; PG8_LDA(At, 0, 0); PG8_STAGE(PG8_SA(1, 1), a1 + hstep, voffA);
            PG8_WAIT_V(8); PG8_WAIT_L(0); PG8_BAR; PG8_MMA(0, 0, At, B0); PG8_MMA(0, 1, At, B1); PG8_BAR; PG8_SCHED;
            PG8_LDA(At, 0, 1); PG8_STAGE(PG8_SB(0, 0), b2, voffB); PG8_STAGE(PG8_SB(0, 1), b2 + hstep, voffB); PG8_STAGE(PG8_SA(0, 0), a2, voffA);
            PG8_WAIT_V(8); PG8_WAIT_L(0); PG8_BAR; PG8_MMA(1, 0, At, B0); PG8_MMA(1, 1, At, B1); PG8_BAR; PG8_SCHED;
            PG8_LDB(B0, 1, 0); PG8_LDB(B1, 1, 1); PG8_SCHED; PG8_LDA(At, 1, 0); PG8_STAGE(PG8_SA(0, 1), a2 + hstep, voffA);
            PG8_WAIT_V(8); PG8_WAIT_L(0); PG8_BAR; PG8_MMA(0, 0, At, B0); PG8_MMA(0, 1, At, B1); PG8_BAR; PG8_SCHED;
            PG8_LDA(At, 1, 1); PG8_STAGE(PG8_SB(1, 0), b3, voffB); PG8_STAGE(PG8_SB(1, 1), b3 + hstep, voffB); PG8_STAGE(PG8_SA(1, 0), a3, voffA);
            PG8_WAIT_V(8); PG8_WAIT_L(0); PG8_BAR; PG8_MMA(1, 0, At, B0); PG8_MMA(1, 1, At, B1); PG8_BAR; PG8_SCHED;
            } else {
            PG8_LDB(B0, 0, 0); PG8_SCHED; PG8_LDA(At, 0, 0); PG8_STAGE(PG8_SA(1, 1), a1 + hstep, voffA);
            PG8_WAIT_L(8); PG8_BAR; PG8_WAIT_L(0); PG8_MMA(0, 0, At, B0); PG8_BAR; PG8_SCHED;
            PG8_LDB(B1, 0, 1); PG8_STAGE(PG8_SB(0, 0), b2, voffB);
            PG8_BAR; PG8_WAIT_L(0); PG8_MMA(0, 1, At, B1); PG8_BAR;
            PG8_LDA(At, 0, 1); PG8_STAGE(PG8_SA(0, 0), a2, voffA);
            PG8_BAR; PG8_WAIT_L(0); PG8_MMA(1, 0, At, B0); PG8_BAR; PG8_SCHED;
            PG8_STAGE(PG8_SB(0, 1), b2 + hstep, voffB);
            PG8_WAIT_V(6); PG8_BAR; PG8_MMA(1, 1, At, B1); PG8_BAR;
            PG8_LDB(B0, 1, 0); PG8_SCHED; PG8_LDA(At, 1, 0); PG8_STAGE(PG8_SA(0, 1), a2 + hstep, voffA);
            PG8_WAIT_L(8); PG8_BAR; PG8_WAIT_L(0); PG8_MMA(0, 0, At, B0); PG8_BAR; PG8_SCHED;
            PG8_LDB(B1, 1, 1); PG8_STAGE(PG8_SB(1, 0), b3, voffB);
            PG8_BAR; PG8_WAIT_L(0); PG8_MMA(0, 1, At, B1); PG8_BAR;
            PG8_LDA(At, 1, 1); PG8_STAGE(PG8_SA(1, 0), a3, voffA);
            PG8_BAR; PG8_WAIT_L(0); PG8_MMA(1, 0, At, B0); PG8_BAR; PG8_SCHED;
            PG8_STAGE(PG8_SB(1, 1), b3 + hstep, voffB);
            PG8_WAIT_V(6); PG8_BAR; PG8_MMA(1, 1, At, B1); PG8_BAR;
            }
        }
        if constexpr (ALIGN_EPI) { if (wr == 0) PG8_BAR; }
        if constexpr (!Epi::AFTER_DRAIN) { E(acc, cur, wr, wc, fr, fq); S.done(cur); }
        if (!has_next) break;
#pragma unroll
        for (int a = 0; a < 2; ++a)
#pragma unroll
            for (int b = 0; b < 2; ++b)
#pragma unroll
                for (int m = 0; m < 4; ++m)
#pragma unroll
                    for (int n = 0; n < 2; ++n) acc[a][b][m][n] = (f32x4){0.f, 0.f, 0.f, 0.f};
        cur = nxt; cA = nA; cB = nB; ++ui;
        if constexpr (ALIGN_EPI) { if (wr == 1) PG8_BAR; }
    }
    PG8_WAIT_V(0);
    if constexpr (!ALIGN_EPI) { if (wr == 0) PG8_BAR; }
    PG8_BAR;
    if constexpr (Epi::AFTER_DRAIN) { E.fused(acc, cur, wr, wc, fr, fq, lds, wid, lane); S.done(cur); }
#undef PG8_SA
#undef PG8_SB
#undef PG8_STAGE
#undef PG8_LDA
#undef PG8_LDB
#undef PG8_MMA
#undef PG8_WAIT_V
#undef PG8_WAIT_L
#undef PG8_BAR
#undef PG8_SCHED
}
}

#define LAS __attribute__((address_space(3)))
typedef unsigned short bf16;
typedef unsigned u32x4 __attribute__((ext_vector_type(4)));
using pg8::u32x2;
typedef float f32x4 __attribute__((ext_vector_type(4)));
typedef short bf16x8 __attribute__((ext_vector_type(8)));

constexpr int NT = 512;
constexpr int M_TOK = 16384, SEQ = 8192, DM = 2048, DFF = 5632, NGU = 11264, NIN = 6672, NINP = 6912, PLD = 6672;
constexpr float LN_EPS = 1e-5f;
constexpr float ALPHA = 1.189207115002721f;
constexpr size_t MiB = (size_t)1 << 20;
constexpr size_t WS_RETS = 0, WS_SSDS = 128 * MiB, WS_WGU = 0, WS_WD = 44 * MiB, WS_WIN = 66 * MiB, WS_COS = 93 * MiB, WS_SIN = 101 * MiB,
                 WS_WOUT = 192 * MiB, WS_XB = 200 * MiB, WS_BIG = 264 * MiB, WS_DT = 473 * MiB, WS_TOT = 474 * MiB, WS_STATS = 474 * MiB + 65536, WS_CTL = 475 * MiB, WS_END = 476 * MiB;
constexpr size_t CTL_ZERO_BYTES = 512 * 1024, WS_ROWS1 = WS_CTL + 65536, WS_ROWS2 = WS_ROWS1 + 131072, WS_CD_IN = WS_ROWS2 + 131072, WS_CD_GU = WS_CD_IN + 65536;
constexpr size_t WS_Y2B = 66 * MiB;
constexpr int MISC_OFF = 152064;
constexpr int LDS_BYTES = 153600;

__device__ __forceinline__ float lo16(unsigned w) { return __uint_as_float(w << 16); }
__device__ __forceinline__ float hi16(unsigned w) { return __uint_as_float(w & 0xffff0000u); }
__device__ __forceinline__ float bf2f(bf16 h) { return __uint_as_float((unsigned)h << 16); }
__device__ __forceinline__ bf16 f2bf(float f) { unsigned u = __float_as_uint(f); return (bf16)((u + 0x7fffu + ((u >> 16) & 1u)) >> 16); }
__device__ __forceinline__ unsigned pk2(float a, float b) { return pg8::cvt_pk_bf16(a, b); }
__device__ __forceinline__ float wave_sum(float v) {
#pragma unroll
    for (int o = 1; o < 64; o <<= 1) v += __shfl_xor(v, o);
    return v;
}
__device__ __forceinline__ float silu_f(float x) { return x * __builtin_amdgcn_rcpf(1.0f + __expf(-x)); }
__device__ __forceinline__ f32x4 mma(bf16x8 y, bf16x8 x, f32x4 c) { return __builtin_amdgcn_mfma_f32_16x16x32_bf16(y, x, c, 0, 0, 0); }
__device__ __forceinline__ unsigned opaque0() { unsigned z; asm volatile("s_mov_b32 %0, 0" : "=s"(z)); return z; }
#define NT_LD(p) __builtin_nontemporal_load(p)
#define NT_ST(v, p) __builtin_nontemporal_store((v), (p))
#define LDS_WAIT() asm volatile("s_waitcnt lgkmcnt(0)" ::: "memory")
#define FRAG(p) (*(const LAS bf16x8*)(p))

template <bool FOLD>
__device__ __forceinline__ void xpose_item(const float* W, int Nsrc, int K, bf16* WT, int k0, int n0, int drow0, LAS float* scr, int lane, const float* gain = nullptr, const float* bias = nullptr, float* cd = nullptr, int ncd = 0) {
    const int c4 = lane & 7, kr = lane >> 3, nn4 = n0 + 4 * c4; const bool okn = nn4 < Nsrc;
    f32x4 cp = (f32x4){0.f, 0.f, 0.f, 0.f}, dp = cp;
    f32x4 wv[8];
#pragma unroll
    for (int i = 0; i < 8; ++i) { const int kk = 8 * i + kr; wv[i] = okn ? NT_LD((const f32x4*)(W + (size_t)(k0 + kk) * Nsrc + nn4)) : (f32x4){0.f, 0.f, 0.f, 0.f}; }
#pragma unroll
    for (int i = 0; i < 8; ++i) { const int kk = 8 * i + kr; f32x4 w = wv[i];
        if (FOLD) { const float bk = bias[k0 + kk], gk = gain[k0 + kk]; dp += w * bk; w = w * gk;
            cp[0] += __uint_as_float(pk2(w[0], 0.0f) << 16); cp[1] += __uint_as_float(pk2(w[1], 0.0f) << 16); cp[2] += __uint_as_float(pk2(w[2], 0.0f) << 16); cp[3] += __uint_as_float(pk2(w[3], 0.0f) << 16); }
        LAS float* d = scr + kk * 33 + 4 * c4; d[0] = w[0]; d[1] = w[1]; d[2] = w[2]; d[3] = w[3]; }
    if (FOLD) {
#pragma unroll
        for (int j = 0; j < 4; ++j) { float a = cp[j], b = dp[j]; a += __shfl_xor(a, 8); a += __shfl_xor(a, 16); a += __shfl_xor(a, 32); b += __shfl_xor(b, 8); b += __shfl_xor(b, 16); b += __shfl_xor(b, 32);
            if (kr == 0) { atomicAdd(cd + drow0 + 4 * c4 + j, a); atomicAdd(cd + ncd + drow0 + 4 * c4 + j, b); } } }
    LDS_WAIT();
    const int c = lane & 7;
#pragma unroll
    for (int j = 0; j < 4; ++j) { const int n = (lane >> 3) + 8 * j; const LAS float* s = scr + (8 * c) * 33 + n;
        u32x4 o; o.x = pk2(s[0 * 33], s[1 * 33]); o.y = pk2(s[2 * 33], s[3 * 33]); o.z = pk2(s[4 * 33], s[5 * 33]); o.w = pk2(s[6 * 33], s[7 * 33]);
        *(u32x4*)(WT + (size_t)(drow0 + n) * K + k0 + 8 * c) = o; }
    LDS_WAIT();
}
template <bool FOLD>
__device__ __forceinline__ void convert_ffn(const float* wg, const float* wu, const float* wd, bf16* WGU, bf16* WD, LAS float* scr, int gw, int NGW, int lane, const float* gain = nullptr, const float* bias = nullptr, float* cd = nullptr) {
    for (int it = gw; it < 3 * 5632; it += NGW) {
        int r = it;
        if (r < 2 * 5632) { const int up = r >= 5632 ? 1 : 0; r -= up * 5632; const int kb = r / 176, nb = r % 176, n0 = nb * 32;
            xpose_item<FOLD>(up ? wu : wg, DFF, DM, WGU, kb * 64, n0, 256 * (n0 >> 7) + (n0 & 127) + up * 128, scr, lane, gain, bias, cd, NGU); }
        else { r -= 2 * 5632; const int kb = r / 64, nb = r % 64; xpose_item<false>(wd, DM, DFF, WD, kb * 64, nb * 32, nb * 32, scr, lane); }
    }
}
template <bool WBF>
__device__ __forceinline__ void ln_rows(float* io, const float* gain, const float* bias, bf16* xb, float* stats, int gw, int NGW, int lane) {
    f32x4 nx[8];
    if (gw < M_TOK) { const f32x4* p0 = (const f32x4*)(io + (size_t)gw * DM) + lane;
#pragma unroll
        for (int j = 0; j < 8; ++j) nx[j] = NT_LD(p0 + 64 * j); }
#pragma unroll 1
    for (int row = gw; row < M_TOK; row += NGW) {
        f32x4* p = (f32x4*)(io + (size_t)row * DM) + lane;
        f32x4 v[8]; float s = 0.f;
#pragma unroll
        for (int j = 0; j < 8; ++j) { v[j] = nx[j]; s += (v[j][0] + v[j][1]) + (v[j][2] + v[j][3]); }
        if (row + NGW < M_TOK) { const f32x4* pn = (const f32x4*)(io + (size_t)(row + NGW) * DM) + lane;
#pragma unroll
            for (int j = 0; j < 8; ++j) nx[j] = NT_LD(pn + 64 * j); }
        const float mean = wave_sum(s) * (1.0f / DM); float s2 = 0.f;
#pragma unroll
        for (int j = 0; j < 8; ++j) { v[j] = v[j] - mean; s2 += (v[j][0] * v[j][0] + v[j][1] * v[j][1]) + (v[j][2] * v[j][2] + v[j][3] * v[j][3]); }
        const float rstd = 1.0f / sqrtf(wave_sum(s2) * (1.0f / DM) + LN_EPS);
#pragma unroll
        for (int j = 0; j < 8; ++j) {
            const f32x4 g = ((const f32x4*)gain)[lane + 64 * j], b = ((const f32x4*)bias)[lane + 64 * j];
            const f32x4 o = v[j] * rstd * g + b;
            if (!WBF) NT_ST(o, p + 64 * j);
            if (WBF) { u32x2 w; w.x = pk2(o[0], o[1]); w.y = pk2(o[2], o[3]); ((u32x2*)(xb + (size_t)row * DM))[lane + 64 * j] = w; }
        }
        if (WBF && lane == 0) { stats[2 * (size_t)row] = mean; stats[2 * (size_t)row + 1] = rstd; }
    }
}

__device__ __forceinline__ void ln3_rows(const bf16* yb, float* out, const float* gain, const float* bias, int gw, int NGW, int lane) {
    u32x4 nx[4];
    if (gw < M_TOK) { const u32x4* p0 = (const u32x4*)(yb + (size_t)gw * DM) + lane;
#pragma unroll
        for (int j = 0; j < 4; ++j) nx[j] = NT_LD(p0 + 64 * j); }
#pragma unroll 1
    for (int row = gw; row < M_TOK; row += NGW) {
        f32x4 v[8]; float s = 0.f;
#pragma unroll
        for (int j = 0; j < 4; ++j) { const u32x4 w = nx[j];
            v[2 * j] = (f32x4){lo16(w.x), hi16(w.x), lo16(w.y), hi16(w.y)}; v[2 * j + 1] = (f32x4){lo16(w.z), hi16(w.z), lo16(w.w), hi16(w.w)};
            s += ((v[2 * j][0] + v[2 * j][1]) + (v[2 * j][2] + v[2 * j][3])) + ((v[2 * j + 1][0] + v[2 * j + 1][1]) + (v[2 * j + 1][2] + v[2 * j + 1][3])); }
        if (row + NGW < M_TOK) { const u32x4* pn = (const u32x4*)(yb + (size_t)(row + NGW) * DM) + lane;
#pragma unroll
            for (int j = 0; j < 4; ++j) nx[j] = NT_LD(pn + 64 * j); }
        const float mean = wave_sum(s) * (1.0f / DM); float s2 = 0.f;
#pragma unroll
        for (int k = 0; k < 8; ++k) { v[k] = v[k] - mean; s2 += (v[k][0] * v[k][0] + v[k][1] * v[k][1]) + (v[k][2] * v[k][2] + v[k][3] * v[k][3]); }
        const float rstd = 1.0f / sqrtf(wave_sum(s2) * (1.0f / DM) + LN_EPS);
        f32x4* po = (f32x4*)(out + (size_t)row * DM);
#pragma unroll
        for (int j = 0; j < 4; ++j) {
            const int e4 = 2 * (lane + 64 * j);
            const f32x4 g0 = ((const f32x4*)gain)[e4], g1 = ((const f32x4*)gain)[e4 + 1], b0 = ((const f32x4*)bias)[e4], b1 = ((const f32x4*)bias)[e4 + 1];
            NT_ST(v[2 * j] * rstd * g0 + b0, po + e4); NT_ST(v[2 * j + 1] * rstd * g1 + b1, po + e4 + 1);
        }
    }
}

__device__ __forceinline__ void conv8(const bf16* PROJ, const float* cw, const float* cb, size_t tokrow, int t, int ch, f32x4& a0, f32x4& a1) {
    a0 = *(const f32x4*)(cb + ch); a1 = *(const f32x4*)(cb + ch + 4);
#pragma unroll
    for (int k = 0; k < 4; ++k) {
        if (t - 3 + k >= 0) {
            const u32x4 raw = *(const u32x4*)(PROJ + (tokrow - 3 + k) * PLD + 5120 + ch);
            const f32x4 w0 = *(const f32x4*)(cw + k * 1536 + ch), w1 = *(const f32x4*)(cw + k * 1536 + ch + 4);
            a0[0] += w0[0] * lo16(raw.x); a0[1] += w0[1] * hi16(raw.x); a0[2] += w0[2] * lo16(raw.y); a0[3] += w0[3] * hi16(raw.y);
            a1[0] += w1[0] * lo16(raw.z); a1[1] += w1[1] * hi16(raw.z); a1[2] += w1[2] * lo16(raw.w); a1[3] += w1[3] * hi16(raw.w);
        }
    }
#pragma unroll
    for (int i = 0; i < 4; ++i) { a0[i] = silu_f(a0[i]); a1[i] = silu_f(a1[i]); }
}
__device__ __forceinline__ void dt_acum(const float* DT, const float* dt_bias, const float* a_log, size_t tok0, int head, int lane, float& dt, float& ac) {
    const float x = DT[(tok0 + lane) * 16 + head] + dt_bias[head];
    dt = x > 20.0f ? x : log1pf(expf(x));
    float s = dt * (-expf(a_log[head]));
#pragma unroll
    for (int o = 1; o < 64; o <<= 1) { const float t = __shfl_up(s, o); if (lane >= o) s += t; }
    ac = s;
}

template <int I> __device__ __forceinline__ float bfel(const u32x4& w) { const unsigned x = (I >> 1) == 0 ? w.x : (I >> 1) == 1 ? w.y : (I >> 1) == 2 ? w.z : w.w; return (I & 1) ? hi16(x) : lo16(x); }
template <int I> __device__ __forceinline__ void xp_row(const u32x4 (&raw)[8], const float (&sc)[8], LAS bf16* dst, int stride) {
    u32x4 w; w.x = pk2(bfel<I>(raw[0]) * sc[0], bfel<I>(raw[1]) * sc[1]); w.y = pk2(bfel<I>(raw[2]) * sc[2], bfel<I>(raw[3]) * sc[3]);
    w.z = pk2(bfel<I>(raw[4]) * sc[4], bfel<I>(raw[5]) * sc[5]); w.w = pk2(bfel<I>(raw[6]) * sc[6], bfel<I>(raw[7]) * sc[7]);
    *(LAS u32x4*)(dst + I * stride) = w;
}
__device__ __forceinline__ void xpose8_store(const u32x4 (&raw)[8], const float (&sc)[8], LAS bf16* dst, int stride) {
    xp_row<0>(raw, sc, dst, stride); xp_row<1>(raw, sc, dst, stride); xp_row<2>(raw, sc, dst, stride); xp_row<3>(raw, sc, dst, stride);
    xp_row<4>(raw, sc, dst, stride); xp_row<5>(raw, sc, dst, stride); xp_row<6>(raw, sc, dst, stride); xp_row<7>(raw, sc, dst, stride);
}
__device__ __forceinline__ void conv_tile8(const bf16* PROJ, const float* cw, const float* cb, size_t tok0, int t0, int tg, int chn, f32x4 (&o0)[8], f32x4 (&o1)[8]) {
    u32x4 rw[11];
#pragma unroll
    for (int k = 0; k < 11; ++k) {
        const int tt = t0 + tg * 8 - 3 + k; const bool ok = tt >= 0; const int rel = ok ? (tg * 8 + k - 3) : -t0;
        const u32x4 v = *(const u32x4*)(PROJ + (size_t)((long)tok0 + rel) * PLD + 5120 + chn);
        rw[k].x = ok ? v.x : 0u; rw[k].y = ok ? v.y : 0u; rw[k].z = ok ? v.z : 0u; rw[k].w = ok ? v.w : 0u; }
    f32x4 w0[4], w1[4];
#pragma unroll
    for (int k = 0; k < 4; ++k) { w0[k] = *(const f32x4*)(cw + k * 1536 + chn); w1[k] = *(const f32x4*)(cw + k * 1536 + chn + 4); }
    const f32x4 b0 = *(const f32x4*)(cb + chn), b1 = *(const f32x4*)(cb + chn + 4);
#pragma unroll
    for (int r = 0; r < 8; ++r) {
        f32x4 a0 = b0, a1 = b1;
#pragma unroll
        for (int k = 0; k < 4; ++k) { const u32x4 x = rw[r + k];
            a0[0] += w0[k][0] * lo16(x.x); a0[1] += w0[k][1] * hi16(x.x); a0[2] += w0[k][2] * lo16(x.y); a0[3] += w0[k][3] * hi16(x.y);
            a1[0] += w1[k][0] * lo16(x.z); a1[1] += w1[k][1] * hi16(x.z); a1[2] += w1[k][2] * lo16(x.w); a1[3] += w1[k][3] * hi16(x.w); }
#pragma unroll
        for (int i = 0; i < 4; ++i) { a0[i] = silu_f(a0[i]); a1[i] = silu_f(a1[i]); }
        o0[r] = a0; o1[r] = a1;
    }
}
template <int I> __device__ __forceinline__ void ct_row(const f32x4 (&o0)[8], const f32x4 (&o1)[8], const float (&sc)[8], LAS bf16* dst, int stride) {
    float v[8];
#pragma unroll
    for (int r = 0; r < 8; ++r) v[r] = (I < 4 ? o0[r][I & 3] : o1[r][I & 3]) * sc[r];
    u32x4 w; w.x = pk2(v[0], v[1]); w.y = pk2(v[2], v[3]); w.z = pk2(v[4], v[5]); w.w = pk2(v[6], v[7]);
    *(LAS u32x4*)(dst + I * stride) = w;
}
__device__ __forceinline__ void conv_store_t(const f32x4 (&o0)[8], const f32x4 (&o1)[8], const float (&sc)[8], LAS bf16* dst, int stride) {
    ct_row<0>(o0, o1, sc, dst, stride); ct_row<1>(o0, o1, sc, dst, stride); ct_row<2>(o0, o1, sc, dst, stride); ct_row<3>(o0, o1, sc, dst, stride);
    ct_row<4>(o0, o1, sc, dst, stride); ct_row<5>(o0, o1, sc, dst, stride); ct_row<6>(o0, o1, sc, dst, stride); ct_row<7>(o0, o1, sc, dst, stride);
}

__device__ __forceinline__ void ret_a_unit(LAS unsigned char* lds, const bf16* PROJ, bf16* RETS, int b, int z, int h, int tid, bool P5_DO_STORE = true) {
    asm volatile("" : "+v"(tid));
    const int wave = tid >> 6, lane = tid & 63, l15 = lane & 15, l4 = lane >> 4;
    const size_t tok0 = (size_t)b * SEQ + (size_t)z * 64;
    const float lg2 = log2f(1.0f - exp2f(-5.0f - (float)h));
    LAS bf16* Kt = (LAS bf16*)lds;
    LAS bf16* Vt = (LAS bf16*)(lds + 36864);
    {
        const int mat = tid >> 8, ch = (tid >> 3) & 31, tg = tid & 7;
        u32x4 raw[8]; float sc[8];
#pragma unroll
        for (int r = 0; r < 8; ++r) raw[r] = *(const u32x4*)(PROJ + (tok0 + tg * 8 + r) * PLD + (mat ? 2048 : 1024) + h * 256 + ch * 8);
#pragma unroll
        for (int r = 0; r < 8; ++r) sc[r] = mat ? 1.0f : exp2f(lg2 * (float)(63 - (tg * 8 + r)));
        xpose8_store(raw, sc, (mat ? Vt : Kt) + (ch * 8) * 72 + tg * 8, 72);
    }
    __syncthreads();
#ifdef DBG_LDS
#define DBG_CHECK(slot) { int bad = 0; \
    for (int it = 0; it < 8; ++it) { const int q = it * NT + tid, j = q & 63, ch = (q >> 6) & 31, mat = q >> 11; \
        const u32x4 raw = *(const u32x4*)(PROJ + (tok0 + j) * PLD + (mat ? 2048 : 1024) + h * 256 + ch * 8); \
        const float sc = mat ? 1.0f : exp2f(lg2 * (float)(63 - j)); \
        volatile LAS bf16* dst = (mat ? Vt : Kt) + (ch * 8) * 72 + j; \
        bad += (dst[0 * 72] != f2bf(lo16(raw.x) * sc)) + (dst[1 * 72] != f2bf(hi16(raw.x) * sc)) + (dst[2 * 72] != f2bf(lo16(raw.y) * sc)) + (dst[3 * 72] != f2bf(hi16(raw.y) * sc)) \
             + (dst[4 * 72] != f2bf(lo16(raw.z) * sc)) + (dst[5 * 72] != f2bf(hi16(raw.z) * sc)) + (dst[6 * 72] != f2bf(lo16(raw.w) * sc)) + (dst[7 * 72] != f2bf(hi16(raw.w) * sc)); } \
    (RETS + (size_t)200 * 1024 * 1024 / 2)[(size_t)((b * 128 + z) * 4 + h) * 1024 + (slot) * 512 + tid] = f2bf(1000.0f * (float)bad); }
    DBG_CHECK(0)
#endif
    bf16* out = RETS + ((size_t)((b * 4 + h) * 128 + z)) * 65536;
#pragma unroll 1
    for (int dh = 0; dh < 2; ++dh) {
        f32x4 acc[2][8];
#pragma unroll
        for (int mt = 0; mt < 2; ++mt)
#pragma unroll
            for (int nt = 0; nt < 8; ++nt) acc[mt][nt] = (f32x4){0.f, 0.f, 0.f, 0.f};
#pragma unroll
        for (int ks = 0; ks < 2; ++ks) {
            bf16x8 xa[2];
#pragma unroll
            for (int mt = 0; mt < 2; ++mt) xa[mt] = FRAG(Vt + (32 * wave + 16 * mt + l15) * 72 + ks * 32 + 8 * l4);
#pragma unroll
            for (int nt = 0; nt < 8; ++nt) { const bf16x8 yb = FRAG(Kt + (128 * dh + 64 * (nt >> 2) + 16 * (l15 >> 2) + 4 * (nt & 3) + (l15 & 3)) * 72 + ks * 32 + 8 * l4);
#pragma unroll
                for (int mt = 0; mt < 2; ++mt) acc[mt][nt] = mma(yb, xa[mt], acc[mt][nt]); }
        }
#pragma unroll
        for (int mt = 0; mt < 2; ++mt)
#pragma unroll
            for (int gq = 0; gq < 2; ++gq) { const int e = 32 * wave + 16 * mt + l15, d = 128 * dh + 64 * gq + 16 * l4;
#pragma unroll
                for (int hh = 0; hh < 2; ++hh) { const f32x4 a = acc[mt][4 * gq + 2 * hh], c = acc[mt][4 * gq + 2 * hh + 1];
                    u32x4 w; w.x = pk2(a[0], a[1]); w.y = pk2(a[2], a[3]); w.z = pk2(c[0], c[1]); w.w = pk2(c[2], c[3]); if (P5_DO_STORE) *(u32x4*)(out + e * 256 + d + 8 * hh) = w; } }
    }
#ifdef DBG_LDS
    DBG_CHECK(1)
#endif
    __syncthreads();
}

__device__ __forceinline__ void ret_a_block(LAS unsigned char* lds, const bf16* PROJ, bf16* RETS, int bx, int G, int tid) {
    asm volatile("" : "+v"(tid));
    const int wave = tid >> 6, lane = tid & 63, l15 = lane & 15, l4 = lane >> 4;
    LAS bf16* Kt = (LAS bf16*)lds;
    LAS bf16* Vt = (LAS bf16*)(lds + 36864);
    const int mat = tid >> 8, ch = (tid >> 3) & 31, tg = tid & 7;
    u32x4 raw[8];
    int u = bx;
    if (u < 1024) { const int b = u >> 9, z = (u >> 2) & 127, h = u & 3; const size_t tok0 = (size_t)b * SEQ + (size_t)z * 64;
#pragma unroll
        for (int r = 0; r < 8; ++r) raw[r] = *(const u32x4*)(PROJ + (tok0 + tg * 8 + r) * PLD + (mat ? 2048 : 1024) + h * 256 + ch * 8); }
#pragma unroll 1
    for (; u < 1024; u += G) {
        const int b = u >> 9, z = (u >> 2) & 127, h = u & 3;
        const float lg2 = log2f(1.0f - exp2f(-5.0f - (float)h));
        { float sc[8];
#pragma unroll
          for (int r = 0; r < 8; ++r) sc[r] = mat ? 1.0f : exp2f(lg2 * (float)(63 - (tg * 8 + r)));
          xpose8_store(raw, sc, (mat ? Vt : Kt) + (ch * 8) * 72 + tg * 8, 72); }
        __syncthreads();
        { const int un = u + G;
          if (un < 1024) { const int bn = un >> 9, zn = (un >> 2) & 127, hn = un & 3; const size_t tokn = (size_t)bn * SEQ + (size_t)zn * 64;
#pragma unroll
            for (int r = 0; r < 8; ++r) raw[r] = *(const u32x4*)(PROJ + (tokn + tg * 8 + r) * PLD + (mat ? 2048 : 1024) + hn * 256 + ch * 8); } }
        bf16* out = RETS + ((size_t)((b * 4 + h) * 128 + z)) * 65536;
#pragma unroll 1
        for (int dh = 0; dh < 2; ++dh) {
            f32x4 acc[2][8];
#pragma unroll
            for (int mt = 0; mt < 2; ++mt)
#pragma unroll
                for (int nt = 0; nt < 8; ++nt) acc[mt][nt] = (f32x4){0.f, 0.f, 0.f, 0.f};
#pragma unroll
            for (int ks = 0; ks < 2; ++ks) {
                bf16x8 xa[2];
#pragma unroll
                for (int mt = 0; mt < 2; ++mt) xa[mt] = FRAG(Vt + (32 * wave + 16 * mt + l15) * 72 + ks * 32 + 8 * l4);
#pragma unroll
                for (int nt = 0; nt < 8; ++nt) { const bf16x8 yb = FRAG(Kt + (128 * dh + 64 * (nt >> 2) + 16 * (l15 >> 2) + 4 * (nt & 3) + (l15 & 3)) * 72 + ks * 32 + 8 * l4);
#pragma unroll
                    for (int mt = 0; mt < 2; ++mt) acc[mt][nt] = mma(yb, xa[mt], acc[mt][nt]); }
            }
#pragma unroll
            for (int mt = 0; mt < 2; ++mt)
#pragma unroll
                for (int gq = 0; gq < 2; ++gq) { const int e = 32 * wave + 16 * mt + l15, d = 128 * dh + 64 * gq + 16 * l4;
#pragma unroll
                    for (int hh = 0; hh < 2; ++hh) { const f32x4 a = acc[mt][4 * gq + 2 * hh], c = acc[mt][4 * gq + 2 * hh + 1];
                        u32x4 w; w.x = pk2(a[0], a[1]); w.y = pk2(a[2], a[3]); w.z = pk2(c[0], c[1]); w.w = pk2(c[2], c[3]); *(u32x4*)(out + e * 256 + d + 8 * hh) = w; } }
        }
        __syncthreads();
    }
}

__device__ __forceinline__ void ssd_a_unit(LAS unsigned char* lds, const bf16* PROJ, const float* DT, const float* cw, const float* cb, const float* dt_bias, const float* a_log,
                                           bf16* SSDS, float* TOT, int b, int z, int g, int tid, bool P5_DO_STORE = true) {
    asm volatile("" : "+v"(tid));
    const int wave = tid >> 6, lane = tid & 63, l15 = lane & 15, l4 = lane >> 4;
    const size_t tok0 = (size_t)b * SEQ + (size_t)z * 64;
    LAS bf16* Bt = (LAS bf16*)lds;
    LAS bf16* Xt = (LAS bf16*)(lds + 18432);
    LAS float* coef = (LAS float*)(lds + 92160);
    { float dt, ac; dt_acum(DT, dt_bias, a_log, tok0, g * 8 + wave, lane, dt, ac); const float last = __shfl(ac, 63);
      coef[wave * 64 + lane] = dt * expf(last - ac); if (lane == 63) TOT[(size_t)(b * 128 + z) * 16 + g * 8 + wave] = expf(last); }
    __syncthreads();
    {
        const int chx = tid >> 3, tg = tid & 7; f32x4 o0[8], o1[8]; float sc[8];
        conv_tile8(PROJ, cw, cb, tok0, z * 64, tg, g * 512 + chx * 8, o0, o1);
#pragma unroll
        for (int r = 0; r < 8; ++r) sc[r] = coef[(chx >> 3) * 64 + tg * 8 + r];
        conv_store_t(o0, o1, sc, Xt + (chx * 8) * 72 + tg * 8, 72);
    }
    if (tid < 128) {
        const int chb = tid >> 3, tg = tid & 7; f32x4 o0[8], o1[8]; float sc[8];
        conv_tile8(PROJ, cw, cb, tok0, z * 64, tg, 1024 + g * 128 + chb * 8, o0, o1);
#pragma unroll
        for (int r = 0; r < 8; ++r) sc[r] = 1.0f;
        conv_store_t(o0, o1, sc, Bt + (chb * 8) * 72 + tg * 8, 72);
    }
    __syncthreads();
    bf16* out = SSDS + ((size_t)((b * 16 + g * 8 + wave) * 128 + z)) * 8192;
#pragma unroll 1
    for (int nh = 0; nh < 2; ++nh) {
        f32x4 acc[4][4];
#pragma unroll
        for (int mt = 0; mt < 4; ++mt)
#pragma unroll
            for (int nt = 0; nt < 4; ++nt) acc[mt][nt] = (f32x4){0.f, 0.f, 0.f, 0.f};
#pragma unroll
        for (int ks = 0; ks < 2; ++ks) {
            bf16x8 xa[4];
#pragma unroll
            for (int mt = 0; mt < 4; ++mt) xa[mt] = FRAG(Xt + (64 * wave + 16 * mt + l15) * 72 + ks * 32 + 8 * l4);
#pragma unroll
            for (int nt = 0; nt < 4; ++nt) { const bf16x8 yb = FRAG(Bt + (64 * nh + 16 * (l15 >> 2) + 4 * nt + (l15 & 3)) * 72 + ks * 32 + 8 * l4);
#pragma unroll
                for (int mt = 0; mt < 4; ++mt) acc[mt][nt] = mma(yb, xa[mt], acc[mt][nt]); }
        }
#pragma unroll
        for (int mt = 0; mt < 4; ++mt)
#pragma unroll
            for (int hh = 0; hh < 2; ++hh) { const int p = 16 * mt + l15, n = 64 * nh + 16 * l4 + 8 * hh; const f32x4 a = acc[mt][2 * hh], c = acc[mt][2 * hh + 1];
                u32x4 w; w.x = pk2(a[0], a[1]); w.y = pk2(a[2], a[3]); w.z = pk2(c[0], c[1]); w.w = pk2(c[2], c[3]); if (P5_DO_STORE) *(u32x4*)(out + p * 128 + n) = w; }
    }
    __syncthreads();
}

__device__ __forceinline__ void scan_phase(bf16* RETS, bf16* SSDS, const float* TOT, int gtid, int nth) {
    for (int task = gtid; task < 98304; task += nth) {
        bf16* base; size_t stride; float cdec = 0.f; const float* totp = nullptr;
        if (task < 65536) { const int bh = task >> 13, e8 = task & 8191; base = RETS + (size_t)bh * 128 * 65536 + (size_t)e8 * 8; stride = 65536;
            cdec = exp2f(64.0f * log2f(1.0f - exp2f(-5.0f - (float)(bh & 3)))); }
        else { const int t2 = task - 65536, bhd = t2 >> 10, e8 = t2 & 1023; base = SSDS + (size_t)bhd * 128 * 8192 + (size_t)e8 * 8; stride = 8192;
            totp = TOT + (size_t)(bhd >> 4) * 128 * 16 + (bhd & 15); }
        float s0 = 0.f, s1 = 0.f, s2 = 0.f, s3 = 0.f, s4 = 0.f, s5 = 0.f, s6 = 0.f, s7 = 0.f;
        u32x4 nv[8]; float ndec[8];
#pragma unroll
        for (int i = 0; i < 8; ++i) { nv[i] = NT_LD((const u32x4*)(base + (size_t)i * stride)); ndec[i] = totp ? totp[i * 16] : cdec; }
#pragma unroll 1
        for (int z0 = 0; z0 < 128; z0 += 8) {
            u32x4 v[8]; float dec[8];
#pragma unroll
            for (int i = 0; i < 8; ++i) { v[i] = nv[i]; dec[i] = ndec[i]; }
            if (z0 + 8 < 128) {
#pragma unroll
                for (int i = 0; i < 8; ++i) { nv[i] = NT_LD((const u32x4*)(base + (size_t)(z0 + 8 + i) * stride)); ndec[i] = totp ? totp[(z0 + 8 + i) * 16] : cdec; } }
#pragma unroll
            for (int i = 0; i < 8; ++i) {
                u32x4 o; o.x = pk2(s0, s1); o.y = pk2(s2, s3); o.z = pk2(s4, s5); o.w = pk2(s6, s7);
                *(u32x4*)(base + (size_t)(z0 + i) * stride) = o;
                const float d = dec[i];
                s0 = s0 * d + lo16(v[i].x); s1 = s1 * d + hi16(v[i].x); s2 = s2 * d + lo16(v[i].y); s3 = s3 * d + hi16(v[i].y);
                s4 = s4 * d + lo16(v[i].z); s5 = s5 * d + hi16(v[i].z); s6 = s6 * d + lo16(v[i].w); s7 = s7 * d + hi16(v[i].w);
            }
        }
    }
}

__device__ __forceinline__ void ret_c_unit(LAS unsigned char* lds, const bf16* PROJ, const bf16* RETS, const float* gn_g, const float* gn_b, bf16* MIX, int b, int z, int h, int tid) {
    asm volatile("" : "+v"(tid));
    const int wave = tid >> 6, lane = tid & 63, l15 = lane & 15, l4 = lane >> 4;
    const size_t tok0 = (size_t)b * SEQ + (size_t)z * 64;
    const float lg2 = log2f(1.0f - exp2f(-5.0f - (float)h));
    LAS bf16* Q = (LAS bf16*)lds;
    LAS bf16* Kn = (LAS bf16*)(lds + 33792);
    LAS bf16* Vt = (LAS bf16*)(lds + 67584);
    LAS bf16* Pm = (LAS bf16*)(lds + 104448);
    LAS float* st1 = (LAS float*)(lds + 113664);
    LAS float* st2 = (LAS float*)(lds + 115712);
    {
        u32x4 qk[8];
#pragma unroll
        for (int it = 0; it < 8; ++it) { const int q = it * NT + tid, ch = q & 31, j = (q >> 5) & 63, mat = q >> 11; qk[it] = *(const u32x4*)(PROJ + (tok0 + j) * PLD + mat * 1024 + h * 256 + ch * 8); }
        if (tid < 256) {
            const int ch = tid >> 3, tg = tid & 7; u32x4 raw[8]; float sc[8];
#pragma unroll
            for (int r = 0; r < 8; ++r) { raw[r] = *(const u32x4*)(PROJ + (tok0 + tg * 8 + r) * PLD + 2048 + h * 256 + ch * 8); sc[r] = 1.0f; }
            xpose8_store(raw, sc, Vt + (ch * 8) * 72 + tg * 8, 72);
        }
#pragma unroll
        for (int it = 0; it < 8; ++it) { const int q = it * NT + tid, ch = q & 31, j = (q >> 5) & 63, mat = q >> 11; *(LAS u32x4*)((mat ? Kn : Q) + j * 264 + ch * 8) = qk[it]; }
    }
    __syncthreads();
    {
        const int mt = wave >> 1, nt0 = 2 * (wave & 1);
        f32x4 sc[2] = {(f32x4){0.f, 0.f, 0.f, 0.f}, (f32x4){0.f, 0.f, 0.f, 0.f}};
#pragma unroll
        for (int ks = 0; ks < 8; ++ks) {
            const bf16x8 xa = FRAG(Q + (16 * mt + l15) * 264 + ks * 32 + 8 * l4);
#pragma unroll
            for (int n2 = 0; n2 < 2; ++n2) { const bf16x8 yb = FRAG(Kn + (16 * (nt0 + n2) + l15) * 264 + ks * 32 + 8 * l4); sc[n2] = mma(yb, xa, sc[n2]); }
        }
#pragma unroll
        for (int n2 = 0; n2 < 2; ++n2) {
            const int i = 16 * mt + l15 + (int)opaque0(), j0 = 16 * (nt0 + n2) + 4 * l4; float p[4];
#pragma unroll
            for (int ii = 0; ii < 4; ++ii) { const int j = j0 + ii; p[ii] = (j <= i) ? sc[n2][ii] * exp2f(lg2 * (float)(i - j)) : 0.0f; }
            u32x2 w; w.x = pk2(p[0], p[1]); w.y = pk2(p[2], p[3]); *(LAS u32x2*)(Pm + i * 72 + j0) = w;
        }
    }
    __syncthreads();
    f32x4 acc[4][2];
#pragma unroll
    for (int mt = 0; mt < 4; ++mt)
#pragma unroll
        for (int nt = 0; nt < 2; ++nt) acc[mt][nt] = (f32x4){0.f, 0.f, 0.f, 0.f};
    const bf16* S = RETS + ((size_t)((b * 4 + h) * 128 + z)) * 65536;
#pragma unroll
    for (int ks = 0; ks < 8; ++ks) {
        bf16x8 yb[2];
#pragma unroll
        for (int nt = 0; nt < 2; ++nt) yb[nt] = NT_LD((const bf16x8*)(S + (32 * wave + 8 * (l15 >> 2) + 4 * nt + (l15 & 3)) * 256 + ks * 32 + 8 * l4));
#pragma unroll
        for (int mt = 0; mt < 4; ++mt) { const bf16x8 xa = FRAG(Q + (16 * mt + l15) * 264 + ks * 32 + 8 * l4);
#pragma unroll
            for (int nt = 0; nt < 2; ++nt) acc[mt][nt] = mma(yb[nt], xa, acc[mt][nt]); }
    }
#pragma unroll
    for (int mt = 0; mt < 4; ++mt) { const float qd = exp2f(lg2 * (float)(16 * mt + l15 + 1));
#pragma unroll
        for (int nt = 0; nt < 2; ++nt) acc[mt][nt] = acc[mt][nt] * qd; }
#pragma unroll
    for (int ks = 0; ks < 2; ++ks) {
        bf16x8 yb[2];
#pragma unroll
        for (int nt = 0; nt < 2; ++nt) yb[nt] = FRAG(Vt + (32 * wave + 8 * (l15 >> 2) + 4 * nt + (l15 & 3)) * 72 + ks * 32 + 8 * l4);
#pragma unroll
        for (int mt = 0; mt < 4; ++mt) { const bf16x8 xa = FRAG(Pm + (16 * mt + l15) * 72 + ks * 32 + 8 * l4);
#pragma unroll
            for (int nt = 0; nt < 2; ++nt) acc[mt][nt] = mma(yb[nt], xa, acc[mt][nt]); }
    }
#pragma unroll
    for (int mt = 0; mt < 4; ++mt) {
        float s = 0.f;
#pragma unroll
        for (int nt = 0; nt < 2; ++nt) s += (acc[mt][nt][0] + acc[mt][nt][1]) + (acc[mt][nt][2] + acc[mt][nt][3]);
        s += __shfl_xor(s, 16); s += __shfl_xor(s, 32);
        if (l4 == 0) st1[wave * 64 + 16 * mt + l15] = s;
    }
    __syncthreads();
    float mean[4];
#pragma unroll
    for (int mt = 0; mt < 4; ++mt) { float m = 0.f;
#pragma unroll
        for (int w = 0; w < 8; ++w) m += st1[w * 64 + 16 * mt + l15];
        mean[mt] = m * (1.0f / 256.0f);
        float s = 0.f;
#pragma unroll
        for (int nt = 0; nt < 2; ++nt) { acc[mt][nt] = acc[mt][nt] - mean[mt]; s += (acc[mt][nt][0] * acc[mt][nt][0] + acc[mt][nt][1] * acc[mt][nt][1]) + (acc[mt][nt][2] * acc[mt][nt][2] + acc[mt][nt][3] * acc[mt][nt][3]); }
        s += __shfl_xor(s, 16); s += __shfl_xor(s, 32);
        if (l4 == 0) st2[wave * 64 + 16 * mt + l15] = s;
    }
    __syncthreads();
#pragma unroll
    for (int mt = 0; mt < 4; ++mt) { float q = 0.f; const int i = 16 * mt + l15;
#pragma unroll
        for (int w = 0; w < 8; ++w) q += st2[w * 64 + i];
        const float rstd = 1.0f / sqrtf(q * (1.0f / 256.0f) + LN_EPS);
        {
            const int col = h * 256 + 32 * wave + 8 * l4;
            const f32x4 g0 = *(const f32x4*)(gn_g + col), g1 = *(const f32x4*)(gn_g + col + 4), b0 = *(const f32x4*)(gn_b + col), b1 = *(const f32x4*)(gn_b + col + 4);
            const u32x4 graw = *(const u32x4*)(PROJ + (tok0 + i) * PLD + 3072 + col);
            const f32x4 o0 = acc[mt][0] * rstd * g0 + b0, o1 = acc[mt][1] * rstd * g1 + b1;
            u32x4 w; w.x = pk2(o0[0] * silu_f(lo16(graw.x)), o0[1] * silu_f(hi16(graw.x))); w.y = pk2(o0[2] * silu_f(lo16(graw.y)), o0[3] * silu_f(hi16(graw.y)));
            w.z = pk2(o1[0] * silu_f(lo16(graw.z)), o1[1] * silu_f(hi16(graw.z))); w.w = pk2(o1[2] * silu_f(lo16(graw.w)), o1[3] * silu_f(hi16(graw.w)));
            *(u32x4*)(MIX + (tok0 + i) * DM + col) = w;
        }
    }
    __syncthreads();
}

__device__ __forceinline__ void ssd_c_unit(LAS unsigned char* lds, const bf16* PROJ, const float* DT, const float* cw, const float* cb, const float* dt_bias, const float* a_log,
                                           const float* dskip, const float* ngain, const bf16* SSDS, bf16* MIX, int b, int z, int g, int tid) {
    asm volatile("" : "+v"(tid));
    const int wave = tid >> 6, lane = tid & 63, l15 = lane & 15, l4 = lane >> 4;
    const size_t tok0 = (size_t)b * SEQ + (size_t)z * 64;
    LAS bf16* Cm = (LAS bf16*)lds;
    LAS bf16* Bm = (LAS bf16*)(lds + 17408);
    LAS bf16* Xt = (LAS bf16*)(lds + 34816);
    LAS float* CB = (LAS float*)(lds + 108544);
    LAS float* dts = (LAS float*)(lds + 125184);
    LAS float* acs = (LAS float*)(lds + 127232);
    LAS bf16* Lw = (LAS bf16*)(lds + 129280 + wave * 2304);
    LAS float* ssq = (LAS float*)(lds + 147712);
    { float dt, ac; dt_acum(DT, dt_bias, a_log, tok0, g * 8 + wave, lane, dt, ac); dts[wave * 64 + lane] = dt; acs[wave * 64 + lane] = ac; }
    __syncthreads();
    {
        const int chx = tid >> 3, tg = tid & 7; f32x4 o0[8], o1[8]; float sc[8];
        conv_tile8(PROJ, cw, cb, tok0, z * 64, tg, g * 512 + chx * 8, o0, o1);
#pragma unroll
        for (int r = 0; r < 8; ++r) sc[r] = dts[(chx >> 3) * 64 + tg * 8 + r];
        conv_store_t(o0, o1, sc, Xt + (chx * 8) * 72 + tg * 8, 72);
    }
    if (tid < 256) {
        const int mat = tid >> 7, chb = (tid >> 3) & 15, tg = tid & 7; f32x4 o0[8], o1[8];
        conv_tile8(PROJ, cw, cb, tok0, z * 64, tg, 1024 + mat * 256 + g * 128 + chb * 8, o0, o1);
#pragma unroll
        for (int r = 0; r < 8; ++r) { u32x4 w; w.x = pk2(o0[r][0], o0[r][1]); w.y = pk2(o0[r][2], o0[r][3]); w.z = pk2(o1[r][0], o1[r][1]); w.w = pk2(o1[r][2], o1[r][3]);
            *(LAS u32x4*)((mat ? Cm : Bm) + (tg * 8 + r) * 136 + chb * 8) = w; }
    }
    __syncthreads();
    {
        const int mt = wave >> 1, nt0 = 2 * (wave & 1);
        f32x4 sc[2] = {(f32x4){0.f, 0.f, 0.f, 0.f}, (f32x4){0.f, 0.f, 0.f, 0.f}};
#pragma unroll
        for (int ks = 0; ks < 4; ++ks) {
            const bf16x8 xa = FRAG(Cm + (16 * mt + l15) * 136 + ks * 32 + 8 * l4);
#pragma unroll
            for (int n2 = 0; n2 < 2; ++n2) { const bf16x8 yb = FRAG(Bm + (16 * (nt0 + n2) + l15) * 136 + ks * 32 + 8 * l4); sc[n2] = mma(yb, xa, sc[n2]); }
        }
#pragma unroll
        for (int n2 = 0; n2 < 2; ++n2) { const int i = 16 * mt + l15, j0 = 16 * (nt0 + n2) + 4 * l4;
#pragma unroll
            for (int ii = 0; ii < 4; ++ii) CB[i * 65 + j0 + ii] = sc[n2][ii]; }
    }
    __syncthreads();
    const int r = wave, head = g * 8 + r;
    f32x4 acc[4][4];
#pragma unroll
    for (int mt = 0; mt < 4; ++mt)
#pragma unroll
        for (int nt = 0; nt < 4; ++nt) acc[mt][nt] = (f32x4){0.f, 0.f, 0.f, 0.f};
    const bf16* S = SSDS + ((size_t)((b * 16 + head) * 128 + z)) * 8192;
#pragma unroll
    for (int ks = 0; ks < 4; ++ks) {
        bf16x8 yb[4];
#pragma unroll
        for (int nt = 0; nt < 4; ++nt) yb[nt] = NT_LD((const bf16x8*)(S + (16 * (l15 >> 2) + 4 * nt + (l15 & 3)) * 128 + ks * 32 + 8 * l4));
#pragma unroll
        for (int mt = 0; mt < 4; ++mt) { const bf16x8 xa = FRAG(Cm + (16 * mt + l15) * 136 + ks * 32 + 8 * l4);
#pragma unroll
            for (int nt = 0; nt < 4; ++nt) acc[mt][nt] = mma(yb[nt], xa, acc[mt][nt]); }
    }
#pragma unroll
    for (int mt = 0; mt < 4; ++mt) { const float fs = expf(acs[r * 64 + 16 * mt + l15]);
#pragma unroll
        for (int nt = 0; nt < 4; ++nt) acc[mt][nt] = acc[mt][nt] * fs; }
#pragma unroll
    for (int mt = 0; mt < 4; ++mt) {
        const int i = 16 * mt + l15 + (int)opaque0(); const float ai = acs[r * 64 + i];
#pragma unroll
        for (int hh = 0; hh < 2; ++hh) {
            float lv[8];
#pragma unroll
            for (int k = 0; k < 8; ++k) { const int j = 16 * l4 + 8 * hh + k; const float e = expf(ai - acs[r * 64 + j]); lv[k] = (j <= i) ? CB[i * 65 + j] * e : 0.0f; }
            u32x4 w; w.x = pk2(lv[0], lv[1]); w.y = pk2(lv[2], lv[3]); w.z = pk2(lv[4], lv[5]); w.w = pk2(lv[6], lv[7]);
            *(LAS u32x4*)(Lw + l15 * 72 + 16 * l4 + 8 * hh) = w;
        }
        LDS_WAIT(); __builtin_amdgcn_wave_barrier();
#pragma unroll
        for (int ks = 0; ks < 2; ++ks) {
            const bf16x8 xa = FRAG(Lw + l15 * 72 + ks * 32 + 8 * l4);
#pragma unroll
            for (int nt = 0; nt < 4; ++nt) { const bf16x8 yb = FRAG(Xt + (64 * r + 16 * (l15 >> 2) + 4 * nt + (l15 & 3)) * 72 + ks * 32 + 8 * l4); acc[mt][nt] = mma(yb, xa, acc[mt][nt]); }
        }
        LDS_WAIT(); __builtin_amdgcn_wave_barrier();
    }
    const float dsk = dskip[head];
#pragma unroll
    for (int mt = 0; mt < 4; ++mt) {
        const int i = 16 * mt + l15; const float dti = dts[r * 64 + i]; const float rdt = dti > 0.f ? 1.0f / dti : 0.f; float sq = 0.f;
        const u32x4 zr0 = *(const u32x4*)(PROJ + (tok0 + i) * PLD + 4096 + g * 512 + r * 64 + 16 * l4), zr1 = *(const u32x4*)(PROJ + (tok0 + i) * PLD + 4096 + g * 512 + r * 64 + 16 * l4 + 8);
#pragma unroll
        for (int nt = 0; nt < 4; ++nt) {
            const int p0 = 16 * l4 + 4 * nt;
            const unsigned zw0 = nt == 0 ? zr0.x : nt == 1 ? zr0.z : nt == 2 ? zr1.x : zr1.z, zw1 = nt == 0 ? zr0.y : nt == 1 ? zr0.w : nt == 2 ? zr1.y : zr1.w;
            const float zz[4] = {lo16(zw0), hi16(zw0), lo16(zw1), hi16(zw1)};
#pragma unroll
            for (int ii = 0; ii < 4; ++ii) { const float x = bf2f(Xt[(64 * r + p0 + ii) * 72 + i]) * rdt; const float y = (acc[mt][nt][ii] + dsk * x) * silu_f(zz[ii]); acc[mt][nt][ii] = y; sq += y * y; }
        }
        sq += __shfl_xor(sq, 16); sq += __shfl_xor(sq, 32);
        if (l4 == 0) ssq[r * 64 + i] = sq;
    }
    __syncthreads();
#pragma unroll
    for (int mt = 0; mt < 4; ++mt) {
        const int i = 16 * mt + l15; float t = 0.f;
#pragma unroll
        for (int w = 0; w < 8; ++w) t += ssq[w * 64 + i];
        const float rstd = 1.0f / sqrtf(t * (1.0f / 512.0f) + LN_EPS);
#pragma unroll
        for (int hh = 0; hh < 2; ++hh) {
            const int col = g * 512 + r * 64 + 16 * l4 + 8 * hh;
            const f32x4 gn0 = *(const f32x4*)(ngain + col), gn1 = *(const f32x4*)(ngain + col + 4);
            const f32x4 o0 = acc[mt][2 * hh] * rstd * gn0, o1 = acc[mt][2 * hh + 1] * rstd * gn1;
            u32x4 w; w.x = pk2(o0[0], o0[1]); w.y = pk2(o0[2], o0[3]); w.z = pk2(o1[0], o1[1]); w.w = pk2(o1[2], o1[3]);
            *(u32x4*)(MIX + (tok0 + i) * DM + 1024 + col) = w;
        }
    }
    __syncthreads();
}

#define XB_TMO      128
#define XB_XCNT(j)  (256  + 64 * (j))
#define XB_XSUB(j)  (1280 + 64 * (j))
#define XB_XGEN(j)  (2304 + 64 * (j))
#define XB_TOP      3328
#define XB_TOPGEN   3392
#define XCD_BAR_WORDS 3456
#define XB_SPIN_CAP (1u << 18)

__device__ __forceinline__ unsigned xb_ld(unsigned* p)              { return __hip_atomic_load(p, __ATOMIC_RELAXED, __HIP_MEMORY_SCOPE_AGENT); }
__device__ __forceinline__ unsigned xb_add(unsigned* p, unsigned v) { return __hip_atomic_fetch_add(p, v, __ATOMIC_RELAXED, __HIP_MEMORY_SCOPE_AGENT); }
__device__ __forceinline__ unsigned xb_xcc_id() { return (unsigned)__builtin_amdgcn_s_getreg((3 << 11) | 20) & 0xFu; }
#define XB_SPIN(cond, bar) do { unsigned _sp = 0; while (cond) { __builtin_amdgcn_s_sleep(1); \
    if ((++_sp & 255u) == 0u) { if (xb_ld(&(bar)[XB_TMO])) break; if (_sp > XB_SPIN_CAP) { atomicAdd(&(bar)[XB_TMO], 1u); break; } } } } while (0)

struct XcdBarrier {
    unsigned* bar; unsigned x;
    volatile LAS unsigned* st;
};

__device__ __forceinline__ XcdBarrier xcd_barrier_post(unsigned* bar, volatile LAS unsigned* st) {
    XcdBarrier b; b.bar = bar; b.x = xb_xcc_id(); b.st = st;
    if (threadIdx.x == 0) (void)xb_add(&bar[XB_XCNT(b.x)], 1u);
    return b;
}
__device__ __forceinline__ void xcd_barrier_complete(unsigned* bar, unsigned x, unsigned& nloc, unsigned& nx) {
    const unsigned G = gridDim.x * gridDim.y * gridDim.z;
    unsigned sum, cnt, mine, sp = 0u;
    for (;;) {
        sum = 0u; cnt = 0u; mine = 0u;
#pragma unroll
        for (unsigned j = 0; j < 16; ++j) { const unsigned c = xb_ld(&bar[XB_XCNT(j)]); sum += c; cnt += (c > 0u) ? 1u : 0u; mine = (j == x) ? c : mine; }
        if (sum == G) break;
        __builtin_amdgcn_s_sleep(1);
        if ((++sp & 255u) == 0u) { if (xb_ld(&bar[XB_TMO])) break; if (sp > XB_SPIN_CAP) { atomicAdd(&bar[XB_TMO], 1u); break; } }
    }
    nloc = mine > 0u ? mine : 1u; nx = cnt > 0u ? cnt : 1u;
}

__device__ __forceinline__ void xcd_barrier(const XcdBarrier& b) {
    asm volatile("s_waitcnt vmcnt(0)" ::: "memory");
    __syncthreads();
    if (threadIdx.x == 0) {
        unsigned* bar = b.bar;
        __builtin_amdgcn_s_waitcnt(0);
        unsigned nloc = b.st[0], nx = b.st[1];
        if (nloc == 0u) { xcd_barrier_complete(bar, b.x, nloc, nx); b.st[0] = nloc; b.st[1] = nx; }
        const unsigned old = xb_add(&bar[XB_XSUB(b.x)], 1u);
        const unsigned gen = old / nloc;
        if (old + 1u == (gen + 1u) * nloc) {
            __builtin_amdgcn_fence(__ATOMIC_RELEASE, "agent");
            asm volatile("s_waitcnt vmcnt(0)" ::: "memory");
            const unsigned og = xb_add(&bar[XB_TOP], 1u);
            const unsigned tg = og / nx;
            if (og + 1u == (tg + 1u) * nx) xb_add(&bar[XB_TOPGEN], 1u);
            else XB_SPIN(xb_ld(&bar[XB_TOPGEN]) == tg, bar);
            __builtin_amdgcn_fence(__ATOMIC_ACQUIRE, "agent");
            xb_add(&bar[XB_XGEN(b.x)], 1u);
            asm volatile("s_waitcnt vmcnt(0)" ::: "memory");
        } else {
            XB_SPIN(xb_ld(&bar[XB_XGEN(b.x)]) == gen, bar);
            __builtin_amdgcn_fence(__ATOMIC_ACQUIRE, "agent");
            asm volatile("s_waitcnt vmcnt(0)" ::: "memory");
        }
    }
    __syncthreads();
}


#ifndef DUMPC
#define DUMPC 0
#endif
__device__ __forceinline__ void dump_bf16(float* out, const bf16* src, size_t ld, size_t col0, int gtid, int nth) {
    for (size_t i = gtid; i < (size_t)M_TOK * DM; i += nth) { const size_t r = i >> 11, c = i & 2047; float v = bf2f(src[r * ld + col0 + c]); if (!(fabsf(v) < 1e30f)) v = 12345.0f; out[i] = v; }
}
struct Args { const void* in[24]; float* out; unsigned char* ws; };
typedef __attribute__((address_space(4))) const unsigned long long karg_t;
#define KARG(T, i) ((T)(__attribute__((address_space(1))) char*)(((karg_t*)__builtin_amdgcn_kernarg_segment_ptr())[(i) + oz]))
#define KF(i) KARG(const float*, i)
#define WSP(T, off) ((T)(KARG(unsigned char*, 25) + (off)))
__global__ void __launch_bounds__(NT, 2) fwd_megakernel(Args a_unused) {
    extern __shared__ __attribute__((aligned(16))) unsigned char lds_raw[];
    LAS unsigned char* lds = (LAS unsigned char*)lds_raw;
    cg::grid_group grid = cg::this_grid();
    XcdBarrier bar;
    { volatile LAS unsigned* misc = (volatile LAS unsigned*)(lds + MISC_OFF); if (threadIdx.x < 2) misc[threadIdx.x] = 0u; if (threadIdx.x == 2) *(volatile LAS unsigned*)(lds + 140000) = 0u; __syncthreads();
      const unsigned oz = opaque0(); bar = xcd_barrier_post((unsigned*)WSP(unsigned char*, WS_CTL), misc); }
    grid.sync();
#define SEAM() xcd_barrier(bar)
#ifndef GEMM_ALIGN
#define GEMM_ALIGN true
#endif
#ifndef SKIP_GEMM
#define SKIP_GEMM 0
#endif
#ifndef STOP_AFTER
#define STOP_AFTER 99
#endif
#define GEOM int tid_o = threadIdx.x; asm volatile("" : "+v"(tid_o)); const int tid = tid_o, lane = tid & 63, wave = __builtin_amdgcn_readfirstlane(tid >> 6); (void)lane; (void)wave; const int G = gridDim.x, bx = blockIdx.x, gw = bx * 8 + wave, NGW = G * 8, gtid = bx * NT + tid, nth = G * NT; (void)gw; (void)NGW; (void)gtid; (void)nth; const unsigned oz = opaque0()

#ifdef P0_TWICE
    for (int rep0 = 0; rep0 < 2; ++rep0)
#endif
    { GEOM; LAS float* scr = (LAS float*)(lds + wave * 8448);
      convert_ffn<false>(KF(2), KF(3), KF(4), WSP(bf16*, WS_WGU), WSP(bf16*, WS_WD), scr, gw, NGW, lane);
      { const float* win = KF(7); const float* wout = KF(16); bf16* WIN = WSP(bf16*, WS_WIN); bf16* WOUT = WSP(bf16*, WS_WOUT);
        for (int it = gw; it < 32 * 216 + 32 * 64; it += NGW) {
            if (it < 32 * 216) { const int kb = it / 216, nb = it % 216; xpose_item<true>(win, NIN, DM, WIN, kb * 64, nb * 32, nb * 32, scr, lane, KF(5), KF(6), WSP(float*, WS_CD_IN), NINP); }
            else { const int r = it - 32 * 216, kb = r / 64, nb = r % 64; xpose_item<false>(wout, DM, DM, WOUT, kb * 64, nb * 32, nb * 32, scr, lane); }
        } }
      { const float* x = KF(0); bf16* XB = WSP(bf16*, WS_XB);
        for (size_t i0 = gtid; i0 < (size_t)M_TOK * DM / 8; i0 += (size_t)4 * nth) {
            f32x4 p[4], q[4];
#pragma unroll
            for (int k = 0; k < 4; ++k) { const size_t i = i0 + (size_t)k * nth; p[k] = NT_LD((const f32x4*)x + 2 * i); q[k] = NT_LD((const f32x4*)x + 2 * i + 1); }
#pragma unroll
            for (int k = 0; k < 4; ++k) { const size_t i = i0 + (size_t)k * nth;
                u32x4 w; w.x = pk2(p[k][0], p[k][1]); w.y = pk2(p[k][2], p[k][3]); w.z = pk2(q[k][0], q[k][1]); w.w = pk2(q[k][2], q[k][3]);
                ((u32x4*)XB)[i] = w; }
        } }
      { const int* pos = KARG(const int*, 1); float* COS = WSP(float*, WS_COS); float* SIN = WSP(float*, WS_SIN);
        const int f = gtid & 127; const double invf = (double)exp2f(-((float)f * (1.0f / 127.0f)) * 13.287712379549449f) * 0.15915494309189535;
        for (int t0 = gtid >> 7; t0 < M_TOK; t0 += 16 * (nth >> 7)) {
            int pp[16];
#pragma unroll
            for (int k = 0; k < 16; ++k) { const int tok = t0 + k * (nth >> 7); pp[k] = tok < M_TOK ? pos[tok] : 0; }
#pragma unroll
            for (int k = 0; k < 16; ++k) { const int tok = t0 + k * (nth >> 7);
                const double rev = (double)pp[k] * invf; const float fr = (float)(rev - rint(rev));
                if (tok < M_TOK) { COS[(size_t)tok * 128 + f] = __builtin_amdgcn_cosf(fr); SIN[(size_t)tok * 128 + f] = __builtin_amdgcn_sinf(fr); } }
        } }
      if (SKIP_GEMM) { bf16* BIGW = WSP(bf16*, WS_BIG); float* DTW = WSP(float*, WS_DT);
        for (size_t i = gtid; i < (size_t)M_TOK * PLD; i += nth) { unsigned hsh = (unsigned)i * 2654435761u; hsh ^= hsh >> 15; hsh *= 2246822519u; hsh ^= hsh >> 13; BIGW[i] = f2bf((float)(hsh & 0xffffu) * (1.0f / 65536.0f) - 0.5f); }
        for (size_t i = gtid; i < (size_t)M_TOK * 16; i += nth) { unsigned hsh = (unsigned)i * 2654435761u; hsh ^= hsh >> 15; hsh *= 2246822519u; hsh ^= hsh >> 13; DTW[i] = (float)(hsh & 0xffffu) * (1.0f / 65536.0f) - 0.5f; } }
    }
    SEAM(); if (STOP_AFTER == 0) return;

    { GEOM; pg8::Gemm g{WSP(const bf16*, WS_XB), WSP(const bf16*, WS_WGU), M_TOK, NGU, DM}; pg8::StaticOrder S; S.init(M_TOK, NGU, G, bx); pg8::EpiSwiglu E{WSP(bf16*, WS_BIG), DFF};
      if (!SKIP_GEMM) pg8::gemm_phase<pg8::EpiSwiglu, pg8::StaticOrder, GEMM_ALIGN, true>(lds, g, S, E); }
    SEAM(); if (STOP_AFTER == 1) return;
    { GEOM; pg8::Gemm g{WSP(const bf16*, WS_BIG), WSP(const bf16*, WS_WD), M_TOK, DM, DFF}; pg8::StaticOrder S; S.init(M_TOK, DM, G, bx); pg8::EpiResEmit<false, 1> E{KF(0), nullptr, nullptr, nullptr, nullptr, WSP(bf16*, WS_XB), WSP(float*, WS_ROWS1)};
      if (!SKIP_GEMM) pg8::gemm_phase<pg8::EpiResEmit<false, 1>, pg8::StaticOrder, GEMM_ALIGN, true>(lds, g, S, E); }
    SEAM(); if (STOP_AFTER == 2) return;
    { GEOM; pg8::Gemm g{WSP(const bf16*, WS_XB), WSP(const bf16*, WS_WIN), M_TOK, NINP, DM}; pg8::StaticOrder S; S.init(M_TOK, NINP, G, bx);
      pg8::EpiInProj E{WSP(bf16*, WS_BIG), WSP(const float*, WS_COS), WSP(const float*, WS_SIN), WSP(float*, WS_DT), WSP(const float*, WS_ROWS1), WSP(const float*, WS_CD_IN), WSP(const float*, WS_CD_IN) + NINP};
      if (!SKIP_GEMM) pg8::gemm_phase<pg8::EpiInProj, pg8::StaticOrder, GEMM_ALIGN, true>(lds, g, S, E);
#ifdef DIAGMODE
      { volatile LAS unsigned* cnt = (volatile LAS unsigned*)(lds + 140000); if (lane == 0) atomicAdd((unsigned*)(lds_raw + 140000), 1u); __syncthreads(); const unsigned v = *cnt; WSP(float*, WS_XB)[gtid] = (float)v; }
#endif
    }
    SEAM();
#ifdef DIAGMODE
    { GEOM; const float* dg = WSP(const float*, WS_XB); float* o = KARG(float*, 24); for (size_t i = gtid; i < (size_t)M_TOK * DM; i += nth) o[i] = dg[i % nth]; return; }
#endif
    if (STOP_AFTER == 4) { GEOM; dump_bf16(KARG(float*, 24), WSP(const bf16*, WS_BIG), PLD, DUMPC, gtid, nth); return; }
#ifdef P5_TWICE
    for (int rep = 0; rep < 2; ++rep) {
#ifdef P5_NOSTORE2
#define P5_STORE_FLAG (rep == 0)
#else
#define P5_STORE_FLAG true
#endif
#else
#define P5_STORE_FLAG true
#endif
    { GEOM; const bf16* BIG = WSP(const bf16*, WS_BIG);
#ifdef TIME_P5
      unsigned long long tacc_r = 0ull, tacc_s = 0ull;
#endif
#ifdef P5_PIPE
      ret_a_block(lds, BIG, WSP(bf16*, WS_RETS), bx, G, tid);
      for (int u = bx + ((1024 - bx + G - 1) / G) * G; u < 1536; u += G) {
#else
      for (int u = bx; u < 1536; u += G) {
#endif
#ifdef TIME_P5
        const unsigned long long tq0 = __builtin_amdgcn_s_memrealtime();
#endif
#ifdef P5_SECOND_ONLY
        if (rep == 1 && ((u < 1024) != (P5_SECOND_ONLY == 0))) continue;
#endif
        if (u < 1024) ret_a_unit(lds, BIG, WSP(bf16*, WS_RETS), u >> 9, (u >> 2) & 127, u & 3, tid, P5_STORE_FLAG);
        else { const int v = u - 1024; ssd_a_unit(lds, BIG, WSP(const float*, WS_DT), KF(10), KF(11), KF(12), KF(13), WSP(bf16*, WS_SSDS), WSP(float*, WS_TOT), v >> 8, (v >> 1) & 127, v & 1, tid, P5_STORE_FLAG); }
#ifdef TIME_P5
        { const unsigned long long tq1 = __builtin_amdgcn_s_memrealtime(); if (u < 1024) tacc_r += tq1 - tq0; else tacc_s += tq1 - tq0; }
#endif
      }
#ifdef TIME_P5
      if (bx == TIME_P5 && tid == 0) { float* dg = WSP(float*, WS_STATS); dg[0] = (float)tacc_r; dg[1] = (float)tacc_s; }
#endif
    }
#ifdef P5_TWICE
    if (rep == 0) SEAM(); }
#endif
#ifdef DBG_FLAG
    { GEOM; unsigned* FL = (unsigned*)WSP(unsigned char*, WS_CTL + 32768); if (tid == 511) FL[bx * 16] = 5u; }
    SEAM();
    { GEOM; const unsigned* FL = (const unsigned*)WSP(unsigned char*, WS_CTL + 32768); int bad = 0; for (int k = 0; k < G; ++k) bad += (FL[k * 16] != 5u);
      float* o = KARG(float*, 24); for (size_t i = gtid; i < (size_t)M_TOK * DM; i += nth) o[i] = 1000.0f * (float)bad; return; }
#endif
#ifdef TIME_P5
    SEAM(); { GEOM; const float* dg = WSP(const float*, WS_STATS); const float a = dg[0], b = dg[1]; float* o = KARG(float*, 24); for (size_t i = gtid; i < (size_t)M_TOK * DM; i += nth) o[i] = (i & 1) ? b : a; return; }
#endif
    SEAM(); if (STOP_AFTER == 5) { GEOM; dump_bf16(KARG(float*, 24), DUMPC == 2 ? WSP(const bf16*, WS_XB) : DUMPC ? WSP(const bf16*, WS_SSDS) : WSP(const bf16*, WS_RETS), DM, 0, gtid, nth); return; }
    { GEOM; scan_phase(WSP(bf16*, WS_RETS), WSP(bf16*, WS_SSDS), WSP(const float*, WS_TOT), gtid, nth); }
    SEAM(); if (STOP_AFTER == 6) { GEOM; dump_bf16(KARG(float*, 24), DUMPC ? WSP(const bf16*, WS_SSDS) : WSP(const bf16*, WS_RETS), DM, 0, gtid, nth); return; }
#ifdef P7_TWICE
    for (int rep7 = 0; rep7 < 2; ++rep7)
#endif
    { GEOM; const bf16* BIG = WSP(const bf16*, WS_BIG); bf16* XB = (bf16*)KARG(float*, 24);
      for (int u = bx; u < 1536; u += G) {
        if (u < 1024) ret_c_unit(lds, BIG, WSP(const bf16*, WS_RETS), KF(8), KF(9), XB, u >> 9, (u >> 2) & 127, u & 3, tid);
        else { const int v = u - 1024; ssd_c_unit(lds, BIG, WSP(const float*, WS_DT), KF(10), KF(11), KF(12), KF(13), KF(14), KF(15), WSP(const bf16*, WS_SSDS), XB, v >> 8, (v >> 1) & 127, v & 1, tid); }
      } }
    SEAM(); if (STOP_AFTER == 7) { GEOM; dump_bf16(KARG(float*, 24), WSP(const bf16*, WS_XB), DM, 0, gtid, nth); return; }
    { GEOM; pg8::Gemm g{(const bf16*)KARG(float*, 24), WSP(const bf16*, WS_WOUT), M_TOK, DM, DM}; pg8::StaticOrder S; S.init(M_TOK, DM, G, bx); pg8::EpiResEmit<true, 2> E{nullptr, WSP(const bf16*, WS_XB), WSP(const float*, WS_ROWS1), KF(5), KF(6), WSP(bf16*, WS_Y2B), WSP(float*, WS_ROWS2)};
      if (!SKIP_GEMM) pg8::gemm_phase<pg8::EpiResEmit<true, 2>, pg8::StaticOrder, GEMM_ALIGN, true>(lds, g, S, E); }
    SEAM(); if (STOP_AFTER == 8) return;
    { GEOM; LAS float* scr = (LAS float*)(lds + wave * 8448);
      convert_ffn<true>(KF(19), KF(20), KF(21), WSP(bf16*, WS_WGU), WSP(bf16*, WS_WD), scr, gw, NGW, lane, KF(17), KF(18), WSP(float*, WS_CD_GU)); }
    SEAM(); if (STOP_AFTER == 9) return;
    { GEOM; pg8::Gemm g{WSP(const bf16*, WS_Y2B), WSP(const bf16*, WS_WGU), M_TOK, NGU, DM}; pg8::StaticOrder S; S.init(M_TOK, NGU, G, bx);
      pg8::EpiSwigluLN E{WSP(bf16*, WS_BIG), DFF, WSP(const float*, WS_ROWS2), WSP(const float*, WS_CD_GU), WSP(const float*, WS_CD_GU) + NGU};
      if (!SKIP_GEMM) pg8::gemm_phase<pg8::EpiSwigluLN, pg8::StaticOrder, GEMM_ALIGN, true>(lds, g, S, E); }
    SEAM(); if (STOP_AFTER == 10) return;
    { GEOM; pg8::Gemm g{WSP(const bf16*, WS_BIG), WSP(const bf16*, WS_WD), M_TOK, DM, DFF}; pg8::StaticOrder S; S.init(M_TOK, DM, G, bx); pg8::EpiResLN2 E{WSP(const bf16*, WS_Y2B), WSP(const float*, WS_ROWS2), KF(17), KF(18), WSP(bf16*, WS_XB)};
      if (!SKIP_GEMM) pg8::gemm_phase<pg8::EpiResLN2, pg8::StaticOrder, GEMM_ALIGN, true>(lds, g, S, E); }
    SEAM(); if (STOP_AFTER == 11) return;
    { GEOM; ln3_rows(WSP(const bf16*, WS_XB), KARG(float*, 24), KF(22), KF(23), gw, NGW, lane); }
}

extern "C" void kernel_launch(void* const* d_in, const int* in_sizes, int n_in, void* d_out, int out_size, void* d_ws, size_t ws_size, hipStream_t stream) {
    static int grid = 0;
    if (grid == 0) {
        if (n_in != 24 || in_sizes[0] != M_TOK * DM || out_size != M_TOK * DM || ws_size < WS_END) {
            fprintf(stderr, "kernel_launch: unexpected problem (n_in %d, in0 %d, out %d, ws %zu); nothing launched\n", n_in, n_in > 0 ? in_sizes[0] : -1, out_size, ws_size); grid = -1; return; }
        int dev = 0, cus = 0, per_cu = 0;
        (void)hipGetDevice(&dev); (void)hipDeviceGetAttribute(&cus, hipDeviceAttributeMultiprocessorCount, dev);
        (void)hipFuncSetAttribute((const void*)fwd_megakernel, hipFuncAttributeMaxDynamicSharedMemorySize, LDS_BYTES);
        if (hipOccupancyMaxActiveBlocksPerMultiprocessor(&per_cu, (const void*)fwd_megakernel, NT, LDS_BYTES) != hipSuccess || per_cu < 1) { per_cu = 1; (void)hipGetLastError(); }
        if (cus < 1) cus = 256;
        grid = cus * per_cu;
    }
    if (grid < 0) return;
    if (hipMemsetAsync((char*)d_ws + WS_CTL, 0, CTL_ZERO_BYTES, stream) != hipSuccess) { fprintf(stderr, "kernel_launch: memset of the barrier words failed\n"); return; }
    Args a{};
    for (int i = 0; i < 24; ++i) a.in[i] = d_in[i];
    a.out = (float*)d_out; a.ws = (unsigned char*)d_ws;
    void* args[] = {&a};
    hipError_t e = hipLaunchCooperativeKernel((const void*)fwd_megakernel, dim3(grid), dim3(NT), args, LDS_BYTES, stream);
    if (e != hipSuccess) fprintf(stderr, "cooperative launch failed: %s (grid %d)\n", hipGetErrorString(e), grid);
}
```

```cpp
#include <hip/hip_runtime.h>
#include <hip/hip_cooperative_groups.h>
#include <cstdio>
#include <cstdint>
namespace cg = cooperative_groups;
#define P5_PIPE 1
namespace pg8 {
#define PG8_LAS __attribute__((address_space(3)))
typedef unsigned short bf16_t;
typedef short bf16x8 __attribute__((ext_vector_type(8)));
typedef float f32x4 __attribute__((ext_vector_type(4)));
typedef unsigned u32x4 __attribute__((ext_vector_type(4)));
constexpr int BM = 256, BK = 64, HALF = 128, HTB = HALF * BK * 2  , STAGE_BYTES = 8 * HTB, NXCD = 8, WGM = 8;

__host__ __device__ __forceinline__ int lds_byte(int r, int c) { const int st = (r >> 4) * 2 + (c >> 5), rr = r & 15, cc = c & 31, ob = rr * 64 + cc * 2; return st * 1024 + (ob ^ (((ob >> 9) & 1) << 5)); }
__host__ __device__ __forceinline__ void stage_rc(int b, int& R, int& C) { const int st = b / 1024, sb = b % 1024, swz = sb ^ (((sb >> 9) & 1) << 5); R = (st >> 1) * 16 + swz / 64; C = (st & 1) * 32 + (swz % 64) / 2; }
__host__ __device__ __forceinline__ int perm32(int rho) { const int n = rho >> 4, i = rho & 15; return 8 * (i >> 2) + 4 * n + (i & 3); }

struct Unit { int pm, pn; };
struct Gemm { const bf16_t* A; const bf16_t* Bt; int M, N, K; };

struct StaticOrder {
    int nM, nN, nwg, G, c;
    __host__ __device__ void init(int M, int N, int G_, int c_) { nM = M / BM; nN = N / BM; nwg = nM * nN; G = G_; c = c_; }
    __host__ __device__ bool next(int i, Unit& u) const {
        const long L = (long)i * G + c; if (L >= nwg) return false;
        int wgid = (int)L; { const int q = nwg / NXCD, r = nwg % NXCD, xcd = wgid % NXCD, off = wgid / NXCD; wgid = (xcd < r ? xcd * (q + 1) : r * (q + 1) + (xcd - r) * q) + off; }
        const int nig = WGM * nN, gid = wgid / nig, fm = gid * WGM, gsz = (nM - fm) < WGM ? (nM - fm) : WGM;
        u.pm = fm + ((wgid % nig) % gsz); u.pn = (wgid % nig) / gsz; return true;
    }
    __device__ __forceinline__ void a_ready(const Unit&) const {}
    __device__ __forceinline__ void done(const Unit&) const {}
};

typedef float cvt_f32x2 __attribute__((ext_vector_type(2)));
typedef __bf16 cvt_bf16x2 __attribute__((ext_vector_type(2)));
__device__ __forceinline__ unsigned cvt_pk_bf16(float lo, float hi) { const cvt_f32x2 v = {lo, hi}; return __builtin_bit_cast(unsigned, __builtin_convertvector(v, cvt_bf16x2)); }

typedef float f32x2e __attribute__((ext_vector_type(2)));
typedef unsigned u32x2 __attribute__((ext_vector_type(2)));
__device__ __forceinline__ void row_stats(const float* rows, int row, float& mu, float& rs) {
    const f32x2e s = *(const f32x2e*)(rows + 2 * (size_t)row);
    mu = s.x * (1.0f / 2048.0f); const float var = s.y * (1.0f / 2048.0f) - mu * mu; rs = 1.0f / sqrtf(fmaxf(var, 0.0f) + 1e-5f);
}
__device__ __forceinline__ float swi(float g, float u) { return g * u * __builtin_amdgcn_rcpf(1.0f + __expf(-g)); }
struct EpiSwiglu {
    static constexpr bool PERM = true, AFTER_DRAIN = false;
    bf16_t* H; int ldh;
    __device__ __forceinline__ void operator()(const f32x4 (&acc)[2][2][4][2], const Unit& u, int wr, int wc, int fr, int fq) const {
        const int row0 = u.pm * BM + wr * 64 + fr, col0 = u.pn * 128 + wc * 32 + 8 * fq;
#pragma unroll
        for (int ai = 0; ai < 2; ++ai)
#pragma unroll
            for (int m = 0; m < 4; ++m) {
                bf16_t* p = H + (size_t)(row0 + ai * HALF + m * 16) * ldh + col0;
                const f32x4 g0 = acc[ai][0][m][0], g1 = acc[ai][0][m][1], u0 = acc[ai][1][m][0], u1 = acc[ai][1][m][1];
                u32x4 w;
                w.x = cvt_pk_bf16(swi(g0[0], u0[0]), swi(g0[1], u0[1])); w.y = cvt_pk_bf16(swi(g0[2], u0[2]), swi(g0[3], u0[3]));
                w.z = cvt_pk_bf16(swi(g1[0], u1[0]), swi(g1[1], u1[1])); w.w = cvt_pk_bf16(swi(g1[2], u1[2]), swi(g1[3], u1[3]));
                *(u32x4*)p = w;
            }
    }
};
struct EpiRes {
    static constexpr bool PERM = false, AFTER_DRAIN = false;
    const float* res; float* out; int ld; float alpha, s;
    __device__ __forceinline__ void operator()(const f32x4 (&acc)[2][2][4][2], const Unit& u, int wr, int wc, int fr, int fq) const {
        const int row0 = u.pm * BM + wr * 64 + fr, col0 = u.pn * BM + wc * 32 + 4 * fq;
#pragma unroll
        for (int ai = 0; ai < 2; ++ai)
#pragma unroll
            for (int m = 0; m < 4; ++m) {
                const size_t off = (size_t)(row0 + ai * HALF + m * 16) * ld + col0;
#pragma unroll
                for (int bj = 0; bj < 2; ++bj)
#pragma unroll
                    for (int n = 0; n < 2; ++n) {
                        const f32x4 r = *(const f32x4*)(res + off + bj * HALF + n * 16);
                        *(f32x4*)(out + off + bj * HALF + n * 16) = r * alpha + acc[ai][bj][m][n] * s;
                    }
            }
    }
};
struct EpiInProj {
    static constexpr bool PERM = true, AFTER_DRAIN = false;
    bf16_t* P; const float* cs; const float* sn; float* DT; const float* rows_in; const float* cv; const float* dv;
    __device__ __forceinline__ void operator()(const f32x4 (&acc)[2][2][4][2], const Unit& u, int wr, int wc, int fr, int fq) const {
        const int row0 = u.pm * BM + wr * 64 + fr, pn = u.pn;
        f32x4 cc[2][2], dd[2][2]; float mu[2][4], rs[2][4];
#pragma unroll
        for (int bj = 0; bj < 2; ++bj) { const int nc = pn * BM + bj * HALF + wc * 32 + 8 * fq;
            cc[bj][0] = *(const f32x4*)(cv + nc); cc[bj][1] = *(const f32x4*)(cv + nc + 4); dd[bj][0] = *(const f32x4*)(dv + nc); dd[bj][1] = *(const f32x4*)(dv + nc + 4); }
#pragma unroll
        for (int ai = 0; ai < 2; ++ai)
#pragma unroll
            for (int m = 0; m < 4; ++m) row_stats(rows_in, row0 + ai * HALF + m * 16, mu[ai][m], rs[ai][m]);
#pragma unroll
        for (int ai = 0; ai < 2; ++ai)
#pragma unroll
            for (int m = 0; m < 4; ++m) {
                const int row = row0 + ai * HALF + m * 16;
#pragma unroll
                for (int bj = 0; bj < 2; ++bj) {
                    const int colt = bj * HALF + wc * 32 + 8 * fq;
                    f32x4 v0 = acc[ai][bj][m][0], v1 = acc[ai][bj][m][1];
                    v0 = (v0 - cc[bj][0] * mu[ai][m]) * rs[ai][m] + dd[bj][0]; v1 = (v1 - cc[bj][1] * mu[ai][m]) * rs[ai][m] + dd[bj][1];
                    if (pn < 8) {
                        const f32x4 c = *(const f32x4*)(cs + (size_t)row * 128 + (colt >> 1)), s = *(const f32x4*)(sn + (size_t)row * 128 + (colt >> 1));
                        const float sc = pn >= 4 ? 0.0625f : 1.0f;
                        f32x4 a, b;
                        a[0] = (v0[0] * c[0] - v0[1] * s[0]) * sc; a[1] = (v0[1] * c[0] + v0[0] * s[0]) * sc;
                        a[2] = (v0[2] * c[1] - v0[3] * s[1]) * sc; a[3] = (v0[3] * c[1] + v0[2] * s[1]) * sc;
                        b[0] = (v1[0] * c[2] - v1[1] * s[2]) * sc; b[1] = (v1[1] * c[2] + v1[0] * s[2]) * sc;
                        b[2] = (v1[2] * c[3] - v1[3] * s[3]) * sc; b[3] = (v1[3] * c[3] + v1[2] * s[3]) * sc;
                        v0 = a; v1 = b;
                    }
                    if (pn < 26) {
                        u32x4 w; w.x = cvt_pk_bf16(v0[0], v0[1]); w.y = cvt_pk_bf16(v0[2], v0[3]); w.z = cvt_pk_bf16(v1[0], v1[1]); w.w = cvt_pk_bf16(v1[2], v1[3]);
                        *(u32x4*)(P + (size_t)row * 6672 + pn * BM + colt) = w;
                    } else if (colt < 16) {
                        *(f32x4*)(DT + (size_t)row * 16 + colt) = v0; *(f32x4*)(DT + (size_t)row * 16 + colt + 4) = v1;
                    }
                }
            }
    }
};

struct EpiResLN {
    static constexpr bool PERM = false, AFTER_DRAIN = false;
    float* out; int ld; const float* stats; const float* gain; const float* bias; float alpha, s;
    __device__ __forceinline__ void operator()(const f32x4 (&acc)[2][2][4][2], const Unit& u, int wr, int wc, int fr, int fq) const {
        const int row0 = u.pm * BM + wr * 64 + fr, col0 = u.pn * BM + wc * 32 + 4 * fq;
#pragma unroll
        for (int bj = 0; bj < 2; ++bj)
#pragma unroll
            for (int n = 0; n < 2; ++n) {
                const f32x4 g = *(const f32x4*)(gain + col0 + bj * HALF + n * 16), b = *(const f32x4*)(bias + col0 + bj * HALF + n * 16);
#pragma unroll
                for (int ai = 0; ai < 2; ++ai)
#pragma unroll
                    for (int m = 0; m < 4; ++m) {
                        const int row = row0 + ai * HALF + m * 16;
                        const f32x2e st = *(const f32x2e*)(stats + 2 * (size_t)row);
                        float* p = out + (size_t)row * ld + col0 + bj * HALF + n * 16;
                        const f32x4 y = *(const f32x4*)p;
                        const f32x4 x = (y - st.x) * st.y * g + b;
                        *(f32x4*)p = x * alpha + acc[ai][bj][m][n] * s;
                    }
            }
    }
};

__device__ __forceinline__ void ld_bf8(const bf16_t* p, f32x4& a, f32x4& b) { const u32x4 w = *(const u32x4*)p;
    a = (f32x4){__uint_as_float(w.x << 16), __uint_as_float(w.x & 0xffff0000u), __uint_as_float(w.y << 16), __uint_as_float(w.y & 0xffff0000u)};
    b = (f32x4){__uint_as_float(w.z << 16), __uint_as_float(w.z & 0xffff0000u), __uint_as_float(w.w << 16), __uint_as_float(w.w & 0xffff0000u)}; }
__device__ __forceinline__ f32x4 ld_bf4(const bf16_t* p) { const u32x2 w = *(const u32x2*)p; return (f32x4){__uint_as_float(w.x << 16), __uint_as_float(w.x & 0xffff0000u), __uint_as_float(w.y << 16), __uint_as_float(w.y & 0xffff0000u)}; }
template <bool LNRES, int HS, bool RESBF = LNRES> struct EpiResEmit {
    static constexpr bool PERM = true, AFTER_DRAIN = false;
    const float* res; const bf16_t* resb; const float* rows_in; const float* gain; const float* bias; bf16_t* yb; float* rows_out;
    __device__ __forceinline__ void operator()(const f32x4 (&acc)[2][2][4][2], const Unit& u, int wr, int wc, int fr, int fq) const {
        constexpr int ld = 2048; constexpr float alpha = 1.189207115002721f, s = 0.5f * HS;
        const int row0 = u.pm * BM + wr * 64 + fr, col0 = u.pn * BM + wc * 32 + 8 * fq;
        f32x4 g[2][2], b[2][2];
#pragma unroll
        for (int bj = 0; bj < 2; ++bj)
#pragma unroll
            for (int n = 0; n < 2; ++n) { g[bj][n] = LNRES ? *(const f32x4*)(gain + col0 + bj * HALF + n * 4) : (f32x4){0.f, 0.f, 0.f, 0.f}; b[bj][n] = LNRES ? *(const f32x4*)(bias + col0 + bj * HALF + n * 4) : (f32x4){0.f, 0.f, 0.f, 0.f}; }
        f32x4 nx[2][2];
#pragma unroll
        for (int bj = 0; bj < 2; ++bj) { const size_t o = (size_t)row0 * ld + col0 + bj * HALF;
            if (RESBF) ld_bf8(resb + o, nx[bj][0], nx[bj][1]); else { nx[bj][0] = *(const f32x4*)(res + o); nx[bj][1] = *(const f32x4*)(res + o + 4); } }
#pragma unroll
        for (int ai = 0; ai < 2; ++ai)
#pragma unroll
            for (int m = 0; m < 4; ++m) {
                const int row = row0 + ai * HALF + m * 16;
                const size_t off0 = (size_t)row * ld + col0;
                f32x4 xv[2][2];
#pragma unroll
                for (int bj = 0; bj < 2; ++bj)
#pragma unroll
                    for (int n = 0; n < 2; ++n) xv[bj][n] = nx[bj][n];
                if (ai * 4 + m < 7) { const int nrow = row0 + ((ai * 4 + m + 1) >> 2) * HALF + ((ai * 4 + m + 1) & 3) * 16;
#pragma unroll
                    for (int bj = 0; bj < 2; ++bj) { const size_t o = (size_t)nrow * ld + col0 + bj * HALF;
                        if (RESBF) ld_bf8(resb + o, nx[bj][0], nx[bj][1]); else { nx[bj][0] = *(const f32x4*)(res + o); nx[bj][1] = *(const f32x4*)(res + o + 4); } } }
                float mu = 0.f, rs = 1.f; if (LNRES) row_stats(rows_in, row, mu, rs);
                float a1 = 0.f, a2 = 0.f;
#pragma unroll
                for (int bj = 0; bj < 2; ++bj) {
                    const size_t off = off0 + bj * HALF;
                    f32x4 x0 = xv[bj][0], x1 = xv[bj][1];
                    if (LNRES) { x0 = (x0 - mu) * rs * g[bj][0] + b[bj][0]; x1 = (x1 - mu) * rs * g[bj][1] + b[bj][1]; }
                    const f32x4 y0 = x0 * alpha + acc[ai][bj][m][0] * s, y1 = x1 * alpha + acc[ai][bj][m][1] * s;
                    u32x4 w; w.x = cvt_pk_bf16(y0[0], y0[1]); w.y = cvt_pk_bf16(y0[2], y0[3]); w.z = cvt_pk_bf16(y1[0], y1[1]); w.w = cvt_pk_bf16(y1[2], y1[3]);
                    *(u32x4*)(yb + off) = w;
                    a1 += ((y0[0] + y0[1]) + (y0[2] + y0[3])) + ((y1[0] + y1[1]) + (y1[2] + y1[3]));
                    a2 += ((y0[0] * y0[0] + y0[1] * y0[1]) + (y0[2] * y0[2] + y0[3] * y0[3])) + ((y1[0] * y1[0] + y1[1] * y1[1]) + (y1[2] * y1[2] + y1[3] * y1[3]));
                }
                a1 += __shfl_xor(a1, 16); a1 += __shfl_xor(a1, 32); a2 += __shfl_xor(a2, 16); a2 += __shfl_xor(a2, 32);
                if (fq == 0) { float* rp = rows_out + 2 * (size_t)row; atomicAdd(rp, a1); atomicAdd(rp + 1, a2); }
            }
    }
};
struct EpiResLN2 {
    static constexpr bool PERM = true, AFTER_DRAIN = false;
    const bf16_t* resb; const float* rows_in; const float* gain; const float* bias; bf16_t* yb;
    __device__ __forceinline__ void operator()(const f32x4 (&acc)[2][2][4][2], const Unit& u, int wr, int wc, int fr, int fq) const {
        constexpr int ld = 2048; constexpr float alpha = 1.189207115002721f, s = 0.5f;
        const int row0 = u.pm * BM + wr * 64 + fr, col0 = u.pn * BM + wc * 32 + 8 * fq;
        f32x4 g[2][2], b[2][2];
#pragma unroll
        for (int bj = 0; bj < 2; ++bj)
#pragma unroll
            for (int n = 0; n < 2; ++n) { g[bj][n] = *(const f32x4*)(gain + col0 + bj * HALF + n * 4); b[bj][n] = *(const f32x4*)(bias + col0 + bj * HALF + n * 4); }
        f32x4 nx[2][2];
#pragma unroll
        for (int bj = 0; bj < 2; ++bj) ld_bf8(resb + (size_t)row0 * ld + col0 + bj * HALF, nx[bj][0], nx[bj][1]);
#pragma unroll
        for (int ai = 0; ai < 2; ++ai)
#pragma unroll
            for (int m = 0; m < 4; ++m) {
                const int row = row0 + ai * HALF + m * 16; const bf16_t* p = resb + (size_t)row * ld + col0;
                f32x4 xv[2][2];
#pragma unroll
                for (int bj = 0; bj < 2; ++bj)
#pragma unroll
                    for (int n = 0; n < 2; ++n) xv[bj][n] = nx[bj][n];
                if (ai * 4 + m < 7) { const int nrow = row0 + ((ai * 4 + m + 1) >> 2) * HALF + ((ai * 4 + m + 1) & 3) * 16;
#pragma unroll
                    for (int bj = 0; bj < 2; ++bj) ld_bf8(resb + (size_t)nrow * ld + col0 + bj * HALF, nx[bj][0], nx[bj][1]); }
                float mu, rs; row_stats(rows_in, row, mu, rs);
#pragma unroll
                for (int bj = 0; bj < 2; ++bj) {
                    const f32x4 y0 = ((xv[bj][0] - mu) * rs * g[bj][0] + b[bj][0]) * alpha + acc[ai][bj][m][0] * s, y1 = ((xv[bj][1] - mu) * rs * g[bj][1] + b[bj][1]) * alpha + acc[ai][bj][m][1] * s;
                    u32x4 w; w.x = cvt_pk_bf16(y0[0], y0[1]); w.y = cvt_pk_bf16(y0[2], y0[3]); w.z = cvt_pk_bf16(y1[0], y1[1]); w.w = cvt_pk_bf16(y1[2], y1[3]);
                    *(u32x4*)(yb + (size_t)row * ld + col0 + bj * HALF) = w; }
                (void)p;
            }
    }
};
struct EpiSwigluLN {
    static constexpr bool PERM = true, AFTER_DRAIN = false;
    bf16_t* H; int ldh; const float* rows_in; const float* cv; const float* dv;
    __device__ __forceinline__ void operator()(const f32x4 (&acc)[2][2][4][2], const Unit& u, int wr, int wc, int fr, int fq) const {
        const int row0 = u.pm * BM + wr * 64 + fr, col0 = u.pn * 128 + wc * 32 + 8 * fq, ncol = u.pn * BM + wc * 32 + 8 * fq;
        const f32x4 cg0 = *(const f32x4*)(cv + ncol), cg1 = *(const f32x4*)(cv + ncol + 4), dg0 = *(const f32x4*)(dv + ncol), dg1 = *(const f32x4*)(dv + ncol + 4);
        const f32x4 cu0 = *(const f32x4*)(cv + ncol + HALF), cu1 = *(const f32x4*)(cv + ncol + HALF + 4), du0 = *(const f32x4*)(dv + ncol + HALF), du1 = *(const f32x4*)(dv + ncol + HALF + 4);
        float mu[2][4], rs[2][4];
#pragma unroll
        for (int ai = 0; ai < 2; ++ai)
#pragma unroll
            for (int m = 0; m < 4; ++m) row_stats(rows_in, row0 + ai * HALF + m * 16, mu[ai][m], rs[ai][m]);
#pragma unroll
        for (int ai = 0; ai < 2; ++ai)
#pragma unroll
            for (int m = 0; m < 4; ++m) {
                const int row = row0 + ai * HALF + m * 16; const float mm = mu[ai][m], rr = rs[ai][m];
                bf16_t* p = H + (size_t)row * ldh + col0;
                const f32x4 g0 = (acc[ai][0][m][0] - cg0 * mm) * rr + dg0, g1 = (acc[ai][0][m][1] - cg1 * mm) * rr + dg1;
                const f32x4 u0 = (acc[ai][1][m][0] - cu0 * mm) * rr + du0, u1 = (acc[ai][1][m][1] - cu1 * mm) * rr + du1;
                u32x4 w;
                w.x = cvt_pk_bf16(swi(g0[0], u0[0]), swi(g0[1], u0[1])); w.y = cvt_pk_bf16(swi(g0[2], u0[2]), swi(g0[3], u0[3]));
                w.z = cvt_pk_bf16(swi(g1[0], u1[0]), swi(g1[1], u1[1])); w.w = cvt_pk_bf16(swi(g1[2], u1[2]), swi(g1[3], u1[3]));
                *(u32x4*)p = w;
            }
    }
};
template <class Epi, class Sched, bool ALIGN_EPI = false, bool SP2 = false>
__device__ __forceinline__ void gemm_phase(PG8_LAS unsigned char* lds, const Gemm g, const Sched& S, const Epi& E) {
    int tid_o = threadIdx.x; asm volatile("" : "+v"(tid_o));
    const int tid = tid_o, wid = __builtin_amdgcn_readfirstlane(tid >> 6), lane = tid & 63, wr = wid >> 2, wc = wid & 3, fr = lane & 15, fq = lane >> 4;
    const int K = g.K, nt = K / BK;
    unsigned voffA[2], voffB[2];
#pragma unroll
    for (int i = 0; i < 2; ++i) { int R, C; stage_rc(tid * 16 + i * 8192, R, C); const int Rb = Epi::PERM ? ((R & ~31) + perm32(R & 31)) : R;
        voffA[i] = (unsigned)(R * K + C) * 2u; voffB[i] = (unsigned)(Rb * K + C) * 2u; }
    const size_t kstep = (size_t)(BK * 2);
    const size_t hstep = (size_t)HALF * K * 2;
    const size_t tstep = 2 * hstep;
    const unsigned ldsw = (unsigned)wid * 1024u;
    const int aoff = lds_byte(wr * 64 + fr, fq * 8), boff = lds_byte(wc * 32 + fr, fq * 8);
#define PG8_SA(b, h) (((b) * 2 + (h)) * HTB)
#define PG8_SB(b, h) ((4 + (b) * 2 + (h)) * HTB)
#define PG8_STAGE(bufoff, gbase, voff) do { _Pragma("unroll") for (int _i = 0; _i < 2; ++_i) \
        __builtin_amdgcn_global_load_lds((const unsigned*)((const char*)(gbase) + (voff)[_i]), (PG8_LAS unsigned*)(lds + (bufoff) + ldsw + _i * 8192), 16, 0, 0); } while (0)
#define PG8_LDA(dst, b, h) do { _Pragma("unroll") for (int m = 0; m < 4; ++m) _Pragma("unroll") for (int k = 0; k < 2; ++k) dst[m][k] = *(const PG8_LAS bf16x8*)(lds + PG8_SA(b, h) + aoff + m * 2048 + k * 1024); } while (0)
#define PG8_LDB(dst, b, h) do { _Pragma("unroll") for (int n = 0; n < 2; ++n) _Pragma("unroll") for (int k = 0; k < 2; ++k) dst[n][k] = *(const PG8_LAS bf16x8*)(lds + PG8_SB(b, h) + boff + n * 2048 + k * 1024); } while (0)
#define PG8_MMA(ai, bj, At, Bt) do { __builtin_amdgcn_s_setprio(1); _Pragma("unroll") for (int m = 0; m < 4; ++m) _Pragma("unroll") for (int n = 0; n < 2; ++n) _Pragma("unroll") for (int k = 0; k < 2; ++k) \
        acc[ai][bj][m][n] = __builtin_amdgcn_mfma_f32_16x16x32_bf16(Bt[n][k], At[m][k], acc[ai][bj][m][n], 0, 0, 0); __builtin_amdgcn_s_setprio(0); } while (0)
#define PG8_WAIT_V(n) asm volatile("s_waitcnt vmcnt(" #n ")" ::: "memory")
#define PG8_WAIT_L(n) asm volatile("s_waitcnt lgkmcnt(" #n ")" ::: "memory")
#define PG8_BAR __builtin_amdgcn_s_barrier()
#define PG8_SCHED __builtin_amdgcn_sched_barrier(0)
    Unit cur, nxt; int ui = 0;
    if (!S.next(0, cur)) return;
    f32x4 acc[2][2][4][2];
#pragma unroll
    for (int a = 0; a < 2; ++a)
#pragma unroll
        for (int b = 0; b < 2; ++b)
#pragma unroll
            for (int m = 0; m < 4; ++m)
#pragma unroll
                for (int n = 0; n < 2; ++n) acc[a][b][m][n] = (f32x4){0.f, 0.f, 0.f, 0.f};
    bf16x8 At[4][2], B0[2][2], B1[2][2];
    const char* cA = (const char*)g.A + (size_t)cur.pm * tstep; const char* cB = (const char*)g.Bt + (size_t)cur.pn * tstep;
    S.a_ready(cur);
    if constexpr (SP2) {
        PG8_STAGE(PG8_SB(0, 0), cB, voffB); PG8_STAGE(PG8_SB(0, 1), cB + hstep, voffB); PG8_STAGE(PG8_SA(0, 0), cA, voffA); PG8_STAGE(PG8_SA(0, 1), cA + hstep, voffA);
        if (wr == 1) PG8_BAR;
        PG8_WAIT_V(2); PG8_BAR;
        PG8_STAGE(PG8_SB(1, 0), cB + kstep, voffB); PG8_STAGE(PG8_SA(1, 0), cA + kstep, voffA); PG8_STAGE(PG8_SB(1, 1), cB + hstep + kstep, voffB);
        PG8_WAIT_V(6); PG8_BAR;
    } else {
        PG8_STAGE(PG8_SB(0, 0), cB, voffB); PG8_STAGE(PG8_SA(0, 0), cA, voffA); PG8_STAGE(PG8_SB(0, 1), cB + hstep, voffB); PG8_STAGE(PG8_SA(0, 1), cA + hstep, voffA);
        if (wr == 1) PG8_BAR;
        PG8_WAIT_V(4); PG8_BAR;
        PG8_STAGE(PG8_SB(1, 0), cB + kstep, voffB); PG8_STAGE(PG8_SA(1, 0), cA + kstep, voffA); PG8_STAGE(PG8_SB(1, 1), cB + hstep + kstep, voffB);
        PG8_WAIT_V(6); PG8_BAR;
    }
    for (;;) {
        const bool has_next = S.next(ui + 1, nxt);
        const char* nA = has_next ? (const char*)g.A + (size_t)nxt.pm * tstep : cA; const char* nB = has_next ? (const char*)g.Bt + (size_t)nxt.pn * tstep : cB;
        for (int t = 0; t < nt; t += 2) {
            const bool last = (t == nt - 2);
            const char* a1 = cA + (size_t)(t + 1) * kstep;
            const char* a2 = last ? nA : cA + (size_t)(t + 2) * kstep; const char* b2 = last ? nB : cB + (size_t)(t + 2) * kstep;
            const char* a3 = a2 + kstep; const char* b3 = b2 + kstep;
            if (last && has_next) S.a_ready(nxt);
            if constexpr (SP2) {
            PG8_LDB(B0, 0, 0); PG8_LDB(B1, 0, 1); PG8_SCHED; PG8_LDA(At, 0, 0); PG8_STAGE(PG8_SA(1, 1), a1 + hstep, voffA);
            PG8_WAIT_V(8); PG8_WAIT_L(0); PG8_BAR; PG8_MMA(0, 0, At, B0); PG8_MMA(0, 1, At, B1); PG8_BAR; PG8_SCHED;
            PG8_LDA(At, 0, 1); PG8_STAGE(PG8_SB(0, 0), b2, voffB); PG8_STAGE(PG8_SB(0, 1), b2 + hstep, voffB); PG8_STAGE(PG8_SA(0, 0), a2, voffA);
            PG8_WAIT_V(8); PG8_WAIT_L(0); PG8_BAR; PG8_MMA(1, 0, At, B0); PG8_MMA(1, 1, At, B1); PG8_BAR; PG8_SCHED;
            PG8_LDB(B0, 1, 0); PG8_LDB(B1, 1, 1); PG8_SCHED; PG8_LDA(At, 1, 0); PG8_STAGE(PG8_SA(0, 1), a2 + hstep, voffA);
            PG8_WAIT_V(8); PG8_WAIT_L(0); PG8_BAR; PG8_MMA(0, 0, At, B0); PG8_MMA(0, 1, At, B1); PG8_BAR; PG8_SCHED;
            PG8_LDA(At, 1, 1); PG8_STAGE(PG8_SB(1, 0), b3, voffB); PG8_STAGE(PG8_SB(1, 1), b3 + hstep, voffB); PG8_STAGE(PG8_SA(1, 0), a3, voffA);
            PG8_WAIT_V(8); PG8_WAIT_L(0); PG8_BAR; PG8_MMA(1, 0, At, B0); PG8_MMA(1, 1, At, B1); PG8_BAR; PG8_SCHED;
            } else {
            PG8_LDB(B0, 0, 0); PG8_SCHED; PG8_LDA(At, 0, 0); PG8_STAGE(PG8_SA(1, 1), a1 + hstep, voffA);
            PG8_WAIT_L(8); PG8_BAR; PG8_WAIT_L(0); PG8_MMA(0, 0, At, B0); PG8_BAR; PG8_SCHED;
            PG8_LDB(B1, 0, 1); PG8_STAGE(PG8_SB(0, 0), b2, voffB);
            PG8_BAR; PG8_WAIT_L(0); PG8_MMA(0, 1, At, B1); PG8_BAR;
            PG8_LDA(At, 0, 1); PG8_STAGE(PG8_SA(0, 0), a2, voffA);
            PG8_BAR; PG8_WAIT_L(0); PG8_MMA(1, 0, At, B0); PG8_BAR; PG8_SCHED;
            PG8_STAGE(PG8_SB(0, 1), b2 + hstep, voffB);
            PG8_WAIT_V(6); PG8_BAR; PG8_MMA(1, 1, At, B1); PG8_BAR;
            PG8_LDB(B0, 1, 0); PG8_SCHED; PG8_LDA(At, 1, 0); PG8_STAGE(PG8_SA(0, 1), a2 + hstep, voffA);
            PG8_WAIT_L(8); PG8_BAR; PG8_WAIT_L(0); PG8_MMA(0, 0, At, B0); PG8_BAR; PG8_SCHED;
            PG8_LDB(B1, 1, 1); PG8_STAGE(PG8_SB(1, 0), b3, voffB);
            PG8_BAR; PG8_WAIT_L(0); PG8_MMA(0, 1, At, B1); PG8_BAR;
            PG8_LDA(At, 1, 1); PG8_STAGE(PG8_SA(1, 0), a3, voffA);
            PG8_BAR; PG8_WAIT_L(0); PG8_MMA(1, 0, At, B0); PG8_BAR; PG8_SCHED;
            PG8_STAGE(PG8_SB(1, 1), b3 + hstep, voffB);
            PG8_WAIT_V(6); PG8_BAR; PG8_MMA(1, 1, At, B1); PG8_BAR;
            }
        }
        if constexpr (ALIGN_EPI) { if (wr == 0) PG8_BAR; }
        if constexpr (!Epi::AFTER_DRAIN) { E(acc, cur, wr, wc, fr, fq); S.done(cur); }
        if (!has_next) break;
#pragma unroll
        for (int a = 0; a < 2; ++a)
#pragma unroll
            for (int b = 0; b < 2; ++b)
#pragma unroll
                for (int m = 0; m < 4; ++m)
#pragma unroll
                    for (int n = 0; n < 2; ++n) acc[a][b][m][n] = (f32x4){0.f, 0.f, 0.f, 0.f};
        cur = nxt; cA = nA; cB = nB; ++ui;
        if constexpr (ALIGN_EPI) { if (wr == 1) PG8_BAR; }
    }
    PG8_WAIT_V(0);
    if constexpr (!ALIGN_EPI) { if (wr == 0) PG8_BAR; }
    PG8_BAR;
    if constexpr (Epi::AFTER_DRAIN) { E.fused(acc, cur, wr, wc, fr, fq, lds, wid, lane); S.done(cur); }
#undef PG8_SA
#undef PG8_SB
#undef PG8_STAGE
#undef PG8_LDA
#undef PG8_LDB
#undef PG8_MMA
#undef PG8_WAIT_V
#undef PG8_WAIT_L
#undef PG8_BAR
#undef PG8_SCHED
}
}

#define LAS __attribute__((address_space(3)))
typedef unsigned short bf16;
typedef unsigned u32x4 __attribute__((ext_vector_type(4)));
using pg8::u32x2;
typedef float f32x4 __attribute__((ext_vector_type(4)));
typedef short bf16x8 __attribute__((ext_vector_type(8)));

constexpr int NT = 512;
constexpr int M_TOK = 16384, SEQ = 8192, DM = 2048, DFF = 5632, NGU = 11264, NIN = 6672, NINP = 6912, PLD = 6672;
constexpr float LN_EPS = 1e-5f;
constexpr float ALPHA = 1.189207115002721f;
constexpr size_t MiB = (size_t)1 << 20;
constexpr size_t WS_RETS = 0, WS_SSDS = 128 * MiB, WS_WGU = 0, WS_WD = 44 * MiB, WS_WIN = 66 * MiB, WS_COS = 93 * MiB, WS_SIN = 101 * MiB,
                 WS_WOUT = 192 * MiB, WS_XB = 200 * MiB, WS_BIG = 264 * MiB, WS_DT = 473 * MiB, WS_TOT = 474 * MiB, WS_STATS = 474 * MiB + 65536, WS_CTL = 475 * MiB, WS_END = 476 * MiB;
constexpr size_t CTL_ZERO_BYTES = 512 * 1024, WS_ROWS1 = WS_CTL + 65536, WS_ROWS2 = WS_ROWS1 + 131072, WS_CD_IN = WS_ROWS2 + 131072, WS_CD_GU = WS_CD_IN + 65536;
constexpr size_t WS_Y2B = 66 * MiB;
constexpr int MISC_OFF = 152064;
constexpr int LDS_BYTES = 153600;

__device__ __forceinline__ float lo16(unsigned w) { return __uint_as_float(w << 16); }
__device__ __forceinline__ float hi16(unsigned w) { return __uint_as_float(w & 0xffff0000u); }
__device__ __forceinline__ float bf2f(bf16 h) { return __uint_as_float((unsigned)h << 16); }
__device__ __forceinline__ bf16 f2bf(float f) { unsigned u = __float_as_uint(f); return (bf16)((u + 0x7fffu + ((u >> 16) & 1u)) >> 16); }
__device__ __forceinline__ unsigned pk2(float a, float b) { return pg8::cvt_pk_bf16(a, b); }
__device__ __forceinline__ float wave_sum(float v) {
#pragma unroll
    for (int o = 1; o < 64; o <<= 1) v += __shfl_xor(v, o);
    return v;
}
__device__ __forceinline__ float silu_f(float x) { return x * __builtin_amdgcn_rcpf(1.0f + __expf(-x)); }
__device__ __forceinline__ f32x4 mma(bf16x8 y, bf16x8 x, f32x4 c) { return __builtin_amdgcn_mfma_f32_16x16x32_bf16(y, x, c, 0, 0, 0); }
__device__ __forceinline__ unsigned opaque0() { unsigned z; asm volatile("s_mov_b32 %0, 0" : "=s"(z)); return z; }
#define NT_LD(p) __builtin_nontemporal_load(p)
#define NT_ST(v, p) __builtin_nontemporal_store((v), (p))
#define LDS_WAIT() asm volatile("s_waitcnt lgkmcnt(0)" ::: "memory")
#define FRAG(p) (*(const LAS bf16x8*)(p))

template <bool FOLD>
__device__ __forceinline__ void xpose_item(const float* W, int Nsrc, int K, bf16* WT, int k0, int n0, int drow0, LAS float* scr, int lane, const float* gain = nullptr, const float* bias = nullptr, float* cd = nullptr, int ncd = 0) {
    const int c4 = lane & 7, kr = lane >> 3, nn4 = n0 + 4 * c4; const bool okn = nn4 < Nsrc;
    f32x4 cp = (f32x4){0.f, 0.f, 0.f, 0.f}, dp = cp;
    f32x4 wv[8];
#pragma unroll
    for (int i = 0; i < 8; ++i) { const int kk = 8 * i + kr; wv[i] = okn ? NT_LD((const f32x4*)(W + (size_t)(k0 + kk) * Nsrc + nn4)) : (f32x4){0.f, 0.f, 0.f, 0.f}; }
#pragma unroll
    for (int i = 0; i < 8; ++i) { const int kk = 8 * i + kr; f32x4 w = wv[i];
        if (FOLD) { const float bk = bias[k0 + kk], gk = gain[k0 + kk]; dp += w * bk; w = w * gk;
            cp[0] += __uint_as_float(pk2(w[0], 0.0f) << 16); cp[1] += __uint_as_float(pk2(w[1], 0.0f) << 16); cp[2] += __uint_as_float(pk2(w[2], 0.0f) << 16); cp[3] += __uint_as_float(pk2(w[3], 0.0f) << 16); }
        LAS float* d = scr + kk * 33 + 4 * c4; d[0] = w[0]; d[1] = w[1]; d[2] = w[2]; d[3] = w[3]; }
    if (FOLD) {
#pragma unroll
        for (int j = 0; j < 4; ++j) { float a = cp[j], b = dp[j]; a += __shfl_xor(a, 8); a += __shfl_xor(a, 16); a += __shfl_xor(a, 32); b += __shfl_xor(b, 8); b += __shfl_xor(b, 16); b += __shfl_xor(b, 32);
            if (kr == 0) { atomicAdd(cd + drow0 + 4 * c4 + j, a); atomicAdd(cd + ncd + drow0 + 4 * c4 + j, b); } } }
    LDS_WAIT();
    const int c = lane & 7;
#pragma unroll
    for (int j = 0; j < 4; ++j) { const int n = (lane >> 3) + 8 * j; const LAS float* s = scr + (8 * c) * 33 + n;
        u32x4 o; o.x = pk2(s[0 * 33], s[1 * 33]); o.y = pk2(s[2 * 33], s[3 * 33]); o.z = pk2(s[4 * 33], s[5 * 33]); o.w = pk2(s[6 * 33], s[7 * 33]);
        *(u32x4*)(WT + (size_t)(drow0 + n) * K + k0 + 8 * c) = o; }
    LDS_WAIT();
}
template <bool FOLD>
__device__ __forceinline__ void convert_ffn(const float* wg, const float* wu, const float* wd, bf16* WGU, bf16* WD, LAS float* scr, int gw, int NGW, int lane, const float* gain = nullptr, const float* bias = nullptr, float* cd = nullptr) {
    for (int it = gw; it < 3 * 5632; it += NGW) {
        int r = it;
        if (r < 2 * 5632) { const int up = r >= 5632 ? 1 : 0; r -= up * 5632; const int kb = r / 176, nb = r % 176, n0 = nb * 32;
            xpose_item<FOLD>(up ? wu : wg, DFF, DM, WGU, kb * 64, n0, 256 * (n0 >> 7) + (n0 & 127) + up * 128, scr, lane, gain, bias, cd, NGU); }
        else { r -= 2 * 5632; const int kb = r / 64, nb = r % 64; xpose_item<false>(wd, DM, DFF, WD, kb * 64, nb * 32, nb * 32, scr, lane); }
    }
}
template <bool WBF>
__device__ __forceinline__ void ln_rows(float* io, const float* gain, const float* bias, bf16* xb, float* stats, int gw, int NGW, int lane) {
    f32x4 nx[8];
    if (gw < M_TOK) { const f32x4* p0 = (const f32x4*)(io + (size_t)gw * DM) + lane;
#pragma unroll
        for (int j = 0; j < 8; ++j) nx[j] = NT_LD(p0 + 64 * j); }
#pragma unroll 1
    for (int row = gw; row < M_TOK; row += NGW) {
        f32x4* p = (f32x4*)(io + (size_t)row * DM) + lane;
        f32x4 v[8]; float s = 0.f;
#pragma unroll
        for (int j = 0; j < 8; ++j) { v[j] = nx[j]; s += (v[j][0] + v[j][1]) + (v[j][2] + v[j][3]); }
        if (row + NGW < M_TOK) { const f32x4* pn = (const f32x4*)(io + (size_t)(row + NGW) * DM) + lane;
#pragma unroll
            for (int j = 0; j < 8; ++j) nx[j] = NT_LD(pn + 64 * j); }
        const float mean = wave_sum(s) * (1.0f / DM); float s2 = 0.f;
#pragma unroll
        for (int j = 0; j < 8; ++j) { v[j] = v[j] - mean; s2 += (v[j][0] * v[j][0] + v[j][1] * v[j][1]) + (v[j][2] * v[j][2] + v[j][3] * v[j][3]); }
        const float rstd = 1.0f / sqrtf(wave_sum(s2) * (1.0f / DM) + LN_EPS);
#pragma unroll
        for (int j = 0; j < 8; ++j) {
            const f32x4 g = ((const f32x4*)gain)[lane + 64 * j], b = ((const f32x4*)bias)[lane + 64 * j];
            const f32x4 o = v[j] * rstd * g + b;
            if (!WBF) NT_ST(o, p + 64 * j);
            if (WBF) { u32x2 w; w.x = pk2(o[0], o[1]); w.y = pk2(o[2], o[3]); ((u32x2*)(xb + (size_t)row * DM))[lane + 64 * j] = w; }
        }
        if (WBF && lane == 0) { stats[2 * (size_t)row] = mean; stats[2 * (size_t)row + 1] = rstd; }
    }
}

__device__ __forceinline__ void ln3_rows(const bf16* yb, float* out, const float* gain, const float* bias, int gw, int NGW, int lane) {
    u32x4 nx[4];
    if (gw < M_TOK) { const u32x4* p0 = (const u32x4*)(yb + (size_t)gw * DM) + lane;
#pragma unroll
        for (int j = 0; j < 4; ++j) nx[j] = NT_LD(p0 + 64 * j); }
#pragma unroll 1
    for (int row = gw; row < M_TOK; row += NGW) {
        f32x4 v[8]; float s = 0.f;
#pragma unroll
        for (int j = 0; j < 4; ++j) { const u32x4 w = nx[j];
            v[2 * j] = (f32x4){lo16(w.x), hi16(w.x), lo16(w.y), hi16(w.y)}; v[2 * j + 1] = (f32x4){lo16(w.z), hi16(w.z), lo16(w.w), hi16(w.w)};
            s += ((v[2 * j][0] + v[2 * j][1]) + (v[2 * j][2] + v[2 * j][3])) + ((v[2 * j + 1][0] + v[2 * j + 1][1]) + (v[2 * j + 1][2] + v[2 * j + 1][3])); }
        if (row + NGW < M_TOK) { const u32x4* pn = (const u32x4*)(yb + (size_t)(row + NGW) * DM) + lane;
#pragma unroll
            for (int j = 0; j < 4; ++j) nx[j] = NT_LD(pn + 64 * j); }
        const float mean = wave_sum(s) * (1.0f / DM); float s2 = 0.f;
#pragma unroll
        for (int k = 0; k < 8; ++k) { v[k] = v[k] - mean; s2 += (v[k][0] * v[k][0] + v[k][1] * v[k][1]) + (v[k][2] * v[k][2] + v[k][3] * v[k][3]); }
        const float rstd = 1.0f / sqrtf(wave_sum(s2) * (1.0f / DM) + LN_EPS);
        f32x4* po = (f32x4*)(out + (size_t)row * DM);
#pragma unroll
        for (int j = 0; j < 4; ++j) {
            const int e4 = 2 * (lane + 64 * j);
            const f32x4 g0 = ((const f32x4*)gain)[e4], g1 = ((const f32x4*)gain)[e4 + 1], b0 = ((const f32x4*)bias)[e4], b1 = ((const f32x4*)bias)[e4 + 1];
            NT_ST(v[2 * j] * rstd * g0 + b0, po + e4); NT_ST(v[2 * j + 1] * rstd * g1 + b1, po + e4 + 1);
        }
    }
}

__device__ __forceinline__ void conv8(const bf16* PROJ, const float* cw, const float* cb, size_t tokrow, int t, int ch, f32x4& a0, f32x4& a1) {
    a0 = *(const f32x4*)(cb + ch); a1 = *(const f32x4*)(cb + ch + 4);
#pragma unroll
    for (int k = 0; k < 4; ++k) {
        if (t - 3 + k >= 0) {
            const u32x4 raw = *(const u32x4*)(PROJ + (tokrow - 3 + k) * PLD + 5120 + ch);
            const f32x4 w0 = *(const f32x4*)(cw + k * 1536 + ch), w1 = *(const f32x4*)(cw + k * 1536 + ch + 4);
            a0[0] += w0[0] * lo16(raw.x); a0[1] += w0[1] * hi16(raw.x); a0[2] += w0[2] * lo16(raw.y); a0[3] += w0[3] * hi16(raw.y);
            a1[0] += w1[0] * lo16(raw.z); a1[1] += w1[1] * hi16(raw.z); a1[2] += w1[2] * lo16(raw.w); a1[3] += w1[3] * hi16(raw.w);
        }
    }
#pragma unroll
    for (int i = 0; i < 4; ++i) { a0[i] = silu_f(a0[i]); a1[i] = silu_f(a1[i]); }
}
__device__ __forceinline__ void dt_acum(const float* DT, const float* dt_bias, const float* a_log, size_t tok0, int head, int lane, float& dt, float& ac) {
    const float x = DT[(tok0 + lane) * 16 + head] + dt_bias[head];
    dt = x > 20.0f ? x : log1pf(expf(x));
    float s = dt * (-expf(a_log[head]));
#pragma unroll
    for (int o = 1; o < 64; o <<= 1) { const float t = __shfl_up(s, o); if (lane >= o) s += t; }
    ac = s;
}

template <int I> __device__ __forceinline__ float bfel(const u32x4& w) { const unsigned x = (I >> 1) == 0 ? w.x : (I >> 1) == 1 ? w.y : (I >> 1) == 2 ? w.z : w.w; return (I & 1) ? hi16(x) : lo16(x); }
template <int I> __device__ __forceinline__ void xp_row(const u32x4 (&raw)[8], const float (&sc)[8], LAS bf16* dst, int stride) {
    u32x4 w; w.x = pk2(bfel<I>(raw[0]) * sc[0], bfel<I>(raw[1]) * sc[1]); w.y = pk2(bfel<I>(raw[2]) * sc[2], bfel<I>(raw[3]) * sc[3]);
    w.z = pk2(bfel<I>(raw[4]) * sc[4], bfel<I>(raw[5]) * sc[5]); w.w = pk2(bfel<I>(raw[6]) * sc[6], bfel<I>(raw[7]) * sc[7]);
    *(LAS u32x4*)(dst + I * stride) = w;
}
__device__ __forceinline__ void xpose8_store(const u32x4 (&raw)[8], const float (&sc)[8], LAS bf16* dst, int stride) {
    xp_row<0>(raw, sc, dst, stride); xp_row<1>(raw, sc, dst, stride); xp_row<2>(raw, sc, dst, stride); xp_row<3>(raw, sc, dst, stride);
    xp_row<4>(raw, sc, dst, stride); xp_row<5>(raw, sc, dst, stride); xp_row<6>(raw, sc, dst, stride); xp_row<7>(raw, sc, dst, stride);
}
__device__ __forceinline__ void conv_tile8(const bf16* PROJ, const float* cw, const float* cb, size_t tok0, int t0, int tg, int chn, f32x4 (&o0)[8], f32x4 (&o1)[8]) {
    u32x4 rw[11];
#pragma unroll
    for (int k = 0; k < 11; ++k) {
        const int tt = t0 + tg * 8 - 3 + k; const bool ok = tt >= 0; const int rel = ok ? (tg * 8 + k - 3) : -t0;
        const u32x4 v = *(const u32x4*)(PROJ + (size_t)((long)tok0 + rel) * PLD + 5120 + chn);
        rw[k].x = ok ? v.x : 0u; rw[k].y = ok ? v.y : 0u; rw[k].z = ok ? v.z : 0u; rw[k].w = ok ? v.w : 0u; }
    f32x4 w0[4], w1[4];
#pragma unroll
    for (int k = 0; k < 4; ++k) { w0[k] = *(const f32x4*)(cw + k * 1536 + chn); w1[k] = *(const f32x4*)(cw + k * 1536 + chn + 4); }
    const f32x4 b0 = *(const f32x4*)(cb + chn), b1 = *(const f32x4*)(cb + chn + 4);
#pragma unroll
    for (int r = 0; r < 8; ++r) {
        f32x4 a0 = b0, a1 = b1;
#pragma unroll
        for (int k = 0; k < 4; ++k) { const u32x4 x = rw[r + k];
            a0[0] += w0[k][0] * lo16(x.x); a0[1] += w0[k][1] * hi16(x.x); a0[2] += w0[k][2] * lo16(x.y); a0[3] += w0[k][3] * hi16(x.y);
            a1[0] += w1[k][0] * lo16(x.z); a1[1] += w1[k][1] * hi16(x.z); a1[2] += w1[k][2] * lo16(x.w); a1[3] += w1[k][3] * hi16(x.w); }
#pragma unroll
        for (int i = 0; i < 4; ++i) { a0[i] = silu_f(a0[i]); a1[i] = silu_f(a1[i]); }
        o0[r] = a0; o1[r] = a1;
    }
}
template <int I> __device__ __forceinline__ void ct_row(const f32x4 (&o0)[8], const f32x4 (&o1)[8], const float (&sc)[8], LAS bf16* dst, int stride) {
    float v[8];
#pragma unroll
    for (int r = 0; r < 8; ++r) v[r] = (I < 4 ? o0[r][I & 3] : o1[r][I & 3]) * sc[r];
    u32x4 w; w.x = pk2(v[0], v[1]); w.y = pk2(v[2], v[3]); w.z = pk2(v[4], v[5]); w.w = pk2(v[6], v[7]);
    *(LAS u32x4*)(dst + I * stride) = w;
}
__device__ __forceinline__ void conv_store_t(const f32x4 (&o0)[8], const f32x4 (&o1)[8], const float (&sc)[8], LAS bf16* dst, int stride) {
    ct_row<0>(o0, o1, sc, dst, stride); ct_row<1>(o0, o1, sc, dst, stride); ct_row<2>(o0, o1, sc, dst, stride); ct_row<3>(o0, o1, sc, dst, stride);
    ct_row<4>(o0, o1, sc, dst, stride); ct_row<5>(o0, o1, sc, dst, stride); ct_row<6>(o0, o1, sc, dst, stride); ct_row<7>(o0, o1, sc, dst, stride);
}

__device__ __forceinline__ void ret_a_unit(LAS unsigned char* lds, const bf16* PROJ, bf16* RETS, int b, int z, int h, int tid, bool P5_DO_STORE = true) {
    asm volatile("" : "+v"(tid));
    const int wave = tid >> 6, lane = tid & 63, l15 = lane & 15, l4 = lane >> 4;
    const size_t tok0 = (size_t)b * SEQ + (size_t)z * 64;
    const float lg2 = log2f(1.0f - exp2f(-5.0f - (float)h));
    LAS bf16* Kt = (LAS bf16*)lds;
    LAS bf16* Vt = (LAS bf16*)(lds + 36864);
    {
        const int mat = tid >> 8, ch = (tid >> 3) & 31, tg = tid & 7;
        u32x4 raw[8]; float sc[8];
#pragma unroll
        for (int r = 0; r < 8; ++r) raw[r] = *(const u32x4*)(PROJ + (tok0 + tg * 8 + r) * PLD + (mat ? 2048 : 1024) + h * 256 + ch * 8);
#pragma unroll
        for (int r = 0; r < 8; ++r) sc[r] = mat ? 1.0f : exp2f(lg2 * (float)(63 - (tg * 8 + r)));
        xpose8_store(raw, sc, (mat ? Vt : Kt) + (ch * 8) * 72 + tg * 8, 72);
    }
    __syncthreads();
#ifdef DBG_LDS
#define DBG_CHECK(slot) { int bad = 0; \
    for (int it = 0; it < 8; ++it) { const int q = it * NT + tid, j = q & 63, ch = (q >> 6) & 31, mat = q >> 11; \
        const u32x4 raw = *(const u32x4*)(PROJ + (tok0 + j) * PLD + (mat ? 2048 : 1024) + h * 256 + ch * 8); \
        const float sc = mat ? 1.0f : exp2f(lg2 * (float)(63 - j)); \
        volatile LAS bf16* dst = (mat ? Vt : Kt) + (ch * 8) * 72 + j; \
        bad += (dst[0 * 72] != f2bf(lo16(raw.x) * sc)) + (dst[1 * 72] != f2bf(hi16(raw.x) * sc)) + (dst[2 * 72] != f2bf(lo16(raw.y) * sc)) + (dst[3 * 72] != f2bf(hi16(raw.y) * sc)) \
             + (dst[4 * 72] != f2bf(lo16(raw.z) * sc)) + (dst[5 * 72] != f2bf(hi16(raw.z) * sc)) + (dst[6 * 72] != f2bf(lo16(raw.w) * sc)) + (dst[7 * 72] != f2bf(hi16(raw.w) * sc)); } \
    (RETS + (size_t)200 * 1024 * 1024 / 2)[(size_t)((b * 128 + z) * 4 + h) * 1024 + (slot) * 512 + tid] = f2bf(1000.0f * (float)bad); }
    DBG_CHECK(0)
#endif
    bf16* out = RETS + ((size_t)((b * 4 + h) * 128 + z)) * 65536;
#pragma unroll 1
    for (int dh = 0; dh < 2; ++dh) {
        f32x4 acc[2][8];
#pragma unroll
        for (int mt = 0; mt < 2; ++mt)
#pragma unroll
            for (int nt = 0; nt < 8; ++nt) acc[mt][nt] = (f32x4){0.f, 0.f, 0.f, 0.f};
#pragma unroll
        for (int ks = 0; ks < 2; ++ks) {
            bf16x8 xa[2];
#pragma unroll
            for (int mt = 0; mt < 2; ++mt) xa[mt] = FRAG(Vt + (32 * wave + 16 * mt + l15) * 72 + ks * 32 + 8 * l4);
#pragma unroll
            for (int nt = 0; nt < 8; ++nt) { const bf16x8 yb = FRAG(Kt + (128 * dh + 64 * (nt >> 2) + 16 * (l15 >> 2) + 4 * (nt & 3) + (l15 & 3)) * 72 + ks * 32 + 8 * l4);
#pragma unroll
                for (int mt = 0; mt < 2; ++mt) acc[mt][nt] = mma(yb, xa[mt], acc[mt][nt]); }
        }
#pragma unroll
        for (int mt = 0; mt < 2; ++mt)
#pragma unroll
            for (int gq = 0; gq < 2; ++gq) { const int e = 32 * wave + 16 * mt + l15, d = 128 * dh + 64 * gq + 16 * l4;
#pragma unroll
                for (int hh = 0; hh < 2; ++hh) { const f32x4 a = acc[mt][4 * gq + 2 * hh], c = acc[mt][4 * gq + 2 * hh + 1];
                    u32x4 w; w.x = pk2(a[0], a[1]); w.y = pk2(a[2], a[3]); w.z = pk2(c[0], c[1]); w.w = pk2(c[2], c[3]); if (P5_DO_STORE) *(u32x4*)(out + e * 256 + d + 8 * hh) = w; } }
    }
#ifdef DBG_LDS
    DBG_CHECK(1)
#endif
    __syncthreads();
}

__device__ __forceinline__ void ret_a_block(LAS unsigned char* lds, const bf16* PROJ, bf16* RETS, int bx, int G, int tid) {
    asm volatile("" : "+v"(tid));
    const int wave = tid >> 6, lane = tid & 63, l15 = lane & 15, l4 = lane >> 4;
    LAS bf16* Kt = (LAS bf16*)lds;
    LAS bf16* Vt = (LAS bf16*)(lds + 36864);
    const int mat = tid >> 8, ch = (tid >> 3) & 31, tg = tid & 7;
    u32x4 raw[8];
    int u = bx;
    if (u < 1024) { const int b = u >> 9, z = (u >> 2) & 127, h = u & 3; const size_t tok0 = (size_t)b * SEQ + (size_t)z * 64;
#pragma unroll
        for (int r = 0; r < 8; ++r) raw[r] = *(const u32x4*)(PROJ + (tok0 + tg * 8 + r) * PLD + (mat ? 2048 : 1024) + h * 256 + ch * 8); }
#pragma unroll 1
    for (; u < 1024; u += G) {
        const int b = u >> 9, z = (u >> 2) & 127, h = u & 3;
        const float lg2 = log2f(1.0f - exp2f(-5.0f - (float)h));
        { float sc[8];
#pragma unroll
          for (int r = 0; r < 8; ++r) sc[r] = mat ? 1.0f : exp2f(lg2 * (float)(63 - (tg * 8 + r)));
          xpose8_store(raw, sc, (mat ? Vt : Kt) + (ch * 8) * 72 + tg * 8, 72); }
        __syncthreads();
        { const int un = u + G;
          if (un < 1024) { const int bn = un >> 9, zn = (un >> 2) & 127, hn = un & 3; const size_t tokn = (size_t)bn * SEQ + (size_t)zn * 64;
#pragma unroll
            for (int r = 0; r < 8; ++r) raw[r] = *(const u32x4*)(PROJ + (tokn + tg * 8 + r) * PLD + (mat ? 2048 : 1024) + hn * 256 + ch * 8); } }
        bf16* out = RETS + ((size_t)((b * 4 + h) * 128 + z)) * 65536;
#pragma unroll 1
        for (int dh = 0; dh < 2; ++dh) {
            f32x4 acc[2][8];
#pragma unroll
            for (int mt = 0; mt < 2; ++mt)
#pragma unroll
                for (int nt = 0; nt < 8; ++nt) acc[mt][nt] = (f32x4){0.f, 0.f, 0.f, 0.f};
#pragma unroll
            for (int ks = 0; ks < 2; ++ks) {
                bf16x8 xa[2];
#pragma unroll
                for (int mt = 0; mt < 2; ++mt) xa[mt] = FRAG(Vt + (32 * wave + 16 * mt + l15) * 72 + ks * 32 + 8 * l4);
#pragma unroll
                for (int nt = 0; nt < 8; ++nt) { const bf16x8 yb = FRAG(Kt + (128 * dh + 64 * (nt >> 2) + 16 * (l15 >> 2) + 4 * (nt & 3) + (l15 & 3)) * 72 + ks * 32 + 8 * l4);
#pragma unroll
                    for (int mt = 0; mt < 2; ++mt) acc[mt][nt] = mma(yb, xa[mt], acc[mt][nt]); }
            }
#pragma unroll
            for (int mt = 0; mt < 2; ++mt)
#pragma unroll
                for (int gq = 0; gq < 2; ++gq) { const int e = 32 * wave + 16 * mt + l15, d = 128 * dh + 64 * gq + 16 * l4;
#pragma unroll
                    for (int hh = 0; hh < 2; ++hh) { const f32x4 a = acc[mt][4 * gq + 2 * hh], c = acc[mt][4 * gq + 2 * hh + 1];
                        u32x4 w; w.x = pk2(a[0], a[1]); w.y = pk2(a[2], a[3]); w.z = pk2(c[0], c[1]); w.w = pk2(c[2], c[3]); *(u32x4*)(out + e * 256 + d + 8 * hh) = w; } }
        }
        __syncthreads();
    }
}

__device__ __forceinline__ void ssd_a_unit(LAS unsigned char* lds, const bf16* PROJ, const float* DT, const float* cw, const float* cb, const float* dt_bias, const float* a_log,
                                           bf16* SSDS, float* TOT, int b, int z, int g, int tid, bool P5_DO_STORE = true) {
    asm volatile("" : "+v"(tid));
    const int wave = tid >> 6, lane = tid & 63, l15 = lane & 15, l4 = lane >> 4;
    const size_t tok0 = (size_t)b * SEQ + (size_t)z * 64;
    LAS bf16* Bt = (LAS bf16*)lds;
    LAS bf16* Xt = (LAS bf16*)(lds + 18432);
    LAS float* coef = (LAS float*)(lds + 92160);
    { float dt, ac; dt_acum(DT, dt_bias, a_log, tok0, g * 8 + wave, lane, dt, ac); const float last = __shfl(ac, 63);
      coef[wave * 64 + lane] = dt * expf(last - ac); if (lane == 63) TOT[(size_t)(b * 128 + z) * 16 + g * 8 + wave] = expf(last); }
    __syncthreads();
    {
        const int chx = tid >> 3, tg = tid & 7; f32x4 o0[8], o1[8]; float sc[8];
        conv_tile8(PROJ, cw, cb, tok0, z * 64, tg, g * 512 + chx * 8, o0, o1);
#pragma unroll
        for (int r = 0; r < 8; ++r) sc[r] = coef[(chx >> 3) * 64 + tg * 8 + r];
        conv_store_t(o0, o1, sc, Xt + (chx * 8) * 72 + tg * 8, 72);
    }
    if (tid < 128) {
        const int chb = tid >> 3, tg = tid & 7; f32x4 o0[8], o1[8]; float sc[8];
        conv_tile8(PROJ, cw, cb, tok0, z * 64, tg, 1024 + g * 128 + chb * 8, o0, o1);
#pragma unroll
        for (int r = 0; r < 8; ++r) sc[r] = 1.0f;
        conv_store_t(o0, o1, sc, Bt + (chb * 8) * 72 + tg * 8, 72);
    }
    __syncthreads();
    bf16* out = SSDS + ((size_t)((b * 16 + g * 8 + wave) * 128 + z)) * 8192;
#pragma unroll 1
    for (int nh = 0; nh < 2; ++nh) {
        f32x4 acc[4][4];
#pragma unroll
        for (int mt = 0; mt < 4; ++mt)
#pragma unroll
            for (int nt = 0; nt < 4; ++nt) acc[mt][nt] = (f32x4){0.f, 0.f, 0.f, 0.f};
#pragma unroll
        for (int ks = 0; ks < 2; ++ks) {
            bf16x8 xa[4];
#pragma unroll
            for (int mt = 0; mt < 4; ++mt) xa[mt] = FRAG(Xt + (64 * wave + 16 * mt + l15) * 72 + ks * 32 + 8 * l4);
#pragma unroll
            for (int nt = 0; nt < 4; ++nt) { const bf16x8 yb = FRAG(Bt + (64 * nh + 16 * (l15 >> 2) + 4 * nt + (l15 & 3)) * 72 + ks * 32 + 8 * l4);
#pragma unroll
                for (int mt = 0; mt < 4; ++mt) acc[mt][nt] = mma(yb, xa[mt], acc[mt][nt]); }
        }
#pragma unroll
        for (int mt = 0; mt < 4; ++mt)
#pragma unroll
            for (int hh = 0; hh < 2; ++hh) { const int p = 16 * mt + l15, n = 64 * nh + 16 * l4 + 8 * hh; const f32x4 a = acc[mt][2 * hh], c = acc[mt][2 * hh + 1];
                u32x4 w; w.x = pk2(a[0], a[1]); w.y = pk2(a[2], a[3]); w.z = pk2(c[0], c[1]); w.w = pk2(c[2], c[3]); if (P5_DO_STORE) *(u32x4*)(out + p * 128 + n) = w; }
    }
    __syncthreads();
}

__device__ __forceinline__ void scan_phase(bf16* RETS, bf16* SSDS, const float* TOT, int gtid, int nth) {
    for (int task = gtid; task < 98304; task += nth) {
        bf16* base; size_t stride; float cdec = 0.f; const float* totp = nullptr;
        if (task < 65536) { const int bh = task >> 13, e8 = task & 8191; base = RETS + (size_t)bh * 128 * 65536 + (size_t)e8 * 8; stride = 65536;
            cdec = exp2f(64.0f * log2f(1.0f - exp2f(-5.0f - (float)(bh & 3)))); }
        else { const int t2 = task - 65536, bhd = t2 >> 10, e8 = t2 & 1023; base = SSDS + (size_t)bhd * 128 * 8192 + (size_t)e8 * 8; stride = 8192;
            totp = TOT + (size_t)(bhd >> 4) * 128 * 16 + (bhd & 15); }
        float s0 = 0.f, s1 = 0.f, s2 = 0.f, s3 = 0.f, s4 = 0.f, s5 = 0.f, s6 = 0.f, s7 = 0.f;
        u32x4 nv[8]; float ndec[8];
#pragma unroll
        for (int i = 0; i < 8; ++i) { nv[i] = NT_LD((const u32x4*)(base + (size_t)i * stride)); ndec[i] = totp ? totp[i * 16] : cdec; }
#pragma unroll 1
        for (int z0 = 0; z0 < 128; z0 += 8) {
            u32x4 v[8]; float dec[8];
#pragma unroll
            for (int i = 0; i < 8; ++i) { v[i] = nv[i]; dec[i] = ndec[i]; }
            if (z0 + 8 < 128) {
#pragma unroll
                for (int i = 0; i < 8; ++i) { nv[i] = NT_LD((const u32x4*)(base + (size_t)(z0 + 8 + i) * stride)); ndec[i] = totp ? totp[(z0 + 8 + i) * 16] : cdec; } }
#pragma unroll
            for (int i = 0; i < 8; ++i) {
                u32x4 o; o.x = pk2(s0, s1); o.y = pk2(s2, s3); o.z = pk2(s4, s5); o.w = pk2(s6, s7);
                *(u32x4*)(base + (size_t)(z0 + i) * stride) = o;
                const float d = dec[i];
                s0 = s0 * d + lo16(v[i].x); s1 = s1 * d + hi16(v[i].x); s2 = s2 * d + lo16(v[i].y); s3 = s3 * d + hi16(v[i].y);
                s4 = s4 * d + lo16(v[i].z); s5 = s5 * d + hi16(v[i].z); s6 = s6 * d + lo16(v[i].w); s7 = s7 * d + hi16(v[i].w);
            }
        }
    }
}

__device__ __forceinline__ void ret_c_unit(LAS unsigned char* lds, const bf16* PROJ, const bf16* RETS, const float* gn_g, const float* gn_b, bf16* MIX, int b, int z, int h, int tid) {
    asm volatile("" : "+v"(tid));
    const int wave = tid >> 6, lane = tid & 63, l15 = lane & 15, l4 = lane >> 4;
    const size_t tok0 = (size_t)b * SEQ + (size_t)z * 64;
    const float lg2 = log2f(1.0f - exp2f(-5.0f - (float)h));
    LAS bf16* Q = (LAS bf16*)lds;
    LAS bf16* Kn = (LAS bf16*)(lds + 33792);
    LAS bf16* Vt = (LAS bf16*)(lds + 67584);
    LAS bf16* Pm = (LAS bf16*)(lds + 104448);
    LAS float* st1 = (LAS float*)(lds + 113664);
    LAS float* st2 = (LAS float*)(lds + 115712);
    {
        u32x4 qk[8];
#pragma unroll
        for (int it = 0; it < 8; ++it) { const int q = it * NT + tid, ch = q & 31, j = (q >> 5) & 63, mat = q >> 11; qk[it] = *(const u32x4*)(PROJ + (tok0 + j) * PLD + mat * 1024 + h * 256 + ch * 8); }
        if (tid < 256) {
            const int ch = tid >> 3, tg = tid & 7; u32x4 raw[8]; float sc[8];
#pragma unroll
            for (int r = 0; r < 8; ++r) { raw[r] = *(const u32x4*)(PROJ + (tok0 + tg * 8 + r) * PLD + 2048 + h * 256 + ch * 8); sc[r] = 1.0f; }
            xpose8_store(raw, sc, Vt + (ch * 8) * 72 + tg * 8, 72);
        }
#pragma unroll
        for (int it = 0; it < 8; ++it) { const int q = it * NT + tid, ch = q & 31, j = (q >> 5) & 63, mat = q >> 11; *(LAS u32x4*)((mat ? Kn : Q) + j * 264 + ch * 8) = qk[it]; }
    }
    __syncthreads();
    {
        const int mt = wave >> 1, nt0 = 2 * (wave & 1);
        f32x4 sc[2] = {(f32x4){0.f, 0.f, 0.f, 0.f}, (f32x4){0.f, 0.f, 0.f, 0.f}};
#pragma unroll
        for (int ks = 0; ks < 8; ++ks) {
            const bf16x8 xa = FRAG(Q + (16 * mt + l15) * 264 + ks * 32 + 8 * l4);
#pragma unroll
            for (int n2 = 0; n2 < 2; ++n2) { const bf16x8 yb = FRAG(Kn + (16 * (nt0 + n2) + l15) * 264 + ks * 32 + 8 * l4); sc[n2] = mma(yb, xa, sc[n2]); }
        }
#pragma unroll
        for (int n2 = 0; n2 < 2; ++n2) {
            const int i = 16 * mt + l15 + (int)opaque0(), j0 = 16 * (nt0 + n2) + 4 * l4; float p[4];
#pragma unroll
            for (int ii = 0; ii < 4; ++ii) { const int j = j0 + ii; p[ii] = (j <= i) ? sc[n2][ii] * exp2f(lg2 * (float)(i - j)) : 0.0f; }
            u32x2 w; w.x = pk2(p[0], p[1]); w.y = pk2(p[2], p[3]); *(LAS u32x2*)(Pm + i * 72 + j0) = w;
        }
    }
    __syncthreads();
    f32x4 acc[4][2];
#pragma unroll
    for (int mt = 0; mt < 4; ++mt)
#pragma unroll
        for (int nt = 0; nt < 2; ++nt) acc[mt][nt] = (f32x4){0.f, 0.f, 0.f, 0.f};
    const bf16* S = RETS + ((size_t)((b * 4 + h) * 128 + z)) * 65536;
#pragma unroll
    for (int ks = 0; ks < 8; ++ks) {
        bf16x8 yb[2];
#pragma unroll
        for (int nt = 0; nt < 2; ++nt) yb[nt] = NT_LD((const bf16x8*)(S + (32 * wave + 8 * (l15 >> 2) + 4 * nt + (l15 & 3)) * 256 + ks * 32 + 8 * l4));
#pragma unroll
        for (int mt = 0; mt < 4; ++mt) { const bf16x8 xa = FRAG(Q + (16 * mt + l15) * 264 + ks * 32 + 8 * l4);
#pragma unroll
            for (int nt = 0; nt < 2; ++nt) acc[mt][nt] = mma(yb[nt], xa, acc[mt][nt]); }
    }
#pragma unroll
    for (int mt = 0; mt < 4; ++mt) { const float qd = exp2f(lg2 * (float)(16 * mt + l15 + 1));
#pragma unroll
        for (int nt = 0; nt < 2; ++nt) acc[mt][nt] = acc[mt][nt] * qd; }
#pragma unroll
    for (int ks = 0; ks < 2; ++ks) {
        bf16x8 yb[2];
#pragma unroll
        for (int nt = 0; nt < 2; ++nt) yb[nt] = FRAG(Vt + (32 * wave + 8 * (l15 >> 2) + 4 * nt + (l15 & 3)) * 72 + ks * 32 + 8 * l4);
#pragma unroll
        for (int mt = 0; mt < 4; ++mt) { const bf16x8 xa = FRAG(Pm + (16 * mt + l15) * 72 + ks * 32 + 8 * l4);
#pragma unroll
            for (int nt = 0; nt < 2; ++nt) acc[mt][nt] = mma(yb[nt], xa, acc[mt][nt]); }
    }
#pragma unroll
    for (int mt = 0; mt < 4; ++mt) {
        float s = 0.f;
#pragma unroll
        for (int nt = 0; nt < 2; ++nt) s += (acc[mt][nt][0] + acc[mt][nt][1]) + (acc[mt][nt][2] + acc[mt][nt][3]);
        s += __shfl_xor(s, 16); s += __shfl_xor(s, 32);
        if (l4 == 0) st1[wave * 64 + 16 * mt + l15] = s;
    }
    __syncthreads();
    float mean[4];
#pragma unroll
    for (int mt = 0; mt < 4; ++mt) { float m = 0.f;
#pragma unroll
        for (int w = 0; w < 8; ++w) m += st1[w * 64 + 16 * mt + l15];
        mean[mt] = m * (1.0f / 256.0f);
        float s = 0.f;
#pragma unroll
        for (int nt = 0; nt < 2; ++nt) { acc[mt][nt] = acc[mt][nt] - mean[mt]; s += (acc[mt][nt][0] * acc[mt][nt][0] + acc[mt][nt][1] * acc[mt][nt][1]) + (acc[mt][nt][2] * acc[mt][nt][2] + acc[mt][nt][3] * acc[mt][nt][3]); }
        s += __shfl_xor(s, 16); s += __shfl_xor(s, 32);
        if (l4 == 0) st2[wave * 64 + 16 * mt + l15] = s;
    }
    __syncthreads();
#pragma unroll
    for (int mt = 0; mt < 4; ++mt) { float q = 0.f; const int i = 16 * mt + l15;
#pragma unroll
        for (int w = 0; w < 8; ++w) q += st2[w * 64 + i];
        const float rstd = 1.0f / sqrtf(q * (1.0f / 256.0f) + LN_EPS);
        {
            const int col = h * 256 + 32 * wave + 8 * l4;
            const f32x4 g0 = *(const f32x4*)(gn_g + col), g1 = *(const f32x4*)(gn_g + col + 4), b0 = *(const f32x4*)(gn_b + col), b1 = *(const f32x4*)(gn_b + col + 4);
            const u32x4 graw = *(const u32x4*)(PROJ + (tok0 + i) * PLD + 3072 + col);
            const f32x4 o0 = acc[mt][0] * rstd * g0 + b0, o1 = acc[mt][1] * rstd * g1 + b1;
            u32x4 w; w.x = pk2(o0[0] * silu_f(lo16(graw.x)), o0[1] * silu_f(hi16(graw.x))); w.y = pk2(o0[2] * silu_f(lo16(graw.y)), o0[3] * silu_f(hi16(graw.y)));
            w.z = pk2(o1[0] * silu_f(lo16(graw.z)), o1[1] * silu_f(hi16(graw.z))); w.w = pk2(o1[2] * silu_f(lo16(graw.w)), o1[3] * silu_f(hi16(graw.w)));
            *(u32x4*)(MIX + (tok0 + i) * DM + col) = w;
        }
    }
    __syncthreads();
}

__device__ __forceinline__ void ssd_c_unit(LAS unsigned char* lds, const bf16* PROJ, const float* DT, const float* cw, const float* cb, const float* dt_bias, const float* a_log,
                                           const float* dskip, const float* ngain, const bf16* SSDS, bf16* MIX, int b, int z, int g, int tid) {
    asm volatile("" : "+v"(tid));
    const int wave = tid >> 6, lane = tid & 63, l15 = lane & 15, l4 = lane >> 4;
    const size_t tok0 = (size_t)b * SEQ + (size_t)z * 64;
    LAS bf16* Cm = (LAS bf16*)lds;
    LAS bf16* Bm = (LAS bf16*)(lds + 17408);
    LAS bf16* Xt = (LAS bf16*)(lds + 34816);
    LAS float* CB = (LAS float*)(lds + 108544);
    LAS float* dts = (LAS float*)(lds + 125184);
    LAS float* acs = (LAS float*)(lds + 127232);
    LAS bf16* Lw = (LAS bf16*)(lds + 129280 + wave * 2304);
    LAS float* ssq = (LAS float*)(lds + 147712);
    { float dt, ac; dt_acum(DT, dt_bias, a_log, tok0, g * 8 + wave, lane, dt, ac); dts[wave * 64 + lane] = dt; acs[wave * 64 + lane] = ac; }
    __syncthreads();
    {
        const int chx = tid >> 3, tg = tid & 7; f32x4 o0[8], o1[8]; float sc[8];
        conv_tile8(PROJ, cw, cb, tok0, z * 64, tg, g * 512 + chx * 8, o0, o1);
#pragma unroll
        for (int r = 0; r < 8; ++r) sc[r] = dts[(chx >> 3) * 64 + tg * 8 + r];
        conv_store_t(o0, o1, sc, Xt + (chx * 8) * 72 + tg * 8, 72);
    }
    if (tid < 256) {
        const int mat = tid >> 7, chb = (tid >> 3) & 15, tg = tid & 7; f32x4 o0[8], o1[8];
        conv_tile8(PROJ, cw, cb, tok0, z * 64, tg, 1024 + mat * 256 + g * 128 + chb * 8, o0, o1);
#pragma unroll
        for (int r = 0; r < 8; ++r) { u32x4 w; w.x = pk2(o0[r][0], o0[r][1]); w.y = pk2(o0[r][2], o0[r][3]); w.z = pk2(o1[r][0], o1[r][1]); w.w = pk2(o1[r][2], o1[r][3]);
            *(LAS u32x4*)((mat ? Cm : Bm) + (tg * 8 + r) * 136 + chb * 8) = w; }
    }
    __syncthreads();
    {
        const int mt = wave >> 1, nt0 = 2 * (wave & 1);
        f32x4 sc[2] = {(f32x4){0.f, 0.f, 0.f, 0.f}, (f32x4){0.f, 0.f, 0.f, 0.f}};
#pragma unroll
        for (int ks = 0; ks < 4; ++ks) {
            const bf16x8 xa = FRAG(Cm + (16 * mt + l15) * 136 + ks * 32 + 8 * l4);
#pragma unroll
            for (int n2 = 0; n2 < 2; ++n2) { const bf16x8 yb = FRAG(Bm + (16 * (nt0 + n2) + l15) * 136 + ks * 32 + 8 * l4); sc[n2] = mma(yb, xa, sc[n2]); }
        }
#pragma unroll
        for (int n2 = 0; n2 < 2; ++n2) { const int i = 16 * mt + l15, j0 = 16 * (nt0 + n2) + 4 * l4;
#pragma unroll
            for (int ii = 0; ii < 4; ++ii) CB[i * 65 + j0 + ii] = sc[n2][ii]; }
    }
    __syncthreads();
    const int r = wave, head = g * 8 + r;
    f32x4 acc[4][4];
#pragma unroll
    for (int mt = 0; mt < 4; ++mt)
#pragma unroll
        for (int nt = 0; nt < 4; ++nt) acc[mt][nt] = (f32x4){0.f, 0.f, 0.f, 0.f};
    const bf16* S = SSDS + ((size_t)((b * 16 + head) * 128 + z)) * 8192;
#pragma unroll
    for (int ks = 0; ks < 4; ++ks) {
        bf16x8 yb[4];
#pragma unroll
        for (int nt = 0; nt < 4; ++nt) yb[nt] = NT_LD((const bf16x8*)(S + (16 * (l15 >> 2) + 4 * nt + (l15 & 3)) * 128 + ks * 32 + 8 * l4));
#pragma unroll
        for (int mt = 0; mt < 4; ++mt) { const bf16x8 xa = FRAG(Cm + (16 * mt + l15) * 136 + ks * 32 + 8 * l4);
#pragma unroll
            for (int nt = 0; nt < 4; ++nt) acc[mt][nt] = mma(yb[nt], xa, acc[mt][nt]); }
    }
#pragma unroll
    for (int mt = 0; mt < 4; ++mt) { const float fs = expf(acs[r * 64 + 16 * mt + l15]);
#pragma unroll
        for (int nt = 0; nt < 4; ++nt) acc[mt][nt] = acc[mt][nt] * fs; }
#pragma unroll
    for (int mt = 0; mt < 4; ++mt) {
        const int i = 16 * mt + l15 + (int)opaque0(); const float ai = acs[r * 64 + i];
#pragma unroll
        for (int hh = 0; hh < 2; ++hh) {
            float lv[8];
#pragma unroll
            for (int k = 0; k < 8; ++k) { const int j = 16 * l4 + 8 * hh + k; const float e = expf(ai - acs[r * 64 + j]); lv[k] = (j <= i) ? CB[i * 65 + j] * e : 0.0f; }
            u32x4 w; w.x = pk2(lv[0], lv[1]); w.y = pk2(lv[2], lv[3]); w.z = pk2(lv[4], lv[5]); w.w = pk2(lv[6], lv[7]);
            *(LAS u32x4*)(Lw + l15 * 72 + 16 * l4 + 8 * hh) = w;
        }
        LDS_WAIT(); __builtin_amdgcn_wave_barrier();
#pragma unroll
        for (int ks = 0; ks < 2; ++ks) {
            const bf16x8 xa = FRAG(Lw + l15 * 72 + ks * 32 + 8 * l4);
#pragma unroll
            for (int nt = 0; nt < 4; ++nt) { const bf16x8 yb = FRAG(Xt + (64 * r + 16 * (l15 >> 2) + 4 * nt + (l15 & 3)) * 72 + ks * 32 + 8 * l4); acc[mt][nt] = mma(yb, xa, acc[mt][nt]); }
        }
        LDS_WAIT(); __builtin_amdgcn_wave_barrier();
    }
    const float dsk = dskip[head];
#pragma unroll
    for (int mt = 0; mt < 4; ++mt) {
        const int i = 16 * mt + l15; const float dti = dts[r * 64 + i]; const float rdt = dti > 0.f ? 1.0f / dti : 0.f; float sq = 0.f;
        const u32x4 zr0 = *(const u32x4*)(PROJ + (tok0 + i) * PLD + 4096 + g * 512 + r * 64 + 16 * l4), zr1 = *(const u32x4*)(PROJ + (tok0 + i) * PLD + 4096 + g * 512 + r * 64 + 16 * l4 + 8);
#pragma unroll
        for (int nt = 0; nt < 4; ++nt) {
            const int p0 = 16 * l4 + 4 * nt;
            const unsigned zw0 = nt == 0 ? zr0.x : nt == 1 ? zr0.z : nt == 2 ? zr1.x : zr1.z, zw1 = nt == 0 ? zr0.y : nt == 1 ? zr0.w : nt == 2 ? zr1.y : zr1.w;
            const float zz[4] = {lo16(zw0), hi16(zw0), lo16(zw1), hi16(zw1)};
#pragma unroll
            for (int ii = 0; ii < 4; ++ii) { const float x = bf2f(Xt[(64 * r + p0 + ii) * 72 + i]) * rdt; const float y = (acc[mt][nt][ii] + dsk * x) * silu_f(zz[ii]); acc[mt][nt][ii] = y; sq += y * y; }
        }
        sq += __shfl_xor(sq, 16); sq += __shfl_xor(sq, 32);
        if (l4 == 0) ssq[r * 64 + i] = sq;
    }
    __syncthreads();
#pragma unroll
    for (int mt = 0; mt < 4; ++mt) {
        const int i = 16 * mt + l15; float t = 0.f;
#pragma unroll
        for (int w = 0; w < 8; ++w) t += ssq[w * 64 + i];
        const float rstd = 1.0f / sqrtf(t * (1.0f / 512.0f) + LN_EPS);
#pragma unroll
        for (int hh = 0; hh < 2; ++hh) {
            const int col = g * 512 + r * 64 + 16 * l4 + 8 * hh;
            const f32x4 gn0 = *(const f32x4*)(ngain + col), gn1 = *(const f32x4*)(ngain + col + 4);
            const f32x4 o0 = acc[mt][2 * hh] * rstd * gn0, o1 = acc[mt][2 * hh + 1] * rstd * gn1;
            u32x4 w; w.x = pk2(o0[0], o0[1]); w.y = pk2(o0[2], o0[3]); w.z = pk2(o1[0], o1[1]); w.w = pk2(o1[2], o1[3]);
            *(u32x4*)(MIX + (tok0 + i) * DM + 1024 + col) = w;
        }
    }
    __syncthreads();
}

#define XB_TMO      128
#define XB_XCNT(j)  (256  + 64 * (j))
#define XB_XSUB(j)  (1280 + 64 * (j))
#define XB_XGEN(j)  (2304 + 64 * (j))
#define XB_TOP      3328
#define XB_TOPGEN   3392
#define XCD_BAR_WORDS 3456
#define XB_SPIN_CAP (1u << 18)

__device__ __forceinline__ unsigned xb_ld(unsigned* p)              { return __hip_atomic_load(p, __ATOMIC_RELAXED, __HIP_MEMORY_SCOPE_AGENT); }
__device__ __forceinline__ unsigned xb_add(unsigned* p, unsigned v) { return __hip_atomic_fetch_add(p, v, __ATOMIC_RELAXED, __HIP_MEMORY_SCOPE_AGENT); }
__device__ __forceinline__ unsigned xb_xcc_id() { return (unsigned)__builtin_amdgcn_s_getreg((3 << 11) | 20) & 0xFu; }
#define XB_SPIN(cond, bar) do { unsigned _sp = 0; while (cond) { __builtin_amdgcn_s_sleep(1); \
    if ((++_sp & 255u) == 0u) { if (xb_ld(&(bar)[XB_TMO])) break; if (_sp > XB_SPIN_CAP) { atomicAdd(&(bar)[XB_TMO], 1u); break; } } } } while (0)

struct XcdBarrier {
    unsigned* bar; unsigned x;
    volatile LAS unsigned* st;
};

__device__ __forceinline__ XcdBarrier xcd_barrier_post(unsigned* bar, volatile LAS unsigned* st) {
    XcdBarrier b; b.bar = bar; b.x = xb_xcc_id(); b.st = st;
    if (threadIdx.x == 0) (void)xb_add(&bar[XB_XCNT(b.x)], 1u);
    return b;
}
__device__ __forceinline__ void xcd_barrier_complete(unsigned* bar, unsigned x, unsigned& nloc, unsigned& nx) {
    const unsigned G = gridDim.x * gridDim.y * gridDim.z;
    unsigned sum, cnt, mine, sp = 0u;
    for (;;) {
        sum = 0u; cnt = 0u; mine = 0u;
#pragma unroll
        for (unsigned j = 0; j < 16; ++j) { const unsigned c = xb_ld(&bar[XB_XCNT(j)]); sum += c; cnt += (c > 0u) ? 1u : 0u; mine = (j == x) ? c : mine; }
        if (sum == G) break;
        __builtin_amdgcn_s_sleep(1);
        if ((++sp & 255u) == 0u) { if (xb_ld(&bar[XB_TMO])) break; if (sp > XB_SPIN_CAP) { atomicAdd(&bar[XB_TMO], 1u); break; } }
    }
    nloc = mine > 0u ? mine : 1u; nx = cnt > 0u ? cnt : 1u;
}

__device__ __forceinline__ void xcd_barrier(const XcdBarrier& b) {
    asm volatile("s_waitcnt vmcnt(0)" ::: "memory");
    __syncthreads();
    if (threadIdx.x == 0) {
        unsigned* bar = b.bar;
        __builtin_amdgcn_s_waitcnt(0);
        unsigned nloc = b.st[0], nx = b.st[1];
        if (nloc == 0u) { xcd_barrier_complete(bar, b.x, nloc, nx); b.st[0] = nloc; b.st[1] = nx; }
        const unsigned old = xb_add(&bar[XB_XSUB(b.x)], 1u);
        const unsigned gen = old / nloc;
        if (old + 1u == (gen + 1u) * nloc) {
            __builtin_amdgcn_fence(__ATOMIC_RELEASE, "agent");
            asm volatile("s_waitcnt vmcnt(0)" ::: "memory");
            const unsigned og = xb_add(&bar[XB_TOP], 1u);
            const unsigned tg = og / nx;
            if (og + 1u == (tg + 1u) * nx) xb_add(&bar[XB_TOPGEN], 1u);
            else XB_SPIN(xb_ld(&bar[XB_TOPGEN]) == tg, bar);
            __builtin_amdgcn_fence(__ATOMIC_ACQUIRE, "agent");
            xb_add(&bar[XB_XGEN(b.x)], 1u);
            asm volatile("s_waitcnt vmcnt(0)" ::: "memory");
        } else {
            XB_SPIN(xb_ld(&bar[XB_XGEN(b.x)]) == gen, bar);
            __builtin_amdgcn_fence(__ATOMIC_ACQUIRE, "agent");
            asm volatile("s_waitcnt vmcnt(0)" ::: "memory");
        }
    }
    __syncthreads();
}


#ifndef DUMPC
#define DUMPC 0
#endif
__device__ __forceinline__ void dump_bf16(float* out, const bf16* src, size_t ld, size_t col0, int gtid, int nth) {
    for (size_t i = gtid; i < (size_t)M_TOK * DM; i += nth) { const size_t r = i >> 11, c = i & 2047; float v = bf2f(src[r * ld + col0 + c]); if (!(fabsf(v) < 1e30f)) v = 12345.0f; out[i] = v; }
}
struct Args { const void* in[24]; float* out; unsigned char* ws; };
typedef __attribute__((address_space(4))) const unsigned long long karg_t;
#define KARG(T, i) ((T)(__attribute__((address_space(1))) char*)(((karg_t*)__builtin_amdgcn_kernarg_segment_ptr())[(i) + oz]))
#define KF(i) KARG(const float*, i)
#define WSP(T, off) ((T)(KARG(unsigned char*, 25) + (off)))
__global__ void __launch_bounds__(NT, 2) fwd_megakernel(Args a_unused) {
    extern __shared__ __attribute__((aligned(16))) unsigned char lds_raw[];
    LAS unsigned char* lds = (LAS unsigned char*)lds_raw;
    cg::grid_group grid = cg::this_grid();
    XcdBarrier bar;
    { volatile LAS unsigned* misc = (volatile LAS unsigned*)(lds + MISC_OFF); if (threadIdx.x < 2) misc[threadIdx.x] = 0u; if (threadIdx.x == 2) *(volatile LAS unsigned*)(lds + 140000) = 0u; __syncthreads();
      const unsigned oz = opaque0(); bar = xcd_barrier_post((unsigned*)WSP(unsigned char*, WS_CTL), misc); }
    grid.sync();
#define SEAM() xcd_barrier(bar)
#ifndef GEMM_ALIGN
#define GEMM_ALIGN true
#endif
#ifndef SKIP_GEMM
#define SKIP_GEMM 0
#endif
#ifndef STOP_AFTER
#define STOP_AFTER 99
#endif
#define GEOM int tid_o = threadIdx.x; asm volatile("" : "+v"(tid_o)); const int tid = tid_o, lane = tid & 63, wave = __builtin_amdgcn_readfirstlane(tid >> 6); (void)lane; (void)wave; const int G = gridDim.x, bx = blockIdx.x, gw = bx * 8 + wave, NGW = G * 8, gtid = bx * NT + tid, nth = G * NT; (void)gw; (void)NGW; (void)gtid; (void)nth; const unsigned oz = opaque0()

#ifdef P0_TWICE
    for (int rep0 = 0; rep0 < 2; ++rep0)
#endif
    { GEOM; LAS float* scr = (LAS float*)(lds + wave * 8448);
      convert_ffn<false>(KF(2), KF(3), KF(4), WSP(bf16*, WS_WGU), WSP(bf16*, WS_WD), scr, gw, NGW, lane);
      { const float* win = KF(7); const float* wout = KF(16); bf16* WIN = WSP(bf16*, WS_WIN); bf16* WOUT = WSP(bf16*, WS_WOUT);
        for (int it = gw; it < 32 * 216 + 32 * 64; it += NGW) {
            if (it < 32 * 216) { const int kb = it / 216, nb = it % 216; xpose_item<true>(win, NIN, DM, WIN, kb * 64, nb * 32, nb * 32, scr, lane, KF(5), KF(6), WSP(float*, WS_CD_IN), NINP); }
            else { const int r = it - 32 * 216, kb = r / 64, nb = r % 64; xpose_item<false>(wout, DM, DM, WOUT, kb * 64, nb * 32, nb * 32, scr, lane); }
        } }
      { const float* x = KF(0); bf16* XB = WSP(bf16*, WS_XB);
        for (size_t i0 = gtid; i0 < (size_t)M_TOK * DM / 8; i0 += (size_t)4 * nth) {
            f32x4 p[4], q[4];
#pragma unroll
            for (int k = 0; k < 4; ++k) { const size_t i = i0 + (size_t)k * nth; p[k] = NT_LD((const f32x4*)x + 2 * i); q[k] = NT_LD((const f32x4*)x + 2 * i + 1); }
#pragma unroll
            for (int k = 0; k < 4; ++k) { const size_t i = i0 + (size_t)k * nth;
                u32x4 w; w.x = pk2(p[k][0], p[k][1]); w.y = pk2(p[k][2], p[k][3]); w.z = pk2(q[k][0], q[k][1]); w.w = pk2(q[k][2], q[k][3]);
                ((u32x4*)XB)[i] = w; }
        } }
      { const int* pos = KARG(const int*, 1); float* COS = WSP(float*, WS_COS); float* SIN = WSP(float*, WS_SIN);
        const int f = gtid & 127; const double invf = (double)exp2f(-((float)f * (1.0f / 127.0f)) * 13.287712379549449f) * 0.15915494309189535;
        for (int t0 = gtid >> 7; t0 < M_TOK; t0 += 16 * (nth >> 7)) {
            int pp[16];
#pragma unroll
            for (int k = 0; k < 16; ++k) { const int tok = t0 + k * (nth >> 7); pp[k] = tok < M_TOK ? pos[tok] : 0; }
#pragma unroll
            for (int k = 0; k < 16; ++k) { const int tok = t0 + k * (nth >> 7);
                const double rev = (double)pp[k] * invf; const float fr = (float)(rev - rint(rev));
                if (tok < M_TOK) { COS[(size_t)tok * 128 + f] = __builtin_amdgcn_cosf(fr); SIN[(size_t)tok * 128 + f] = __builtin_amdgcn_sinf(fr); } }
        } }
      if (SKIP_GEMM) { bf16* BIGW = WSP(bf16*, WS_BIG); float* DTW = WSP(float*, WS_DT);
        for (size_t i = gtid; i < (size_t)M_TOK * PLD; i += nth) { unsigned hsh = (unsigned)i * 2654435761u; hsh ^= hsh >> 15; hsh *= 2246822519u; hsh ^= hsh >> 13; BIGW[i] = f2bf((float)(hsh & 0xffffu) * (1.0f / 65536.0f) - 0.5f); }
        for (size_t i = gtid; i < (size_t)M_TOK * 16; i += nth) { unsigned hsh = (unsigned)i * 2654435761u; hsh ^= hsh >> 15; hsh *= 2246822519u; hsh ^= hsh >> 13; DTW[i] = (float)(hsh & 0xffffu) * (1.0f / 65536.0f) - 0.5f; } }
    }
    SEAM(); if (STOP_AFTER == 0) return;

    { GEOM; pg8::Gemm g{WSP(const bf16*, WS_XB), WSP(const bf16*, WS_WGU), M_TOK, NGU, DM}; pg8::StaticOrder S; S.init(M_TOK, NGU, G, bx); pg8::EpiSwiglu E{WSP(bf16*, WS_BIG), DFF};
      if (!SKIP_GEMM) pg8::gemm_phase<pg8::EpiSwiglu, pg8::StaticOrder, GEMM_ALIGN, true>(lds, g, S, E); }
    SEAM(); if (STOP_AFTER == 1) return;
    { GEOM; pg8::Gemm g{WSP(const bf16*, WS_BIG), WSP(const bf16*, WS_WD), M_TOK, DM, DFF}; pg8::StaticOrder S; S.init(M_TOK, DM, G, bx); pg8::EpiResEmit<false, 1, true> E{nullptr, WSP(const bf16*, WS_XB), nullptr, nullptr, nullptr, WSP(bf16*, WS_XB), WSP(float*, WS_ROWS1)};
      if (!SKIP_GEMM) pg8::gemm_phase<pg8::EpiResEmit<false, 1, true>, pg8::StaticOrder, GEMM_ALIGN, true>(lds, g, S, E); }
    SEAM(); if (STOP_AFTER == 2) return;
    { GEOM; pg8::Gemm g{WSP(const bf16*, WS_XB), WSP(const bf16*, WS_WIN), M_TOK, NINP, DM}; pg8::StaticOrder S; S.init(M_TOK, NINP, G, bx);
      pg8::EpiInProj E{WSP(bf16*, WS_BIG), WSP(const float*, WS_COS), WSP(const float*, WS_SIN), WSP(float*, WS_DT), WSP(const float*, WS_ROWS1), WSP(const float*, WS_CD_IN), WSP(const float*, WS_CD_IN) + NINP};
      if (!SKIP_GEMM) pg8::gemm_phase<pg8::EpiInProj, pg8::StaticOrder, GEMM_ALIGN, true>(lds, g, S, E);
#ifdef DIAGMODE
      { volatile LAS unsigned* cnt = (volatile LAS unsigned*)(lds + 140000); if (lane == 0) atomicAdd((unsigned*)(lds_raw + 140000), 1u); __syncthreads(); const unsigned v = *cnt; WSP(float*, WS_XB)[gtid] = (float)v; }
#endif
    }
    SEAM();
#ifdef DIAGMODE
    { GEOM; const float* dg = WSP(const float*, WS_XB); float* o = KARG(float*, 24); for (size_t i = gtid; i < (size_t)M_TOK * DM; i += nth) o[i] = dg[i % nth]; return; }
#endif
    if (STOP_AFTER == 4) { GEOM; dump_bf16(KARG(float*, 24), WSP(const bf16*, WS_BIG), PLD, DUMPC, gtid, nth); return; }
#ifdef P5_TWICE
    for (int rep = 0; rep < 2; ++rep) {
#ifdef P5_NOSTORE2
#define P5_STORE_FLAG (rep == 0)
#else
#define P5_STORE_FLAG true
#endif
#else
#define P5_STORE_FLAG true
#endif
    { GEOM; const bf16* BIG = WSP(const bf16*, WS_BIG);
#ifdef TIME_P5
      unsigned long long tacc_r = 0ull, tacc_s = 0ull;
#endif
#ifdef P5_PIPE
      ret_a_block(lds, BIG, WSP(bf16*, WS_RETS), bx, G, tid);
      for (int u = bx + ((1024 - bx + G - 1) / G) * G; u < 1536; u += G) {
#else
      for (int u = bx; u < 1536; u += G) {
#endif
#ifdef TIME_P5
        const unsigned long long tq0 = __builtin_amdgcn_s_memrealtime();
#endif
#ifdef P5_SECOND_ONLY
        if (rep == 1 && ((u < 1024) != (P5_SECOND_ONLY == 0))) continue;
#endif
        if (u < 1024) ret_a_unit(lds, BIG, WSP(bf16*, WS_RETS), u >> 9, (u >> 2) & 127, u & 3, tid, P5_STORE_FLAG);
        else { const int v = u - 1024; ssd_a_unit(lds, BIG, WSP(const float*, WS_DT), KF(10), KF(11), KF(12), KF(13), WSP(bf16*, WS_SSDS), WSP(float*, WS_TOT), v >> 8, (v >> 1) & 127, v & 1, tid, P5_STORE_FLAG); }
#ifdef TIME_P5
        { const unsigned long long tq1 = __builtin_amdgcn_s_memrealtime(); if (u < 1024) tacc_r += tq1 - tq0; else tacc_s += tq1 - tq0; }
#endif
      }
#ifdef TIME_P5
      if (bx == TIME_P5 && tid == 0) { float* dg = WSP(float*, WS_STATS); dg[0] = (float)tacc_r; dg[1] = (float)tacc_s; }
#endif
    }
#ifdef P5_TWICE
    if (rep == 0) SEAM(); }
#endif
#ifdef DBG_FLAG
    { GEOM; unsigned* FL = (unsigned*)WSP(unsigned char*, WS_CTL + 32768); if (tid == 511) FL[bx * 16] = 5u; }
    SEAM();
    { GEOM; const unsigned* FL = (const unsigned*)WSP(unsigned char*, WS_CTL + 32768); int bad = 0; for (int k = 0; k < G; ++k) bad += (FL[k * 16] != 5u);
      float* o = KARG(float*, 24); for (size_t i = gtid; i < (size_t)M_TOK * DM; i += nth) o[i] = 1000.0f * (float)bad; return; }
#endif
#ifdef TIME_P5
    SEAM(); { GEOM; const float* dg = WSP(const float*, WS_STATS); const float a = dg[0], b = dg[1]; float* o = KARG(float*, 24); for (size_t i = gtid; i < (size_t)M_TOK * DM; i += nth) o[i] = (i & 1) ? b : a; return; }
#endif
    SEAM(); if (STOP_AFTER == 5) { GEOM; dump_bf16(KARG(float*, 24), DUMPC == 2 ? WSP(const bf16*, WS_XB) : DUMPC ? WSP(const bf16*, WS_SSDS) : WSP(const bf16*, WS_RETS), DM, 0, gtid, nth); return; }
    { GEOM; scan_phase(WSP(bf16*, WS_RETS), WSP(bf16*, WS_SSDS), WSP(const float*, WS_TOT), gtid, nth); }
    SEAM(); if (STOP_AFTER == 6) { GEOM; dump_bf16(KARG(float*, 24), DUMPC ? WSP(const bf16*, WS_SSDS) : WSP(const bf16*, WS_RETS), DM, 0, gtid, nth); return; }
#ifdef P7_TWICE
    for (int rep7 = 0; rep7 < 2; ++rep7)
#endif
    { GEOM; const bf16* BIG = WSP(const bf16*, WS_BIG); bf16* XB = (bf16*)KARG(float*, 24);
      for (int u = bx; u < 1536; u += G) {
        if (u < 1024) ret_c_unit(lds, BIG, WSP(const bf16*, WS_RETS), KF(8), KF(9), XB, u >> 9, (u >> 2) & 127, u & 3, tid);
        else { const int v = u - 1024; ssd_c_unit(lds, BIG, WSP(const float*, WS_DT), KF(10), KF(11), KF(12), KF(13), KF(14), KF(15), WSP(const bf16*, WS_SSDS), XB, v >> 8, (v >> 1) & 127, v & 1, tid); }
      } }
    SEAM(); if (STOP_AFTER == 7) { GEOM; dump_bf16(KARG(float*, 24), WSP(const bf16*, WS_XB), DM, 0, gtid, nth); return; }
    { GEOM; pg8::Gemm g{(const bf16*)KARG(float*, 24), WSP(const bf16*, WS_WOUT), M_TOK, DM, DM}; pg8::StaticOrder S; S.init(M_TOK, DM, G, bx); pg8::EpiResEmit<true, 2> E{nullptr, WSP(const bf16*, WS_XB), WSP(const float*, WS_ROWS1), KF(5), KF(6), WSP(bf16*, WS_Y2B), WSP(float*, WS_ROWS2)};
      if (!SKIP_GEMM) pg8::gemm_phase<pg8::EpiResEmit<true, 2>, pg8::StaticOrder, GEMM_ALIGN, true>(lds, g, S, E); }
    SEAM(); if (STOP_AFTER == 8) return;
    { GEOM; LAS float* scr = (LAS float*)(lds + wave * 8448);
      convert_ffn<true>(KF(19), KF(20), KF(21), WSP(bf16*, WS_WGU), WSP(bf16*, WS_WD), scr, gw, NGW, lane, KF(17), KF(18), WSP(float*, WS_CD_GU)); }
    SEAM(); if (STOP_AFTER == 9) return;
    { GEOM; pg8::Gemm g{WSP(const bf16*, WS_Y2B), WSP(const bf16*, WS_WGU), M_TOK, NGU, DM}; pg8::StaticOrder S; S.init(M_TOK, NGU, G, bx);
      pg8::EpiSwigluLN E{WSP(bf16*, WS_BIG), DFF, WSP(const float*, WS_ROWS2), WSP(const float*, WS_CD_GU), WSP(const float*, WS_CD_GU) + NGU};
      if (!SKIP_GEMM) pg8::gemm_phase<pg8::EpiSwigluLN, pg8::StaticOrder, GEMM_ALIGN, true>(lds, g, S, E); }
    SEAM(); if (STOP_AFTER == 10) return;
    { GEOM; pg8::Gemm g{WSP(const bf16*, WS_BIG), WSP(const bf16*, WS_WD), M_TOK, DM, DFF}; pg8::StaticOrder S; S.init(M_TOK, DM, G, bx); pg8::EpiResLN2 E{WSP(const bf16*, WS_Y2B), WSP(const float*, WS_ROWS2), KF(17), KF(18), WSP(bf16*, WS_XB)};
      if (!SKIP_GEMM) pg8::gemm_phase<pg8::EpiResLN2, pg8::StaticOrder, GEMM_ALIGN, true>(lds, g, S, E); }
    SEAM(); if (STOP_AFTER == 11) return;
    { GEOM; ln3_rows(WSP(const bf16*, WS_XB), KARG(float*, 24), KF(22), KF(23), gw, NGW, lane); }
}

extern "C" void kernel_launch(void* const* d_in, const int* in_sizes, int n_in, void* d_out, int out_size, void* d_ws, size_t ws_size, hipStream_t stream) {
    static int grid = 0;
    if (grid == 0) {
        if (n_in != 24 || in_sizes[0] != M_TOK * DM || out_size != M_TOK * DM || ws_size < WS_END) {
            fprintf(stderr, "kernel_launch: unexpected problem (n_in %d, in0 %d, out %d, ws %zu); nothing launched\n", n_in, n_in > 0 ? in_sizes[0] : -1, out_size, ws_size); grid = -1; return; }
        int dev = 0, cus = 0, per_cu = 0;
        (void)hipGetDevice(&dev); (void)hipDeviceGetAttribute(&cus, hipDeviceAttributeMultiprocessorCount, dev);
        (void)hipFuncSetAttribute((const void*)fwd_megakernel, hipFuncAttributeMaxDynamicSharedMemorySize, LDS_BYTES);
        if (hipOccupancyMaxActiveBlocksPerMultiprocessor(&per_cu, (const void*)fwd_megakernel, NT, LDS_BYTES) != hipSuccess || per_cu < 1) { per_cu = 1; (void)hipGetLastError(); }
        if (cus < 1) cus = 256;
        grid = cus * per_cu;
    }
    if (grid < 0) return;
    if (hipMemsetAsync((char*)d_ws + WS_CTL, 0, CTL_ZERO_BYTES, stream) != hipSuccess) { fprintf(stderr, "kernel_launch: memset of the barrier words failed\n"); return; }
    Args a{};
    for (int i = 0; i < 24; ++i) a.in[i] = d_in[i];
    a.out = (float*)d_out; a.ws = (unsigned char*)d_ws;
    void* args[] = {&a};
    hipError_t e = hipLaunchCooperativeKernel((const void*)fwd_megakernel, dim3(grid), dim3(NT), args, LDS_BYTES, stream);
    if (e != hipSuccess) fprintf(stderr, "cooperative launch failed: %s (grid %d)\n", hipGetErrorString(e), grid);
}
```
